# Optimizing an MI355X kernel written in HIP

```python
import jax, jax.numpy as jnp
from jax import lax
import numpy as np

D_MODEL = 1024
BATCH = 16
SEQ = 2048
DEPTH = 1

N_MEM = 256
D_LRU = D_MODEL // 2
LRU_BLOCKS = 8
LRU_BLOCK_DIM = D_LRU // LRU_BLOCKS
CONV_WIDTH = 4
LRU_C = 8.0
D_ATTN = D_MODEL - D_LRU
ATTN_HEADS = 8
ATTN_HEAD_DIM = D_ATTN // ATTN_HEADS
MOBA_BLOCK = 256
MOBA_TOPK = 3
MOBA_Q_CHUNK = 16
D_IN = 2 * D_LRU + 3 * D_ATTN
CROSS_HEADS = 4
CROSS_HEAD_DIM = D_MODEL // CROSS_HEADS
PEER_KEYS = 128
PEER_EXPERTS = PEER_KEYS * PEER_KEYS
PEER_HEADS = 8
PEER_TOPK = 16
PEER_QDIM = 256
PEER_HALF = PEER_QDIM // 2
PEER_TOKEN_CHUNK = 128
PEER_V_SCALE = 0.5

EPS = 1e-6
NEG = -1e30

kernel_name = "hymba_rglru_moba_peer_block"


def rmsnorm(x, g):
    xf = x.astype(jnp.float32)
    y = xf * lax.rsqrt(jnp.mean(xf * xf, axis=-1, keepdims=True) + EPS)
    return (y * g.astype(jnp.float32)).astype(x.dtype)


def causal_depthwise_conv(x, w, b):
    y = lax.conv_general_dilated(
        x, w[:, None, :], window_strides=(1,), padding=[(CONV_WIDTH - 1, 0)],
        dimension_numbers=('NWC', 'WIO', 'NWC'), feature_group_count=x.shape[-1])
    return y + b


def rg_lru(x, wa, ba, wx, bx, lam):
    B, S, C = x.shape
    xb = x.reshape(B, S, LRU_BLOCKS, LRU_BLOCK_DIM)
    gate_r = jax.nn.sigmoid(jnp.einsum('bsnd,nde->bsne', xb, wa).reshape(B, S, C) + ba)
    gate_i = jax.nn.sigmoid(jnp.einsum('bsnd,nde->bsne', xb, wx).reshape(B, S, C) + bx)
    log_a = (-LRU_C * gate_r.astype(jnp.float32)) * jax.nn.softplus(-lam.astype(jnp.float32))
    a = jnp.exp(log_a)
    b = jnp.sqrt(-jnp.expm1(2.0 * log_a)) * (gate_i * x).astype(jnp.float32)

    def combine(left, right):
        a1, b1 = left
        a2, b2 = right
        return a1 * a2, a2 * b1 + b2

    _, h = lax.associative_scan(combine, (a, b), axis=1)
    return h.astype(x.dtype)


def moba_attention(q, k, v):
    B, S, H, Dh = q.shape
    nb = -(-S // MOBA_BLOCK)
    s_pad = nb * MOBA_BLOCK
    pad = [(0, 0), (0, s_pad - S), (0, 0), (0, 0)]
    q, k, v = (jnp.pad(t, pad).transpose(0, 2, 1, 3) for t in (q, k, v))
    scale = Dh ** -0.5
    k_blocks = k.reshape(B, H, nb, MOBA_BLOCK, Dh)
    v_blocks = v.reshape(B, H, nb, MOBA_BLOCK, Dh)
    k_mean = jnp.mean(k_blocks.astype(jnp.float32), axis=3)
    q_block = jnp.arange(s_pad) // MOBA_BLOCK
    gate = jnp.einsum('bhsd,bhnd->bhsn', q.astype(jnp.float32), k_mean)
    fully_past = jnp.arange(nb)[None, :] < q_block[:, None]
    gate = jnp.where(fully_past, gate, NEG)
    topk = min(MOBA_TOPK, nb)
    _, sel = lax.top_k(gate, topk)
    sel_valid = sel < q_block[:, None]
    gather_blocks = jax.vmap(jax.vmap(lambda blocks, idx: blocks[idx]))
    n_chunks = s_pad // MOBA_Q_CHUNK

    def chunk(c):
        start = c * MOBA_Q_CHUNK
        q_c = lax.dynamic_slice_in_dim(q, start, MOBA_Q_CHUNK, axis=2)
        sel_c = lax.dynamic_slice_in_dim(sel, start, MOBA_Q_CHUNK, axis=2)
        valid_c = lax.dynamic_slice_in_dim(sel_valid, start, MOBA_Q_CHUNK, axis=2)
        flat_sel = sel_c.reshape(B, H, MOBA_Q_CHUNK * topk)
        k_sel = gather_blocks(k_blocks, flat_sel).reshape(B, H, MOBA_Q_CHUNK, topk * MOBA_BLOCK, Dh)
        v_sel = gather_blocks(v_blocks, flat_sel).reshape(B, H, MOBA_Q_CHUNK, topk * MOBA_BLOCK, Dh)
        j = start // MOBA_BLOCK
        k_own = lax.dynamic_index_in_dim(k_blocks, j, axis=2, keepdims=False)
        v_own = lax.dynamic_index_in_dim(v_blocks, j, axis=2, keepdims=False)
        s_past = jnp.einsum('bhqd,bhqkd->bhqk', q_c, k_sel).astype(jnp.float32) * scale
        s_past = jnp.where(jnp.repeat(valid_c, MOBA_BLOCK, axis=-1), s_past, NEG)
        s_own = jnp.einsum('bhqd,bhkd->bhqk', q_c, k_own).astype(jnp.float32) * scale
        q_pos = start + jnp.arange(MOBA_Q_CHUNK)
        k_pos = j * MOBA_BLOCK + jnp.arange(MOBA_BLOCK)
        s_own = jnp.where(k_pos[None, :] <= q_pos[:, None], s_own, NEG)
        p = jax.nn.softmax(jnp.concatenate([s_past, s_own], axis=-1), axis=-1).astype(v.dtype)
        p_past, p_own = p[..., :topk * MOBA_BLOCK], p[..., topk * MOBA_BLOCK:]
        return (jnp.einsum('bhqk,bhqkd->bhqd', p_past, v_sel)
                + jnp.einsum('bhqk,bhkd->bhqd', p_own, v_own))

    out = lax.map(chunk, jnp.arange(n_chunks))
    out = out.transpose(1, 0, 3, 2, 4).reshape(B, s_pad, H, Dh)
    return out[:, :S]


def memory_cross_attention(xn, memn, w_q, w_k, w_v, w_o):
    B, S, _ = xn.shape
    M = memn.shape[1]
    q = (xn @ w_q).reshape(B, S, CROSS_HEADS, CROSS_HEAD_DIM)
    k = (memn @ w_k).reshape(B, M, CROSS_HEADS, CROSS_HEAD_DIM)
    v = (memn @ w_v).reshape(B, M, CROSS_HEADS, CROSS_HEAD_DIM)
    s = jnp.einsum('bshd,bmhd->bhsm', q, k).astype(jnp.float32) * CROSS_HEAD_DIM ** -0.5
    p = jax.nn.softmax(s, axis=-1).astype(v.dtype)
    o = jnp.einsum('bhsm,bmhd->bshd', p, v).reshape(B, S, D_MODEL)
    return o @ w_o


def peer_ffn(xn, w_q, sub_keys, u, v):
    B, S, D = xn.shape
    T = B * S
    t = xn.reshape(T, D)
    q = (t @ w_q).reshape(T, PEER_HEADS, 2, PEER_HALF)
    s = jnp.einsum('thpd,hpnd->thpn', q, sub_keys).astype(jnp.float32)
    s_top, i_top = lax.top_k(s, PEER_TOPK)
    cand_s = (s_top[:, :, 0, :, None] + s_top[:, :, 1, None, :]).reshape(T, PEER_HEADS, PEER_TOPK * PEER_TOPK)
    cand_i = (i_top[:, :, 0, :, None] * PEER_KEYS + i_top[:, :, 1, None, :]).reshape(T, PEER_HEADS, PEER_TOPK * PEER_TOPK)
    best_s, pos = lax.top_k(cand_s, PEER_TOPK)
    ids = jnp.take_along_axis(cand_i, pos, axis=-1).reshape(T, PEER_HEADS * PEER_TOPK)
    gates = jax.nn.softmax(best_s, axis=-1).reshape(T, PEER_HEADS * PEER_TOPK)
    n_chunks = T // PEER_TOKEN_CHUNK

    def chunk(args):
        x_c, ids_c, g_c = args
        act = jax.nn.gelu(jnp.einsum('td,ted->te', x_c, u[ids_c]), approximate=False)
        return jnp.einsum('te,ted->td', g_c.astype(x_c.dtype) * act, v[ids_c])

    y = lax.map(chunk, (t.reshape(n_chunks, PEER_TOKEN_CHUNK, D),
                        ids.reshape(n_chunks, PEER_TOKEN_CHUNK, -1),
                        gates.reshape(n_chunks, PEER_TOKEN_CHUNK, -1)))
    return y.reshape(B, S, D)


def hybrid_layer(x, mem, ln_mix_g, w_in, conv_w, conv_b, lru_wa, lru_ba, lru_wx, lru_bx,
                 lru_lambda, gn_lru_g, gn_attn_g, w_out, ln_cross_g, ln_mem_g, w_cq, w_ck,
                 w_cv, w_co, ln_ffn_g, peer_wq, peer_subkeys, peer_u, peer_v):
    B, S, _ = x.shape
    h = rmsnorm(x, ln_mix_g)
    proj = h @ w_in
    lru_x, lru_gate, q, k, v = jnp.split(
        proj, [D_LRU, 2 * D_LRU, 2 * D_LRU + D_ATTN, 2 * D_LRU + 2 * D_ATTN], axis=-1)
    lru_x = causal_depthwise_conv(lru_x, conv_w, conv_b)
    y_lru = rg_lru(lru_x, lru_wa, lru_ba, lru_wx, lru_bx, lru_lambda) * jax.nn.gelu(lru_gate, approximate=False)
    shp = (B, S, ATTN_HEADS, ATTN_HEAD_DIM)
    y_attn = moba_attention(q.reshape(shp), k.reshape(shp), v.reshape(shp)).reshape(B, S, D_ATTN)
    mixed = jnp.concatenate([rmsnorm(y_lru, gn_lru_g), rmsnorm(y_attn, gn_attn_g)], axis=-1)
    x = x + mixed @ w_out
    x = x + memory_cross_attention(rmsnorm(x, ln_cross_g), rmsnorm(mem, ln_mem_g), w_cq, w_ck, w_cv, w_co)
    x = x + peer_ffn(rmsnorm(x, ln_ffn_g), peer_wq, peer_subkeys, peer_u, peer_v)
    return x


def setup_inputs(seed: int = 0) -> dict:
    key = jax.random.key(seed)
    ks = jax.random.split(key, 32)

    def normal(k, shape, scale):
        return jax.random.normal(k, shape, jnp.float32) * scale

    def gain(k, shape):
        return 1.0 + normal(k, shape, 0.02)

    L = DEPTH
    u_a = jax.random.uniform(ks[8], (L, D_LRU), jnp.float32, minval=0.9, maxval=0.999)
    p_a = u_a ** (1.0 / LRU_C)
    lru_lambda = jnp.log(p_a) - jnp.log1p(-p_a)
    return {
        "x": normal(ks[0], (BATCH, SEQ, D_MODEL), 1.0),
        "mem": normal(ks[1], (BATCH, N_MEM, D_MODEL), 1.0),
        "ln_mix_g": gain(ks[2], (L, D_MODEL)),
        "w_in": normal(ks[3], (L, D_MODEL, D_IN), D_MODEL ** -0.5),
        "conv_w": normal(ks[4], (L, CONV_WIDTH, D_LRU), CONV_WIDTH ** -0.5),
        "conv_b": normal(ks[5], (L, D_LRU), 0.01),
        "lru_wa": normal(ks[6], (L, LRU_BLOCKS, LRU_BLOCK_DIM, LRU_BLOCK_DIM), LRU_BLOCK_DIM ** -0.5),
        "lru_ba": normal(ks[7], (L, D_LRU), 0.01),
        "lru_wx": normal(ks[9], (L, LRU_BLOCKS, LRU_BLOCK_DIM, LRU_BLOCK_DIM), LRU_BLOCK_DIM ** -0.5),
        "lru_bx": normal(ks[10], (L, D_LRU), 0.01),
        "lru_lambda": lru_lambda,
        "gn_lru_g": gain(ks[11], (L, D_LRU)),
        "gn_attn_g": gain(ks[12], (L, D_ATTN)),
        "w_out": normal(ks[13], (L, D_MODEL, D_MODEL), D_MODEL ** -0.5),
        "ln_cross_g": gain(ks[14], (L, D_MODEL)),
        "ln_mem_g": gain(ks[15], (L, D_MODEL)),
        "w_cq": normal(ks[16], (L, D_MODEL, D_MODEL), D_MODEL ** -0.5),
        "w_ck": normal(ks[17], (L, D_MODEL, D_MODEL), D_MODEL ** -0.5),
        "w_cv": normal(ks[18], (L, D_MODEL, D_MODEL), D_MODEL ** -0.5),
        "w_co": normal(ks[19], (L, D_MODEL, D_MODEL), D_MODEL ** -0.5),
        "ln_ffn_g": gain(ks[20], (L, D_MODEL)),
        "peer_wq": normal(ks[21], (L, D_MODEL, PEER_HEADS * PEER_QDIM), D_MODEL ** -0.5),
        "peer_subkeys": normal(ks[22], (L, PEER_HEADS, 2, PEER_KEYS, PEER_HALF), PEER_HALF ** -0.5),
        "peer_u": normal(ks[23], (L, PEER_EXPERTS, D_MODEL), D_MODEL ** -0.5),
        "peer_v": normal(ks[24], (L, PEER_EXPERTS, D_MODEL), PEER_V_SCALE),
        "ln_final_g": gain(ks[25], (D_MODEL,)),
    }


def reference(x, mem, ln_mix_g, w_in, conv_w, conv_b, lru_wa, lru_ba, lru_wx, lru_bx,
              lru_lambda, gn_lru_g, gn_attn_g, w_out, ln_cross_g, ln_mem_g, w_cq, w_ck,
              w_cv, w_co, ln_ffn_g, peer_wq, peer_subkeys, peer_u, peer_v, ln_final_g):
    for l in range(DEPTH):
        x = hybrid_layer(x, mem, ln_mix_g[l], w_in[l], conv_w[l], conv_b[l], lru_wa[l], lru_ba[l],
                         lru_wx[l], lru_bx[l], lru_lambda[l], gn_lru_g[l], gn_attn_g[l], w_out[l],
                         ln_cross_g[l], ln_mem_g[l], w_cq[l], w_ck[l], w_cv[l], w_co[l],
                         ln_ffn_g[l], peer_wq[l], peer_subkeys[l], peer_u[l], peer_v[l])
    return rmsnorm(x, ln_final_g)
```

```cpp
#include <hip/hip_runtime.h>
#include <cstdio>
#include <cstdint>
namespace pg8 {
#define PG8_LAS __attribute__((address_space(3)))
typedef unsigned short bf16_t;
typedef short bf16x8 __attribute__((ext_vector_type(8)));
typedef float f32x4 __attribute__((ext_vector_type(4)));
typedef unsigned u32x4 __attribute__((ext_vector_type(4)));
constexpr int BM = 256, BK = 64, HALF = 128, HTB = HALF * BK * 2  , STAGE_BYTES = 8 * HTB, NXCD = 8, WGM = 8;

__host__ __device__ __forceinline__ int lds_byte(int r, int c) { const int st = (r >> 4) * 2 + (c >> 5), rr = r & 15, cc = c & 31, ob = rr * 64 + cc * 2; return st * 1024 + (ob ^ (((ob >> 9) & 1) << 5)); }
__host__ __device__ __forceinline__ void stage_rc(int b, int& R, int& C) { const int st = b / 1024, sb = b % 1024, swz = sb ^ (((sb >> 9) & 1) << 5); R = (st >> 1) * 16 + swz / 64; C = (st & 1) * 32 + (swz % 64) / 2; }
__host__ __device__ __forceinline__ int perm32(int rho) { const int n = rho >> 4, i = rho & 15; return 8 * (i >> 2) + 4 * n + (i & 3); }

struct Unit { int pm, pn; };
struct Gemm { const bf16_t* A; const bf16_t* Bt; int M, N, K; };

struct StaticOrder {
    int nM, nN, nwg, G, c;
    __host__ __device__ void init(int M, int N, int G_, int c_) { nM = M / BM; nN = N / BM; nwg = nM * nN; G = G_; c = c_; }
    __host__ __device__ bool next(int i, Unit& u) const {
        const long L = (long)i * G + c; if (L >= nwg) return false;
        int wgid = (int)L; { const int q = nwg / NXCD, r = nwg % NXCD, xcd = wgid % NXCD, off = wgid / NXCD; wgid = (xcd < r ? xcd * (q + 1) : r * (q + 1) + (xcd - r) * q) + off; }
        const int nig = WGM * nN, gid = wgid / nig, fm = gid * WGM, gsz = (nM - fm) < WGM ? (nM - fm) : WGM;
        u.pm = fm + ((wgid % nig) % gsz); u.pn = (wgid % nig) / gsz; return true;
    }
    __device__ __forceinline__ void a_ready(const Unit&) const {}
    __device__ __forceinline__ void done(const Unit&) const {}
};
__device__ __forceinline__ unsigned cvt_pk_bf16(float lo, float hi) { unsigned r; asm volatile("v_cvt_pk_bf16_f32 %0, %1, %2" : "=v"(r) : "v"(lo), "v"(hi)); return r; }
typedef float f32x2 __attribute__((ext_vector_type(2)));
struct EpiStore {
    static constexpr bool PERM = true, AFTER_DRAIN = false;
    bf16_t* O; int ldc;
    __device__ __forceinline__ void operator()(const f32x4 (&acc)[2][2][4][2], const Unit& u, int wr, int wc, int fr, int fq) const {
        const int row0 = u.pm * BM + wr * 64 + fr, col0 = u.pn * BM + wc * 32 + 8 * fq;
#pragma unroll
        for (int ai = 0; ai < 2; ++ai)
#pragma unroll
            for (int m = 0; m < 4; ++m) { bf16_t* rowp = O + (size_t)(row0 + ai * HALF + m * 16) * ldc + col0;
#pragma unroll
                for (int bj = 0; bj < 2; ++bj) { const f32x4 v0 = acc[ai][bj][m][0], v1 = acc[ai][bj][m][1];
                    u32x4 w; w.x = cvt_pk_bf16(v0[0], v0[1]); w.y = cvt_pk_bf16(v0[2], v0[3]); w.z = cvt_pk_bf16(v1[0], v1[1]); w.w = cvt_pk_bf16(v1[2], v1[3]);
                    *(u32x4*)(rowp + bj * HALF) = w; } }
    }
};
__device__ __forceinline__ float bfl(unsigned w) { return __uint_as_float(w << 16); }
__device__ __forceinline__ float bfh(unsigned w) { return __uint_as_float(w & 0xffff0000u); }
struct EpiResid {
    static constexpr bool PERM = true, AFTER_DRAIN = false;
    const float* resf; const bf16_t* resb; bf16_t* O; float* SS; int ldc;
    __device__ __forceinline__ void operator()(const f32x4 (&acc)[2][2][4][2], const Unit& u, int wr, int wc, int fr, int fq) const {
        const int row0 = u.pm * BM + wr * 64 + fr, col0 = u.pn * BM + wc * 32 + 8 * fq;
#pragma unroll
        for (int ai = 0; ai < 2; ++ai)
#pragma unroll
            for (int m = 0; m < 4; ++m) { const int row = row0 + ai * HALF + m * 16; const size_t off = (size_t)row * ldc + col0; float ss = 0.f;
#pragma unroll
                for (int bj = 0; bj < 2; ++bj) { f32x4 v0 = acc[ai][bj][m][0], v1 = acc[ai][bj][m][1];
                    if (resf) { const f32x4 r0 = *(const f32x4*)(resf + off + bj * HALF), r1 = *(const f32x4*)(resf + off + bj * HALF + 4); v0 = v0 + r0; v1 = v1 + r1; }
                    else { const u32x4 r = *(const u32x4*)(resb + off + bj * HALF);
                        v0[0] += bfl(r.x); v0[1] += bfh(r.x); v0[2] += bfl(r.y); v0[3] += bfh(r.y); v1[0] += bfl(r.z); v1[1] += bfh(r.z); v1[2] += bfl(r.w); v1[3] += bfh(r.w); }
                    ss += (v0[0] * v0[0] + v0[1] * v0[1]) + (v0[2] * v0[2] + v0[3] * v0[3]) + (v1[0] * v1[0] + v1[1] * v1[1]) + (v1[2] * v1[2] + v1[3] * v1[3]);
                    u32x4 w; w.x = cvt_pk_bf16(v0[0], v0[1]); w.y = cvt_pk_bf16(v0[2], v0[3]); w.z = cvt_pk_bf16(v1[0], v1[1]); w.w = cvt_pk_bf16(v1[2], v1[3]);
                    *(u32x4*)(O + off + bj * HALF) = w; }
                ss += __shfl_xor(ss, 16); ss += __shfl_xor(ss, 32);
                if (fq == 0) SS[(size_t)row * 16 + u.pn * 4 + wc] = ss; }
    }
};
struct EpiScale {
    static constexpr bool PERM = true, AFTER_DRAIN = false;
    const float* SS; bf16_t* O; int ldc; float eps;
    __device__ __forceinline__ void operator()(const f32x4 (&acc)[2][2][4][2], const Unit& u, int wr, int wc, int fr, int fq) const {
        const int row0 = u.pm * BM + wr * 64 + fr, col0 = u.pn * BM + wc * 32 + 8 * fq;
#pragma unroll
        for (int ai = 0; ai < 2; ++ai)
#pragma unroll
            for (int m = 0; m < 4; ++m) { const int row = row0 + ai * HALF + m * 16; bf16_t* rowp = O + (size_t)row * ldc + col0;
                const f32x4* sp = (const f32x4*)(SS + (size_t)row * 16); const f32x4 s0 = sp[0], s1 = sp[1], s2 = sp[2], s3 = sp[3];
                const float tot = ((s0[0] + s0[1]) + (s0[2] + s0[3])) + ((s1[0] + s1[1]) + (s1[2] + s1[3])) + ((s2[0] + s2[1]) + (s2[2] + s2[3])) + ((s3[0] + s3[1]) + (s3[2] + s3[3]));
                const float rs = 1.0f / sqrtf(tot * (1.0f / 1024.0f) + eps);
#pragma unroll
                for (int bj = 0; bj < 2; ++bj) { const f32x4 v0 = acc[ai][bj][m][0] * rs, v1 = acc[ai][bj][m][1] * rs;
                    u32x4 w; w.x = cvt_pk_bf16(v0[0], v0[1]); w.y = cvt_pk_bf16(v0[2], v0[3]); w.z = cvt_pk_bf16(v1[0], v1[1]); w.w = cvt_pk_bf16(v1[2], v1[3]);
                    *(u32x4*)(rowp + bj * HALF) = w; } }
    }
};

template <class Epi, class Sched, bool ALIGN_EPI = false, bool SP2 = false>
__device__ __forceinline__ void gemm_phase(PG8_LAS unsigned char* lds, const Gemm g, const Sched& S, const Epi& E) {
    const int tid = threadIdx.x, wid = __builtin_amdgcn_readfirstlane(tid >> 6), lane = tid & 63, wr = wid >> 2, wc = wid & 3, fr = lane & 15, fq = lane >> 4;
    const int K = g.K, nt = K / BK;
    unsigned voffA[2], voffB[2];
#pragma unroll
    for (int i = 0; i < 2; ++i) { int R, C; stage_rc(tid * 16 + i * 8192, R, C); const int Rb = Epi::PERM ? ((R & ~31) + perm32(R & 31)) : R;
        voffA[i] = (unsigned)(R * K + C) * 2u; voffB[i] = (unsigned)(Rb * K + C) * 2u; }
    const size_t kstep = (size_t)(BK * 2);
    const size_t hstep = (size_t)HALF * K * 2;
    const size_t tstep = 2 * hstep;
    const unsigned ldsw = (unsigned)wid * 1024u;
    const int aoff = lds_byte(wr * 64 + fr, fq * 8), boff = lds_byte(wc * 32 + fr, fq * 8);
#define PG8_SA(b, h) (((b) * 2 + (h)) * HTB)
#define PG8_SB(b, h) ((4 + (b) * 2 + (h)) * HTB)
#define PG8_STAGE(bufoff, gbase, voff) do { _Pragma("unroll") for (int _i = 0; _i < 2; ++_i) \
        __builtin_amdgcn_global_load_lds((const unsigned*)((const char*)(gbase) + (voff)[_i]), (PG8_LAS unsigned*)(lds + (bufoff) + ldsw + _i * 8192), 16, 0, 0); } while (0)
#define PG8_LDA(dst, b, h) do { _Pragma("unroll") for (int m = 0; m < 4; ++m) _Pragma("unroll") for (int k = 0; k < 2; ++k) dst[m][k] = *(const PG8_LAS bf16x8*)(lds + PG8_SA(b, h) + aoff + m * 2048 + k * 1024); } while (0)
#define PG8_LDB(dst, b, h) do { _Pragma("unroll") for (int n = 0; n < 2; ++n) _Pragma("unroll") for (int k = 0; k < 2; ++k) dst[n][k] = *(const PG8_LAS bf16x8*)(lds + PG8_SB(b, h) + boff + n * 2048 + k * 1024); } while (0)
#define PG8_MMA(ai, bj, At, Bt) do { __builtin_amdgcn_s_setprio(1); _Pragma("unroll") for (int m = 0; m < 4; ++m) _Pragma("unroll") for (int n = 0; n < 2; ++n) _Pragma("unroll") for (int k = 0; k < 2; ++k) \
        acc[ai][bj][m][n] = __builtin_amdgcn_mfma_f32_16x16x32_bf16(Bt[n][k], At[m][k], acc[ai][bj][m][n], 0, 0, 0); __builtin_amdgcn_s_setprio(0); } while (0)
#define PG8_WAIT_V(n) asm volatile("s_waitcnt vmcnt(" #n ")" ::: "memory")
#define PG8_WAIT_L(n) asm volatile("s_waitcnt lgkmcnt(" #n ")" ::: "memory")
#define PG8_BAR __builtin_amdgcn_s_barrier()
#define PG8_SCHED __builtin_amdgcn_sched_barrier(0)
    Unit cur, nxt; int ui = 0;
    if (!S.next(0, cur)) return;
    f32x4 acc[2][2][4][2];
#pragma unroll
    for (int a = 0; a < 2; ++a)
#pragma unroll
        for (int b = 0; b < 2; ++b)
#pragma unroll
            for (int m = 0; m < 4; ++m)
#pragma unroll
                for (int n = 0; n < 2; ++n) acc[a][b][m][n] = (f32x4){0.f, 0.f, 0.f, 0.f};
    bf16x8 At[4][2], B0[2][2], B1[2][2];
    const char* cA = (const char*)g.A + (size_t)cur.pm * tstep; const char* cB = (const char*)g.Bt + (size_t)cur.pn * tstep;
    S.a_ready(cur);
    if constexpr (SP2) {
        PG8_STAGE(PG8_SB(0, 0), cB, voffB); PG8_STAGE(PG8_SB(0, 1), cB + hstep, voffB); PG8_STAGE(PG8_SA(0, 0), cA, voffA); PG8_STAGE(PG8_SA(0, 1), cA + hstep, voffA);
        if (wr == 1) PG8_BAR;
        PG8_WAIT_V(2); PG8_BAR;
        PG8_STAGE(PG8_SB(1, 0), cB + kstep, voffB); PG8_STAGE(PG8_SA(1, 0), cA + kstep, voffA); PG8_STAGE(PG8_SB(1, 1), cB + hstep + kstep, voffB);
        PG8_WAIT_V(6); PG8_BAR;
    } else {
        PG8_STAGE(PG8_SB(0, 0), cB, voffB); PG8_STAGE(PG8_SA(0, 0), cA, voffA); PG8_STAGE(PG8_SB(0, 1), cB + hstep, voffB); PG8_STAGE(PG8_SA(0, 1), cA + hstep, voffA);
        if (wr == 1) PG8_BAR;
        PG8_WAIT_V(4); PG8_BAR;
        PG8_STAGE(PG8_SB(1, 0), cB + kstep, voffB); PG8_STAGE(PG8_SA(1, 0), cA + kstep, voffA); PG8_STAGE(PG8_SB(1, 1), cB + hstep + kstep, voffB);
        PG8_WAIT_V(6); PG8_BAR;
    }
    for (;;) {
        const bool has_next = S.next(ui + 1, nxt);
        const char* nA = has_next ? (const char*)g.A + (size_t)nxt.pm * tstep : cA; const char* nB = has_next ? (const char*)g.Bt + (size_t)nxt.pn * tstep : cB;
        for (int t = 0; t < nt; t += 2) {
            const bool last = (t == nt - 2);
            const char* a1 = cA + (size_t)(t + 1) * kstep;
            const char* a2 = last ? nA : cA + (size_t)(t + 2) * kstep; const char* b2 = last ? nB : cB + (size_t)(t + 2) * kstep;
            const char* a3 = a2 + kstep; const char* b3 = b2 + kstep;
            if (last && has_next) S.a_ready(nxt);
            if constexpr (SP2) {
            PG8_LDB(B0, 0, 0); PG8_LDB(B1, 0, 1); PG8_SCHED; PG8_LDA(At, 0, 0); PG8_STAGE(PG8_SA(1, 1), a1 + hstep, voffA);
            PG8_WAIT_V(8); PG8_WAIT_L(0); PG8_BAR; PG8_MMA(0, 0, At, B0); PG8_MMA(0, 1, At, B1); PG8_BAR; PG8_SCHED;
            PG8_LDA(At, 0, 1); PG8_STAGE(PG8_SB(0, 0), b2, voffB); PG8_STAGE(PG8_SB(0, 1), b2 + hstep, voffB); PG8_STAGE(PG8_SA(0, 0), a2, voffA);
            PG8_WAIT_V(8); PG8_WAIT_L(0); PG8_BAR; PG8_MMA(1, 0, At, B0); PG8_MMA(1, 1, At, B1); PG8_BAR; PG8_SCHED;
            PG8_LDB(B0, 1, 0); PG8_LDB(B1, 1, 1); PG8_SCHED; PG8_LDA(At, 1, 0); PG8_STAGE(PG8_SA(0, 1), a2 + hstep, voffA);
            PG8_WAIT_V(8); PG8_WAIT_L(0); PG8_BAR; PG8_MMA(0, 0, At, B0); PG8_MMA(0, 1, At, B1); PG8_BAR; PG8_SCHED;
            PG8_LDA(At, 1, 1); PG8_STAGE(PG8_SB(1, 0), b3, voffB); PG8_STAGE(PG8_SB(1, 1), b3 + hstep, voffB); PG8_STAGE(PG8_SA(1, 0), a3, voffA);
            PG8_WAIT_V(8); PG8_WAIT_L(0); PG8_BAR; PG8_MMA(1, 0, At, B0); PG8_MMA(1, 1, At, B1); PG8_BAR; PG8_SCHED;
            } else {
            PG8_LDB(B0, 0, 0); PG8_SCHED; PG8_LDA(At, 0, 0); PG8_STAGE(PG8_SA(1, 1), a1 + hstep, voffA);
            PG8_WAIT_L(8); PG8_BAR; PG8_WAIT_L(0); PG8_MMA(0, 0, At, B0); PG8_BAR; PG8_SCHED;
            PG8_LDB(B1, 0, 1); PG8_STAGE(PG8_SB(0, 0), b2, voffB);
            PG8_BAR; PG8_WAIT_L(0); PG8_MMA(0, 1, At, B1); PG8_BAR;
            PG8_LDA(At, 0, 1); PG8_STAGE(PG8_SA(0, 0), a2, voffA);
            PG8_BAR; PG8_WAIT_L(0); PG8_MMA(1, 0, At, B0); PG8_BAR; PG8_SCHED;
            PG8_STAGE(PG8_SB(0, 1), b2 + hstep, voffB);
            PG8_WAIT_V(6); PG8_BAR; PG8_MMA(1, 1, At, B1); PG8_BAR;
            PG8_LDB(B0, 1, 0); PG8_SCHED; PG8_LDA(At, 1, 0); PG8_STAGE(PG8_SA(0, 1), a2 + hstep, voffA);
            PG8_WAIT_L(8); PG8_BAR; PG8_WAIT_L(0); PG8_MMA(0, 0, At, B0); PG8_BAR; PG8_SCHED;
            PG8_LDB(B1, 1, 1); PG8_STAGE(PG8_SB(1, 0), b3, voffB);
            PG8_BAR; PG8_WAIT_L(0); PG8_MMA(0, 1, At, B1); PG8_BAR;
            PG8_LDA(At, 1, 1); PG8_STAGE(PG8_SA(1, 0), a3, voffA);
            PG8_BAR; PG8_WAIT_L(0); PG8_MMA(1, 0, At, B0); PG8_BAR; PG8_SCHED;
            PG8_STAGE(PG8_SB(1, 1), b3 + hstep, voffB);
            PG8_WAIT_V(6); PG8_BAR; PG8_MMA(1, 1, At, B1); PG8_BAR;
            }
        }
        if constexpr (ALIGN_EPI) { if (wr == 0) PG8_BAR; }
        if constexpr (!Epi::AFTER_DRAIN) { E(acc, cur, wr, wc, fr, fq); S.done(cur); }
        if (!has_next) break;
#pragma unroll
        for (int a = 0; a < 2; ++a)
#pragma unroll
            for (int b = 0; b < 2; ++b)
#pragma unroll
                for (int m = 0; m < 4; ++m)
#pragma unroll
                    for (int n = 0; n < 2; ++n) acc[a][b][m][n] = (f32x4){0.f, 0.f, 0.f, 0.f};
        cur = nxt; cA = nA; cB = nB; ++ui;
        if constexpr (ALIGN_EPI) { if (wr == 1) PG8_BAR; }
    }
    PG8_WAIT_V(0);
    if constexpr (!ALIGN_EPI) { if (wr == 0) PG8_BAR; }
    PG8_BAR;
    if constexpr (Epi::AFTER_DRAIN) { E.fused(acc, cur, wr, wc, fr, fq, lds, wid, lane); S.done(cur); }
#undef PG8_SA
#undef PG8_SB
#undef PG8_STAGE
#undef PG8_LDA
#undef PG8_LDB
#undef PG8_MMA
#undef PG8_WAIT_V
#undef PG8_WAIT_L
#undef PG8_BAR
#undef PG8_SCHED
}
}
#define GAS __attribute__((address_space(1)))
#define LAS __attribute__((address_space(3)))
typedef unsigned short bf16;
typedef unsigned v4u __attribute__((ext_vector_type(4)));
typedef float f32x4 __attribute__((ext_vector_type(4)));
typedef short bf16x8 __attribute__((ext_vector_type(8)));
typedef GAS unsigned gu32;
typedef GAS unsigned long long gu64;
#define RLX_AGENT __ATOMIC_RELAXED, __HIP_MEMORY_SCOPE_AGENT
#define LDS_WAIT() asm volatile("s_waitcnt lgkmcnt(0)" ::: "memory")
#define VM_WAIT() asm volatile("s_waitcnt vmcnt(0)" ::: "memory")
__device__ __forceinline__ unsigned long long rt() { return __builtin_amdgcn_s_memrealtime(); }
__device__ __forceinline__ unsigned f2bf(float f) { unsigned u = __builtin_bit_cast(unsigned, f); return (u + 0x7fffu + ((u >> 16) & 1u)) >> 16; }
__device__ __forceinline__ unsigned pk2(float lo, float hi) { return f2bf(lo) | (f2bf(hi) << 16); }

#define XB_TMO      128
#define XB_XCNT(j)  (256  + 64 * (j))
#define XB_XSUB(j)  (1280 + 64 * (j))
#define XB_XGEN(j)  (2304 + 64 * (j))
#define XB_TOP      3328
#define XB_TOPGEN   3392
#define XCD_BAR_WORDS 3456
#define XB_SPIN_CAP (1u << 18)

__device__ __forceinline__ unsigned xb_ld(unsigned* p)              { return __hip_atomic_load(p, __ATOMIC_RELAXED, __HIP_MEMORY_SCOPE_AGENT); }
__device__ __forceinline__ unsigned xb_add(unsigned* p, unsigned v) { return __hip_atomic_fetch_add(p, v, __ATOMIC_RELAXED, __HIP_MEMORY_SCOPE_AGENT); }
__device__ __forceinline__ unsigned xb_xcc_id() { return (unsigned)__builtin_amdgcn_s_getreg((3 << 11) | 20) & 0xFu; }
#define XB_SPIN(cond, bar) do { unsigned _sp = 0; while (cond) { __builtin_amdgcn_s_sleep(1); \
    if ((++_sp & 255u) == 0u) { if (xb_ld(&(bar)[XB_TMO])) break; if (_sp > XB_SPIN_CAP) { atomicAdd(&(bar)[XB_TMO], 1u); break; } } } } while (0)

struct XcdBarrier {
    unsigned* bar; unsigned x;
    volatile LAS unsigned* st;
};

__device__ __forceinline__ XcdBarrier xcd_barrier_post(unsigned* bar, volatile LAS unsigned* st) {
    XcdBarrier b; b.bar = bar; b.x = xb_xcc_id(); b.st = st;
    if (threadIdx.x == 0) (void)xb_add(&bar[XB_XCNT(b.x)], 1u);
    return b;
}
__device__ __forceinline__ void xcd_barrier_complete(unsigned* bar, unsigned x, unsigned& nloc, unsigned& nx) {
    const unsigned G = gridDim.x * gridDim.y * gridDim.z;
    unsigned sum, cnt, mine, sp = 0u;
    for (;;) {
        sum = 0u; cnt = 0u; mine = 0u;
#pragma unroll
        for (unsigned j = 0; j < 16; ++j) { const unsigned c = xb_ld(&bar[XB_XCNT(j)]); sum += c; cnt += (c > 0u) ? 1u : 0u; mine = (j == x) ? c : mine; }
        if (sum == G) break;
        __builtin_amdgcn_s_sleep(1);
        if ((++sp & 255u) == 0u) { if (xb_ld(&bar[XB_TMO])) break; if (sp > XB_SPIN_CAP) { atomicAdd(&bar[XB_TMO], 1u); break; } }
    }
    nloc = mine > 0u ? mine : 1u; nx = cnt > 0u ? cnt : 1u;
}

__device__ __forceinline__ void xcd_barrier(const XcdBarrier& b) {
    asm volatile("s_waitcnt vmcnt(0)" ::: "memory");
    __syncthreads();
    if (threadIdx.x == 0) {
        unsigned* bar = b.bar;
        __builtin_amdgcn_s_waitcnt(0);
        unsigned nloc = b.st[0], nx = b.st[1];
        if (nloc == 0u) { xcd_barrier_complete(bar, b.x, nloc, nx); b.st[0] = nloc; b.st[1] = nx; }
        const unsigned old = xb_add(&bar[XB_XSUB(b.x)], 1u);
        const unsigned gen = old / nloc;
        if (old + 1u == (gen + 1u) * nloc) {
            __builtin_amdgcn_fence(__ATOMIC_RELEASE, "agent");
            asm volatile("s_waitcnt vmcnt(0)" ::: "memory");
            const unsigned og = xb_add(&bar[XB_TOP], 1u);
            const unsigned tg = og / nx;
            if (og + 1u == (tg + 1u) * nx) xb_add(&bar[XB_TOPGEN], 1u);
            else XB_SPIN(xb_ld(&bar[XB_TOPGEN]) == tg, bar);
            __builtin_amdgcn_fence(__ATOMIC_ACQUIRE, "agent");
            xb_add(&bar[XB_XGEN(b.x)], 1u);
            asm volatile("s_waitcnt vmcnt(0)" ::: "memory");
        } else {
            XB_SPIN(xb_ld(&bar[XB_XGEN(b.x)]) == gen, bar);
            __builtin_amdgcn_fence(__ATOMIC_ACQUIRE, "agent");
            asm volatile("s_waitcnt vmcnt(0)" ::: "memory");
        }
    }
    __syncthreads();
}

constexpr int NWAVES = 8;
constexpr int BATCH = 16, SEQ = 2048, T = BATCH * SEQ, D = 1024, DIN = 2560, NMEM = 256, TM = BATCH * NMEM;
constexpr int DLRU = 512, LBLK = 8, LBD = 64;
constexpr int AH = 8, AD = 64, MOBA = 256, NB = SEQ / MOBA;
constexpr int CH = 4, CD = 256;
constexpr int PKEYS = 128, PHEADS = 8, PTOP = 16, PHALF = 128, PEXP = PHEADS * PTOP;
constexpr float EPS = 1e-6f;
constexpr int COL_LX = 0, COL_LG = 512, COL_Q = 1024, COL_K = 1536, COL_V = 2048;

constexpr size_t MiB = 1u << 20;
constexpr size_t WS_CTL = 0, CTL_ZERO_BYTES = 1 * MiB;
constexpr size_t WS_WIN = 2 * MiB, WS_WOUT = 7 * MiB, WS_WCQ = 9 * MiB, WS_WCKV = 11 * MiB, WS_WCO = 15 * MiB, WS_WPQ = 17 * MiB, WS_SUBK = 21 * MiB;
constexpr size_t WS_KMEAN = 23 * MiB;
constexpr size_t WS_MEMN = 24 * MiB;
constexpr size_t WS_KCVC = 32 * MiB;
constexpr size_t WS_SS1 = 48 * MiB, WS_SS2 = 50 * MiB;
constexpr size_t WS_IDS = 52 * MiB;
constexpr size_t WS_GATES = 60 * MiB;
constexpr size_t WS_A = 80 * MiB;
constexpr size_t WS_B = 144 * MiB;
constexpr size_t WS_C = 304 * MiB;
constexpr size_t WS_E = 368 * MiB;
constexpr size_t WS_END = 496 * MiB;
constexpr int CW_TMO = 0, CW_BAR = 4096;

constexpr int RING_OFF = 0, RING_BYTES = 131072;
constexpr int LDSCTL_OFF = RING_BYTES, MISC_OFF = LDSCTL_OFF + 320;
constexpr int LDS_BYTES = 147456;

__device__ __forceinline__ float bf2f(bf16 b) { return __uint_as_float(((unsigned)b) << 16); }
__device__ __forceinline__ float bflo(unsigned w) { return __uint_as_float(w << 16); }
__device__ __forceinline__ float bfhi(unsigned w) { return __uint_as_float(w & 0xffff0000u); }
__device__ __forceinline__ float wave_sum(float v) {
#pragma unroll
    for (int o = 1; o < 64; o <<= 1) v += __shfl_xor(v, o);
    return v;
}
__device__ __forceinline__ float wave_max(float v) {
#pragma unroll
    for (int o = 1; o < 64; o <<= 1) v = fmaxf(v, __shfl_xor(v, o));
    return v;
}
__device__ __forceinline__ unsigned wave_umax(unsigned v) {
#pragma unroll
    for (int o = 1; o < 64; o <<= 1) { const unsigned w = (unsigned)__shfl_xor((int)v, o); v = v > w ? v : w; }
    return v;
}
__device__ __forceinline__ float gelu_erf(float v) { return 0.5f * v * (1.0f + erff(v * 0.70710678118654752f)); }
__device__ __forceinline__ float sigmoidf_(float v) { return 1.0f / (1.0f + __expf(-v)); }
__device__ __forceinline__ unsigned ordf(float f) { const unsigned u = __float_as_uint(f); return (u & 0x80000000u) ? ~u : (u | 0x80000000u); }

struct Frame {
    LAS unsigned char* lds;
    volatile LAS unsigned* MISC;
    gu32* ctl;
    int tid, lane, wave, vcu, G;
    const float* in[26]; float* out; unsigned char* ws;
};

__device__ __forceinline__ void p0_transpose_item(const float* W, int K, int N, bf16* WT, int row_off, LAS float* scr, int item, int lane, const float* g0, const float* g1) {
    const int nblk = N / 32, kb = item / nblk, nb = item % nblk, k0 = 64 * kb, n0 = 32 * nb;
#pragma unroll 8
    for (int i = 0; i < 32; ++i) { const int kk = 2 * i + (lane >> 5); const int k = k0 + kk; float gv = 1.f; if (g0) gv = (k < 512) ? g0[k] : g1[k - 512];
        scr[kk * 33 + (lane & 31)] = W[(size_t)k * N + n0 + (lane & 31)] * gv; }
    LDS_WAIT(); asm volatile("" ::: "memory");
    const int c = lane & 7;
#pragma unroll
    for (int j = 0; j < 4; ++j) { const int n = (lane >> 3) + 8 * j; const LAS float* s = scr + (8 * c) * 33 + n;
        v4u o; o.x = pk2(s[0 * 33], s[1 * 33]); o.y = pk2(s[2 * 33], s[3 * 33]); o.z = pk2(s[4 * 33], s[5 * 33]); o.w = pk2(s[6 * 33], s[7 * 33]);
        *(GAS v4u*)(WT + (size_t)(row_off + n0 + n) * K + k0 + 8 * c) = o; }
    LDS_WAIT(); asm volatile("" ::: "memory");
}
__device__ __forceinline__ void rms_row_to_bf16(int lane, const float* xrow, const float* g, bf16* orow) {
    const GAS f32x4* xr = (const GAS f32x4*)xrow + lane; const GAS f32x4* gr = (const GAS f32x4*)g + lane;
    f32x4 v[4]; float s = 0.f;
#pragma unroll
    for (int j = 0; j < 4; ++j) { v[j] = xr[64 * j]; s += (v[j].x * v[j].x + v[j].y * v[j].y) + (v[j].z * v[j].z + v[j].w * v[j].w); }
    const float rs = 1.f / sqrtf(wave_sum(s) * (1.f / D) + EPS);
    GAS unsigned long long* o8 = (GAS unsigned long long*)orow + lane;
#pragma unroll
    for (int j = 0; j < 4; ++j) { const f32x4 gg = gr[64 * j]; o8[64 * j] = (unsigned long long)pk2(v[j].x * rs * gg.x, v[j].y * rs * gg.y) | ((unsigned long long)pk2(v[j].z * rs * gg.z, v[j].w * rs * gg.w) << 32); }
}
__device__ __forceinline__ void p0_prologue(Frame& F) {
    LAS float* scr = (LAS float*)(F.lds + RING_OFF + F.wave * 16384);
    const int gw = F.vcu * NWAVES + F.wave, NGW = F.G * NWAVES;
    bf16* Win_t = (bf16*)(F.ws + WS_WIN); bf16* Wout_t = (bf16*)(F.ws + WS_WOUT); bf16* Wcq_t = (bf16*)(F.ws + WS_WCQ); bf16* Wckv_t = (bf16*)(F.ws + WS_WCKV);
    bf16* Wco_t = (bf16*)(F.ws + WS_WCO); bf16* Wpq_t = (bf16*)(F.ws + WS_WPQ);
    constexpr int I_IN = (D / 64) * (DIN / 32), I_SQ = (D / 64) * (D / 32), I_PQ = (D / 64) * (2048 / 32);
    constexpr int NITEMS = I_IN + 5 * I_SQ + I_PQ;
    for (int it = gw; it < NITEMS; it += NGW) {
        int r = it;
        if (r < I_IN) { p0_transpose_item(F.in[3], D, DIN, Win_t, 0, scr, r, F.lane, nullptr, nullptr); continue; } r -= I_IN;
        if (r < I_SQ) { p0_transpose_item(F.in[13], D, D, Wout_t, 0, scr, r, F.lane, F.in[11], F.in[12]); continue; } r -= I_SQ;
        if (r < I_SQ) { p0_transpose_item(F.in[16], D, D, Wcq_t, 0, scr, r, F.lane, F.in[14], F.in[14] + 512); continue; } r -= I_SQ;
        if (r < I_SQ) { p0_transpose_item(F.in[17], D, D, Wckv_t, 0, scr, r, F.lane, nullptr, nullptr); continue; } r -= I_SQ;
        if (r < I_SQ) { p0_transpose_item(F.in[18], D, D, Wckv_t, D, scr, r, F.lane, nullptr, nullptr); continue; } r -= I_SQ;
        if (r < I_SQ) { p0_transpose_item(F.in[19], D, D, Wco_t, 0, scr, r, F.lane, nullptr, nullptr); continue; } r -= I_SQ;
        p0_transpose_item(F.in[21], D, 2048, Wpq_t, 0, scr, r, F.lane, F.in[20], F.in[20] + 512);
    }
    bf16* H = (bf16*)(F.ws + WS_A); bf16* MEMN = (bf16*)(F.ws + WS_MEMN);
    for (int m = gw; m < T; m += NGW) rms_row_to_bf16(F.lane, F.in[0] + (size_t)m * D, F.in[2], H + (size_t)m * D);
    for (int m = gw; m < TM; m += NGW) rms_row_to_bf16(F.lane, F.in[1] + (size_t)m * D, F.in[15], MEMN + (size_t)m * D);
    { bf16* SUBK = (bf16*)(F.ws + WS_SUBK); const float* sk = F.in[22]; const int gt = F.vcu * (NWAVES * 64) + F.tid, NGT = F.G * NWAVES * 64;
      for (int i = gt; i < PHEADS * 2 * PKEYS * PHALF / 4; i += NGT) { const f32x4 v = ((const GAS f32x4*)sk)[i]; ((GAS unsigned long long*)SUBK)[i] = (unsigned long long)pk2(v.x, v.y) | ((unsigned long long)pk2(v.z, v.w) << 32); } }
}

__device__ __forceinline__ void nv_lru_ab(Frame& F) {
    const bf16* PROJ = (const bf16*)(F.ws + WS_B); float* Aarr = (float*)(F.ws + WS_E); float* Barr = Aarr + (size_t)T * DLRU;
    const float* conv_w = F.in[4]; const float* conv_b = F.in[5]; const float* wa = F.in[6]; const float* ba = F.in[7]; const float* wx = F.in[8]; const float* bx = F.in[9]; const float* lam = F.in[10];
    const int gw = F.vcu * NWAVES + F.wave, NGW = F.G * NWAVES, e = F.lane;
    for (int it = gw; it < T * LBLK; it += NGW) {
        const int t = it / LBLK, n = it % LBLK, c = n * LBD + e, s = t % SEQ;
        float xb = conv_b[c];
#pragma unroll
        for (int k = 0; k < 4; ++k) { const int sp = s - 3 + k; if (sp >= 0) xb += conv_w[k * DLRU + c] * bf2f(PROJ[(size_t)(t - 3 + k) * DIN + COL_LX + c]); }
        float r = 0.f, ii = 0.f;
        for (int d = 0; d < LBD; ++d) { const float xd = __shfl(xb, d); r += xd * wa[(size_t)(n * LBD + d) * LBD + e]; ii += xd * wx[(size_t)(n * LBD + d) * LBD + e]; }
        const float gr = sigmoidf_(r + ba[c]), gi = sigmoidf_(ii + bx[c]);
        const float sp_ = log1pf(expf(-lam[c]));
        const float log_a = -8.0f * gr * sp_;
        const float a = expf(log_a), bb = sqrtf(-expm1f(2.0f * log_a)) * (gi * xb);
        Aarr[(size_t)t * DLRU + c] = a; Barr[(size_t)t * DLRU + c] = bb;
    }
}
__device__ __forceinline__ void nv_kmean(Frame& F) {
    const bf16* PROJ = (const bf16*)(F.ws + WS_B); float* KM = (float*)(F.ws + WS_KMEAN);
    const int gw = F.vcu * NWAVES + F.wave, NGW = F.G * NWAVES;
    for (int it = gw; it < BATCH * AH * NB; it += NGW) {
        const int n = it % NB, h = (it / NB) % AH, b = it / (NB * AH); float s = 0.f;
        for (int r = 0; r < MOBA; ++r) s += bf2f(PROJ[(size_t)(b * SEQ + n * MOBA + r) * DIN + COL_K + h * AD + F.lane]);
        KM[(size_t)it * AD + F.lane] = s * (1.0f / MOBA);
    }
}
__device__ __forceinline__ void nv_lru_scan(Frame& F) {
    const bf16* PROJ = (const bf16*)(F.ws + WS_B); const float* Aarr = (const float*)(F.ws + WS_E); const float* Barr = Aarr + (size_t)T * DLRU;
    bf16* MIXED = (bf16*)(F.ws + WS_C); LAS float* ex = (LAS float*)(F.lds + RING_OFF);
    for (int it = F.vcu; it < BATCH * LBLK; it += F.G) {
        const int b = it / LBLK, n = it % LBLK, c = n * LBD + F.lane, t0 = b * SEQ + F.wave * 256;
        float Ac = 1.f, Bc = 0.f;
        for (int i = 0; i < 256; ++i) { const float a = Aarr[(size_t)(t0 + i) * DLRU + c], bb = Barr[(size_t)(t0 + i) * DLRU + c]; Ac *= a; Bc = a * Bc + bb; }
        ex[(F.wave * 64 + F.lane) * 2] = Ac; ex[(F.wave * 64 + F.lane) * 2 + 1] = Bc;
        __syncthreads();
        float h = 0.f;
        for (int w = 0; w < F.wave; ++w) h = ex[(w * 64 + F.lane) * 2] * h + ex[(w * 64 + F.lane) * 2 + 1];
        for (int i = 0; i < 256; ++i) { const size_t t = (size_t)(t0 + i); const float a = Aarr[t * DLRU + c], bb = Barr[t * DLRU + c]; h = a * h + bb;
            const float gt = bf2f(PROJ[t * DIN + COL_LG + c]); MIXED[t * D + c] = (bf16)f2bf(h * gelu_erf(gt)); }
        __syncthreads();
    }
}
__device__ __forceinline__ void nv_moba(Frame& F) {
    const bf16* PROJ = (const bf16*)(F.ws + WS_B); const float* KM = (const float*)(F.ws + WS_KMEAN); bf16* MIXED = (bf16*)(F.ws + WS_C);
    const int gw = F.vcu * NWAVES + F.wave, NGW = F.G * NWAVES, lane = F.lane;
    for (int it = gw; it < BATCH * AH * SEQ; it += NGW) {
        const int s = it % SEQ, h = (it / SEQ) % AH, b = it / (SEQ * AH), j = s / MOBA; const size_t trow = (size_t)(b * SEQ + s);
        const float qv = bf2f(PROJ[trow * DIN + COL_Q + h * AD + lane]);
        unsigned sel = 0u;
        if (j <= 3) sel = (1u << j) - 1u;
        else { float gate[NB];
#pragma unroll
            for (int n = 0; n < NB; ++n) gate[n] = (n < j) ? wave_sum(qv * KM[((size_t)(b * AH + h) * NB + n) * AD + lane]) : -3.0e38f;
            for (int k = 0; k < 3; ++k) { float best = -3.0e38f; int bi = 0;
#pragma unroll
                for (int n = 0; n < NB; ++n) { const bool take = (n < j) && !((sel >> n) & 1u) && gate[n] > best; best = take ? gate[n] : best; bi = take ? n : bi; }
                sel |= 1u << bi; } }
        sel |= 1u << j;
        float m = -3.0e38f, l = 0.f, o = 0.f;
        for (int n = 0; n <= j; ++n) { if (!((sel >> n) & 1u)) continue;
            for (int sub = 0; sub < 4; ++sub) { const int kk = n * MOBA + sub * 64 + lane; if (n == j && sub * 64 + n * MOBA > s) break;
                const uint4* kp = (const uint4*)(PROJ + (size_t)(b * SEQ + kk) * DIN + COL_K + h * AD); float sc = 0.f;
#pragma unroll
                for (int c8 = 0; c8 < 8; ++c8) { const uint4 kv = kp[c8];
                    sc += __shfl(qv, c8 * 8 + 0) * bflo(kv.x) + __shfl(qv, c8 * 8 + 1) * bfhi(kv.x) + __shfl(qv, c8 * 8 + 2) * bflo(kv.y) + __shfl(qv, c8 * 8 + 3) * bfhi(kv.y)
                        + __shfl(qv, c8 * 8 + 4) * bflo(kv.z) + __shfl(qv, c8 * 8 + 5) * bfhi(kv.z) + __shfl(qv, c8 * 8 + 6) * bflo(kv.w) + __shfl(qv, c8 * 8 + 7) * bfhi(kv.w); }
                sc *= 0.125f; const bool valid = (kk <= s); if (!valid) sc = -3.0e38f;
                const float mn = fmaxf(m, wave_max(sc)); const float alpha = __expf(m - mn); const float p = valid ? __expf(sc - mn) : 0.f;
                l = l * alpha + wave_sum(p); o *= alpha; m = mn;
                const bf16* vp = PROJ + (size_t)(b * SEQ + n * MOBA + sub * 64) * DIN + COL_V + h * AD + lane;
                for (int i = 0; i < 64; ++i) o += __shfl(p, i) * bf2f(vp[(size_t)i * DIN]);
            } }
        MIXED[trow * D + DLRU + h * AD + lane] = (bf16)f2bf(o / l);
    }
}
__device__ __forceinline__ void nv_groupnorm(Frame& F) {
    bf16* MIXED = (bf16*)(F.ws + WS_C); const int gw = F.vcu * NWAVES + F.wave, NGW = F.G * NWAVES;
    for (int t = gw; t < T; t += NGW) { uint4* rp = (uint4*)(MIXED + (size_t)t * D) + F.lane;
#pragma unroll
        for (int half = 0; half < 2; ++half) { const uint4 v = rp[64 * half]; float x[8] = {bflo(v.x), bfhi(v.x), bflo(v.y), bfhi(v.y), bflo(v.z), bfhi(v.z), bflo(v.w), bfhi(v.w)}; float ss = 0.f;
#pragma unroll
            for (int i = 0; i < 8; ++i) ss += x[i] * x[i];
            const float rs = 1.f / sqrtf(wave_sum(ss) * (1.f / 512.f) + EPS);
            uint4 o; o.x = pk2(x[0] * rs, x[1] * rs); o.y = pk2(x[2] * rs, x[3] * rs); o.z = pk2(x[4] * rs, x[5] * rs); o.w = pk2(x[6] * rs, x[7] * rs); rp[64 * half] = o; } }
}
__device__ __forceinline__ void nv_cross(Frame& F) {
    const bf16* QC = (const bf16*)(F.ws + WS_B); const bf16* KCVC = (const bf16*)(F.ws + WS_KCVC); bf16* OC = (bf16*)(F.ws + WS_B + 64 * MiB);
    LAS float* qs = (LAS float*)(F.lds + RING_OFF) + F.wave * 256;
    const int gw = F.vcu * NWAVES + F.wave, NGW = F.G * NWAVES, lane = F.lane;
    for (int it = gw; it < T * CH; it += NGW) {
        const int t = it / CH, hd = it % CH, b = t / SEQ;
        { const uint2 qv = *(const uint2*)(QC + (size_t)t * D + hd * CD + 4 * lane); qs[4 * lane] = bflo(qv.x); qs[4 * lane + 1] = bfhi(qv.x); qs[4 * lane + 2] = bflo(qv.y); qs[4 * lane + 3] = bfhi(qv.y); }
        LDS_WAIT(); asm volatile("" ::: "memory");
        float sc[4];
#pragma unroll
        for (int i = 0; i < 4; ++i) { const uint4* kp = (const uint4*)(KCVC + (size_t)(b * NMEM + lane + 64 * i) * 2048 + hd * CD); float a = 0.f;
            for (int c8 = 0; c8 < 32; ++c8) { const uint4 kv = kp[c8]; const LAS float* q8 = qs + 8 * c8;
                a += q8[0] * bflo(kv.x) + q8[1] * bfhi(kv.x) + q8[2] * bflo(kv.y) + q8[3] * bfhi(kv.y) + q8[4] * bflo(kv.z) + q8[5] * bfhi(kv.z) + q8[6] * bflo(kv.w) + q8[7] * bfhi(kv.w); }
            sc[i] = a * 0.0625f; }
        const float mx = wave_max(fmaxf(fmaxf(sc[0], sc[1]), fmaxf(sc[2], sc[3])));
        float p[4]; float ls = 0.f;
#pragma unroll
        for (int i = 0; i < 4; ++i) { p[i] = __expf(sc[i] - mx); ls += p[i]; }
        const float linv = 1.0f / wave_sum(ls);
        float o0 = 0.f, o1 = 0.f, o2 = 0.f, o3 = 0.f;
#pragma unroll
        for (int i = 0; i < 4; ++i)
            for (int src = 0; src < 64; ++src) { const float pm = __shfl(p[i], src); const uint2 vv = *(const uint2*)(KCVC + (size_t)(b * NMEM + src + 64 * i) * 2048 + 1024 + hd * CD + 4 * lane);
                o0 += pm * bflo(vv.x); o1 += pm * bfhi(vv.x); o2 += pm * bflo(vv.y); o3 += pm * bfhi(vv.y); }
        uint2 ov; ov.x = pk2(o0 * linv, o1 * linv); ov.y = pk2(o2 * linv, o3 * linv);
        *(uint2*)(OC + (size_t)t * D + hd * CD + 4 * lane) = ov;
        LDS_WAIT(); asm volatile("" ::: "memory");
    }
}
__device__ __forceinline__ void nv_route(Frame& F) {
    const bf16* PQ = (const bf16*)(F.ws + WS_E); const bf16* SUBK = (const bf16*)(F.ws + WS_SUBK); unsigned short* IDS = (unsigned short*)(F.ws + WS_IDS); float* GATES = (float*)(F.ws + WS_GATES);
    LAS float* ws_ = (LAS float*)(F.lds + RING_OFF) + F.wave * 512;
    const int gw = F.vcu * NWAVES + F.wave, NGW = F.G * NWAVES, lane = F.lane;
    for (int it = gw; it < T * PHEADS; it += NGW) {
        const int t = it / PHEADS, h = it % PHEADS;
        { const uint2 qv = *(const uint2*)(PQ + (size_t)t * 2048 + h * 256 + 4 * lane); ws_[4 * lane] = bflo(qv.x); ws_[4 * lane + 1] = bfhi(qv.x); ws_[4 * lane + 2] = bflo(qv.y); ws_[4 * lane + 3] = bfhi(qv.y); }
        LDS_WAIT(); asm volatile("" ::: "memory");
#pragma unroll
        for (int p = 0; p < 2; ++p) {
            float v[2];
#pragma unroll
            for (int i = 0; i < 2; ++i) { const int n = lane + 64 * i; const uint4* kp = (const uint4*)(SUBK + ((size_t)(h * 2 + p) * PKEYS + n) * PHALF); float a = 0.f;
                for (int c8 = 0; c8 < 16; ++c8) { const uint4 kv = kp[c8]; const LAS float* q8 = ws_ + p * 128 + 8 * c8;
                    a += q8[0] * bflo(kv.x) + q8[1] * bfhi(kv.x) + q8[2] * bflo(kv.y) + q8[3] * bfhi(kv.y) + q8[4] * bflo(kv.z) + q8[5] * bfhi(kv.z) + q8[6] * bflo(kv.w) + q8[7] * bfhi(kv.w); }
                v[i] = a; }
            unsigned k0 = (ordf(v[0]) & ~0x7Fu) | (unsigned)(127 - lane), k1 = (ordf(v[1]) & ~0x7Fu) | (unsigned)(127 - (lane + 64));
            for (int k = 0; k < PTOP; ++k) { const unsigned best = wave_umax(k0 > k1 ? k0 : k1); const int n = 127 - (int)(best & 0x7Fu);
                const float e0 = __shfl(v[0], n & 63), e1 = __shfl(v[1], n & 63); const float ev = (n >> 6) ? e1 : e0;
                if (lane == 0) { ws_[256 + p * 16 + k] = ev; ws_[288 + p * 16 + k] = __int_as_float(n); }
                if (lane == (n & 63)) { if (n >> 6) k1 = 0u; else k0 = 0u; } }
        }
        LDS_WAIT(); asm volatile("" ::: "memory");
        float cs[4]; unsigned ck[4]; const int ci = lane >> 2;
#pragma unroll
        for (int r = 0; r < 4; ++r) { const int cj = 4 * (lane & 3) + r; cs[r] = ws_[256 + ci] + ws_[256 + 16 + cj]; ck[r] = (ordf(cs[r]) & ~0xFFu) | (unsigned)(255 - (ci * 16 + cj)); }
        float bs = 0.f; int bid = 0; float mxs = 0.f;
        for (int k = 0; k < PTOP; ++k) { unsigned loc = ck[0] > ck[1] ? ck[0] : ck[1]; const unsigned loc2 = ck[2] > ck[3] ? ck[2] : ck[3]; loc = loc > loc2 ? loc : loc2;
            const unsigned best = wave_umax(loc); const int pos = 255 - (int)(best & 0xFFu); const int pi = pos >> 4, pj = pos & 15;
            const float sv = ws_[256 + pi] + ws_[256 + 16 + pj]; const int id = __float_as_int(ws_[288 + pi]) * PKEYS + __float_as_int(ws_[288 + 16 + pj]);
            if (k == 0) mxs = sv;
            if (lane == k) { bs = sv; bid = id; }
            if (lane == (pos >> 2)) {
#pragma unroll
                for (int r = 0; r < 4; ++r) if ((pos & 3) == r) ck[r] = 0u; } }
        const float pe = (lane < PTOP) ? __expf(bs - mxs) : 0.f; const float den = wave_sum(pe);
        if (lane < PTOP) { IDS[(size_t)t * PEXP + h * PTOP + lane] = (unsigned short)bid; GATES[(size_t)t * PEXP + h * PTOP + lane] = pe / den; }
        LDS_WAIT(); asm volatile("" ::: "memory");
    }
}
__device__ __forceinline__ void nv_peer(Frame& F) {
    const bf16* X2 = (const bf16*)(F.ws + WS_C); const float* SS2 = (const float*)(F.ws + WS_SS2); const unsigned short* IDS = (const unsigned short*)(F.ws + WS_IDS); const float* GATES = (const float*)(F.ws + WS_GATES);
    const float* gf = F.in[20]; const float* U = F.in[23]; const float* V = F.in[24]; const float* gfin = F.in[25];
    const int gw = F.vcu * NWAVES + F.wave, NGW = F.G * NWAVES, lane = F.lane;
    for (int t = gw; t < T; t += NGW) {
        float x2[16], xn[16], y[16];
        float tot = 0.f; { const f32x4* sp = (const f32x4*)(SS2 + (size_t)t * 16); for (int i = 0; i < 4; ++i) { const f32x4 s = sp[i]; tot += (s[0] + s[1]) + (s[2] + s[3]); } }
        const float rs2 = 1.f / sqrtf(tot * (1.f / D) + EPS);
#pragma unroll
        for (int i = 0; i < 4; ++i) { const uint2 v = *(const uint2*)(X2 + (size_t)t * D + 256 * i + 4 * lane); const f32x4 g = *(const f32x4*)(gf + 256 * i + 4 * lane);
            x2[4 * i] = bflo(v.x); x2[4 * i + 1] = bfhi(v.x); x2[4 * i + 2] = bflo(v.y); x2[4 * i + 3] = bfhi(v.y);
            xn[4 * i] = x2[4 * i] * rs2 * g[0]; xn[4 * i + 1] = x2[4 * i + 1] * rs2 * g[1]; xn[4 * i + 2] = x2[4 * i + 2] * rs2 * g[2]; xn[4 * i + 3] = x2[4 * i + 3] * rs2 * g[3]; }
#pragma unroll
        for (int i = 0; i < 16; ++i) y[i] = 0.f;
        for (int e = 0; e < PEXP; ++e) { const int id = IDS[(size_t)t * PEXP + e]; const float gt = GATES[(size_t)t * PEXP + e];
            const float* ur = U + (size_t)id * D + 4 * lane; const float* vr = V + (size_t)id * D + 4 * lane; float dt = 0.f;
#pragma unroll
            for (int i = 0; i < 4; ++i) { const f32x4 uu = *(const f32x4*)(ur + 256 * i); dt += xn[4 * i] * uu[0] + xn[4 * i + 1] * uu[1] + xn[4 * i + 2] * uu[2] + xn[4 * i + 3] * uu[3]; }
            const float w = gt * gelu_erf(wave_sum(dt));
#pragma unroll
            for (int i = 0; i < 4; ++i) { const f32x4 vv = *(const f32x4*)(vr + 256 * i); y[4 * i] += w * vv[0]; y[4 * i + 1] += w * vv[1]; y[4 * i + 2] += w * vv[2]; y[4 * i + 3] += w * vv[3]; } }
        float ss = 0.f;
#pragma unroll
        for (int i = 0; i < 16; ++i) { y[i] += x2[i]; ss += y[i] * y[i]; }
        const float rs3 = 1.f / sqrtf(wave_sum(ss) * (1.f / D) + EPS);
#pragma unroll
        for (int i = 0; i < 4; ++i) { const f32x4 g = *(const f32x4*)(gfin + 256 * i + 4 * lane); f32x4 o; o[0] = y[4 * i] * rs3 * g[0]; o[1] = y[4 * i + 1] * rs3 * g[1]; o[2] = y[4 * i + 2] * rs3 * g[2]; o[3] = y[4 * i + 3] * rs3 * g[3];
            *(f32x4*)(F.out + (size_t)t * D + 256 * i + 4 * lane) = o; }
    }
}

constexpr int NPHASE = 12;
#ifndef MK_ONE_LAUNCH
#define MK_ONE_LAUNCH 0
#endif
struct Args { const float* in[26]; float* out; unsigned char* ws; int ph_lo, ph_hi; };
__global__ void __launch_bounds__(NWAVES * 64, 2) mk_fwd(Args args) {
    extern __shared__ __attribute__((aligned(16))) unsigned char lds[];
    Frame F;
    F.lds = (LAS unsigned char*)lds;
    F.MISC = (volatile LAS unsigned*)(F.lds + MISC_OFF);
    F.tid = threadIdx.x; F.lane = F.tid & 63; F.wave = __builtin_amdgcn_readfirstlane(F.tid >> 6);
    F.G = gridDim.x; { const int bx = blockIdx.x; F.vcu = (F.G % 8 == 0) ? (bx % 8) * (F.G / 8) + bx / 8 : bx; }
    F.ws = args.ws; F.out = args.out; F.ctl = (gu32*)(args.ws + WS_CTL);
#pragma unroll
    for (int i = 0; i < 26; ++i) F.in[i] = args.in[i];
    for (int u = F.tid; u < (LDS_BYTES - LDSCTL_OFF) / 4; u += NWAVES * 64) ((LAS unsigned*)(F.lds + LDSCTL_OFF))[u] = 0u;
    __syncthreads();
    const int lo = args.ph_lo, hi = args.ph_hi;
    XcdBarrier bar; bar.bar = (unsigned*)(F.ctl + CW_BAR); bar.x = 0; bar.st = nullptr;
    if (hi - lo > 1) bar = xcd_barrier_post((unsigned*)(F.ctl + CW_BAR), F.MISC + 8);
#define IN(k) (lo <= (k) && (k) < hi)
#define SEAM(k) do { if (IN(k) && IN((k) + 1)) xcd_barrier(bar); } while (0)
    bf16* Win_t = (bf16*)(F.ws + WS_WIN); bf16* Wout_t = (bf16*)(F.ws + WS_WOUT); bf16* Wcq_t = (bf16*)(F.ws + WS_WCQ); bf16* Wckv_t = (bf16*)(F.ws + WS_WCKV);
    bf16* Wco_t = (bf16*)(F.ws + WS_WCO); bf16* Wpq_t = (bf16*)(F.ws + WS_WPQ);
    bf16* H = (bf16*)(F.ws + WS_A); bf16* X1 = (bf16*)(F.ws + WS_A); bf16* PROJ = (bf16*)(F.ws + WS_B); bf16* QC = (bf16*)(F.ws + WS_B); bf16* OC = (bf16*)(F.ws + WS_B + 64 * MiB);
    bf16* MIXED = (bf16*)(F.ws + WS_C); bf16* X2 = (bf16*)(F.ws + WS_C); bf16* MEMN = (bf16*)(F.ws + WS_MEMN); bf16* KCVC = (bf16*)(F.ws + WS_KCVC); bf16* PQ = (bf16*)(F.ws + WS_E);
    float* SS1 = (float*)(F.ws + WS_SS1); float* SS2 = (float*)(F.ws + WS_SS2);

    if (IN(0)) { p0_prologue(F); SEAM(0); }
    if (IN(1)) {
        { pg8::Gemm g{H, Win_t, T, DIN, D}; pg8::StaticOrder S; S.init(T, DIN, F.G, (int)blockIdx.x); pg8::EpiStore E{PROJ, DIN};
          pg8::gemm_phase<pg8::EpiStore, pg8::StaticOrder, true, true>(F.lds + RING_OFF, g, S, E); }
        { pg8::Gemm g{MEMN, Wckv_t, TM, 2048, D}; pg8::StaticOrder S; S.init(TM, 2048, F.G, (int)blockIdx.x); pg8::EpiStore E{KCVC, 2048};
          pg8::gemm_phase<pg8::EpiStore, pg8::StaticOrder, true, true>(F.lds + RING_OFF, g, S, E); }
        SEAM(1);
    }
    if (IN(2)) { nv_lru_ab(F); nv_kmean(F); SEAM(2); }
    if (IN(3)) { nv_lru_scan(F); nv_moba(F); SEAM(3); }
    if (IN(4)) { nv_groupnorm(F); SEAM(4); }
    if (IN(5)) { pg8::Gemm g{MIXED, Wout_t, T, D, D}; pg8::StaticOrder S; S.init(T, D, F.G, (int)blockIdx.x); pg8::EpiResid E{F.in[0], nullptr, X1, SS1, D};
        pg8::gemm_phase<pg8::EpiResid, pg8::StaticOrder, true, true>(F.lds + RING_OFF, g, S, E); SEAM(5); }
    if (IN(6)) { pg8::Gemm g{X1, Wcq_t, T, D, D}; pg8::StaticOrder S; S.init(T, D, F.G, (int)blockIdx.x); pg8::EpiScale E{SS1, QC, D, EPS};
        pg8::gemm_phase<pg8::EpiScale, pg8::StaticOrder, true, true>(F.lds + RING_OFF, g, S, E); SEAM(6); }
    if (IN(7)) { nv_cross(F); SEAM(7); }
    if (IN(8)) { pg8::Gemm g{OC, Wco_t, T, D, D}; pg8::StaticOrder S; S.init(T, D, F.G, (int)blockIdx.x); pg8::EpiResid E{nullptr, X1, X2, SS2, D};
        pg8::gemm_phase<pg8::EpiResid, pg8::StaticOrder, true, true>(F.lds + RING_OFF, g, S, E); SEAM(8); }
    if (IN(9)) { pg8::Gemm g{X2, Wpq_t, T, 2048, D}; pg8::StaticOrder S; S.init(T, 2048, F.G, (int)blockIdx.x); pg8::EpiScale E{SS2, PQ, 2048, EPS};
        pg8::gemm_phase<pg8::EpiScale, pg8::StaticOrder, true, true>(F.lds + RING_OFF, g, S, E); SEAM(9); }
    if (IN(10)) { nv_route(F); SEAM(10); }
    if (IN(11)) { nv_peer(F); }
#undef IN
#undef SEAM
}

extern "C" void kernel_launch(void* const* d_in, const int* in_sizes, int n_in, void* d_out, int out_size, void* d_ws, size_t ws_size, hipStream_t stream) {
    static int grid = 0;
    if (grid == 0) {
        if (n_in != 26 || in_sizes[0] != T * D || out_size != T * D || ws_size < WS_END) { fprintf(stderr, "kernel_launch: unexpected shapes (n_in %d, in0 %d, out %d, ws %zu); nothing launched\n", n_in, n_in > 0 ? in_sizes[0] : -1, out_size, ws_size); grid = -1; return; }
        int dev = 0, cus = 0, per_cu = 0;
        if (hipGetDevice(&dev) != hipSuccess || hipDeviceGetAttribute(&cus, hipDeviceAttributeMultiprocessorCount, dev) != hipSuccess) { grid = -1; return; }
        if (hipFuncSetAttribute((const void*)mk_fwd, hipFuncAttributeMaxDynamicSharedMemorySize, LDS_BYTES) != hipSuccess) { fprintf(stderr, "kernel_launch: hipFuncSetAttribute failed\n"); grid = -1; return; }
        if (hipOccupancyMaxActiveBlocksPerMultiprocessor(&per_cu, (const void*)mk_fwd, NWAVES * 64, LDS_BYTES) != hipSuccess || per_cu < 1) fprintf(stderr, "kernel_launch: occupancy query reports %d\n", per_cu);
        (void)hipGetLastError();
        grid = cus;
    }
    if (grid < 0) return;
    (void)hipMemsetAsync((char*)d_ws + WS_CTL, 0, CTL_ZERO_BYTES, stream);
    Args a{};
    for (int i = 0; i < 26; ++i) a.in[i] = (const float*)d_in[i];
    a.out = (float*)d_out; a.ws = (unsigned char*)d_ws;
#if MK_ONE_LAUNCH
    a.ph_lo = 0; a.ph_hi = NPHASE;
    hipLaunchKernelGGL(mk_fwd, dim3(grid), dim3(NWAVES * 64), LDS_BYTES, stream, a);
#else
    for (int p = 0; p < NPHASE; ++p) { a.ph_lo = p; a.ph_hi = p + 1; hipLaunchKernelGGL(mk_fwd, dim3(grid), dim3(NWAVES * 64), LDS_BYTES, stream, a); }
#endif
}
```

```cpp
#include <hip/hip_runtime.h>
#include <cstdio>
#include <cstdint>
namespace pg8 {
#define PG8_LAS __attribute__((address_space(3)))
typedef unsigned short bf16_t;
typedef short bf16x8 __attribute__((ext_vector_type(8)));
typedef float f32x4 __attribute__((ext_vector_type(4)));
typedef unsigned u32x4 __attribute__((ext_vector_type(4)));
constexpr int BM = 256, BK = 64, HALF = 128, HTB = HALF * BK * 2  , STAGE_BYTES = 8 * HTB, NXCD = 8, WGM = 8;

__host__ __device__ __forceinline__ int lds_byte(int r, int c) { const int st = (r >> 4) * 2 + (c >> 5), rr = r & 15, cc = c & 31, ob = rr * 64 + cc * 2; return st * 1024 + (ob ^ (((ob >> 9) & 1) << 5)); }
__host__ __device__ __forceinline__ void stage_rc(int b, int& R, int& C) { const int st = b / 1024, sb = b % 1024, swz = sb ^ (((sb >> 9) & 1) << 5); R = (st >> 1) * 16 + swz / 64; C = (st & 1) * 32 + (swz % 64) / 2; }
__host__ __device__ __forceinline__ int perm32(int rho) { const int n = rho >> 4, i = rho & 15; return 8 * (i >> 2) + 4 * n + (i & 3); }

struct Unit { int pm, pn; };
struct Gemm { const bf16_t* A; const bf16_t* Bt; int M, N, K; };

struct StaticOrder {
    int nM, nN, nwg, G, c;
    __host__ __device__ __forceinline__ void init(int M, int N, int G_, int c_) { nM = M / BM; nN = N / BM; nwg = nM * nN; G = G_; c = c_; }
    __host__ __device__ __forceinline__ bool next(int i, Unit& u) const {
        const long L = (long)i * G + c; if (L >= nwg) return false;
        int wgid = (int)L; { const int q = nwg / NXCD, r = nwg % NXCD, xcd = wgid % NXCD, off = wgid / NXCD; wgid = (xcd < r ? xcd * (q + 1) : r * (q + 1) + (xcd - r) * q) + off; }
        const int nig = WGM * nN, gid = wgid / nig, fm = gid * WGM, gsz = (nM - fm) < WGM ? (nM - fm) : WGM;
        u.pm = fm + ((wgid % nig) % gsz); u.pn = (wgid % nig) / gsz; return true;
    }
    __device__ __forceinline__ void a_ready(const Unit&) const {}
    __device__ __forceinline__ void done(const Unit&) const {}
};
struct OneUnit { int pm, pn; bool have;
    __device__ __forceinline__ bool next(int i, Unit& u) const { if (i != 0 || !have) return false; u.pm = pm; u.pn = pn; return true; }
    __device__ __forceinline__ void a_ready(const Unit&) const {}
    __device__ __forceinline__ void done(const Unit&) const {}
};
__device__ __forceinline__ unsigned cvt_pk_bf16(float lo, float hi) { unsigned r; asm volatile("v_cvt_pk_bf16_f32 %0, %1, %2" : "=v"(r) : "v"(lo), "v"(hi)); return r; }
typedef float f32x2 __attribute__((ext_vector_type(2)));
template <int CTRL> __device__ __forceinline__ float dppf(float x) { return __int_as_float(__builtin_amdgcn_update_dpp(0, __float_as_int(x), CTRL, 0xf, 0xf, true)); }
struct EpiStore {
    static constexpr bool PERM = true, AFTER_DRAIN = false, MIDK = false;
    bf16_t* O; int ldc; int slo, shi; float scale; float* KMP;
    __device__ __forceinline__ void operator()(const f32x4 (&acc)[2][2][4][2], const Unit& u, int wr, int wc, int fr, int fq) const {
        const int row0 = u.pm * BM + wr * 64 + fr, col0 = u.pn * BM + wc * 32 + 8 * fq; const float sc = (u.pn >= slo && u.pn < shi) ? scale : 1.0f;
#pragma unroll
        for (int ai = 0; ai < 2; ++ai)
#pragma unroll
            for (int m = 0; m < 4; ++m) { bf16_t* rowp = O + (size_t)(row0 + ai * HALF + m * 16) * ldc + col0;
#pragma unroll
                for (int bj = 0; bj < 2; ++bj) { const f32x4 v0 = acc[ai][bj][m][0] * sc, v1 = acc[ai][bj][m][1] * sc;
                    u32x4 w; w.x = cvt_pk_bf16(v0[0], v0[1]); w.y = cvt_pk_bf16(v0[2], v0[3]); w.z = cvt_pk_bf16(v1[0], v1[1]); w.w = cvt_pk_bf16(v1[2], v1[3]);
                    *(u32x4*)(rowp + bj * HALF) = w; } }
        if (KMP != nullptr && (u.pn == 6 || u.pn == 7)) {
            float cs[16];
#pragma unroll
            for (int bj = 0; bj < 2; ++bj)
#pragma unroll
                for (int n = 0; n < 2; ++n)
#pragma unroll
                    for (int e = 0; e < 4; ++e) { float a = 0.f;
#pragma unroll
                        for (int ai = 0; ai < 2; ++ai)
#pragma unroll
                            for (int m = 0; m < 4; ++m) a += acc[ai][bj][m][n][e];
                        cs[bj * 8 + n * 4 + e] = a; }
            const bool b3 = (fr & 8) != 0, b2 = (fr & 4) != 0, b1 = (fr & 2) != 0, b0 = (fr & 1) != 0; float r8[8], r4[4], r2[2], r1;
#pragma unroll
            for (int i = 0; i < 8; ++i) { const float sa = cs[i] + dppf<0x128>(cs[i]), sb = cs[i + 8] + dppf<0x128>(cs[i + 8]); r8[i] = b3 ? sb : sa; }
#pragma unroll
            for (int i = 0; i < 4; ++i) { const float sa = r8[i] + dppf<0x141>(r8[i]), sb = r8[i + 4] + dppf<0x141>(r8[i + 4]); r4[i] = b2 ? sb : sa; }
#pragma unroll
            for (int i = 0; i < 2; ++i) { const float sa = r4[i] + dppf<0x4E>(r4[i]), sb = r4[i + 2] + dppf<0x4E>(r4[i + 2]); r2[i] = b1 ? sb : sa; }
            { const float sa = r2[0] + dppf<0xB1>(r2[0]), sb = r2[1] + dppf<0xB1>(r2[1]); r1 = b0 ? sb : sa; }
            const int cg = (u.pn - 6) * 256 + 128 * (fr >> 3) + 32 * wc + 8 * fq + (fr & 7);
            KMP[((((size_t)wr * 16 + (u.pm >> 3)) * 8 + (cg >> 6)) * 8 + (u.pm & 7)) * 64 + (cg & 63)] = r1;
        }
    }
};
__device__ __forceinline__ float bfl(unsigned w) { return __uint_as_float(w << 16); }
__device__ __forceinline__ float bfh(unsigned w) { return __uint_as_float(w & 0xffff0000u); }
struct EpiResid {
    static constexpr bool PERM = true, AFTER_DRAIN = false, MIDK = false;
    const float* resf; const bf16_t* resb; bf16_t* O; float* SS; int ldc;
    __device__ __forceinline__ void operator()(const f32x4 (&acc)[2][2][4][2], const Unit& u, int wr, int wc, int fr, int fq) const {
        const int row0 = u.pm * BM + wr * 64 + fr, col0 = u.pn * BM + wc * 32 + 8 * fq;
#pragma unroll
        for (int ai = 0; ai < 2; ++ai)
#pragma unroll
            for (int m = 0; m < 4; ++m) { const int row = row0 + ai * HALF + m * 16; const size_t off = (size_t)row * ldc + col0; float ss = 0.f;
#pragma unroll
                for (int bj = 0; bj < 2; ++bj) { f32x4 v0 = acc[ai][bj][m][0], v1 = acc[ai][bj][m][1];
                    if (resf) { const f32x4 r0 = *(const f32x4*)(resf + off + bj * HALF), r1 = *(const f32x4*)(resf + off + bj * HALF + 4); v0 = v0 + r0; v1 = v1 + r1; }
                    else { const u32x4 r = *(const u32x4*)(resb + off + bj * HALF);
                        v0[0] += bfl(r.x); v0[1] += bfh(r.x); v0[2] += bfl(r.y); v0[3] += bfh(r.y); v1[0] += bfl(r.z); v1[1] += bfh(r.z); v1[2] += bfl(r.w); v1[3] += bfh(r.w); }
                    ss += (v0[0] * v0[0] + v0[1] * v0[1]) + (v0[2] * v0[2] + v0[3] * v0[3]) + (v1[0] * v1[0] + v1[1] * v1[1]) + (v1[2] * v1[2] + v1[3] * v1[3]);
                    u32x4 w; w.x = cvt_pk_bf16(v0[0], v0[1]); w.y = cvt_pk_bf16(v0[2], v0[3]); w.z = cvt_pk_bf16(v1[0], v1[1]); w.w = cvt_pk_bf16(v1[2], v1[3]);
                    *(u32x4*)(O + off + bj * HALF) = w; }
                ss += __shfl_xor(ss, 16); ss += __shfl_xor(ss, 32);
                if (fq == 0) SS[(size_t)row * 16 + u.pn * 4 + wc] = ss; }
    }
};
struct EpiScale {
    static constexpr bool PERM = true, AFTER_DRAIN = false, MIDK = false;
    const float* SS; bf16_t* O; int ldc; float eps;
    __device__ __forceinline__ void operator()(const f32x4 (&acc)[2][2][4][2], const Unit& u, int wr, int wc, int fr, int fq) const {
        const int row0 = u.pm * BM + wr * 64 + fr, col0 = u.pn * BM + wc * 32 + 8 * fq;
#pragma unroll
        for (int ai = 0; ai < 2; ++ai)
#pragma unroll
            for (int m = 0; m < 4; ++m) { const int row = row0 + ai * HALF + m * 16; bf16_t* rowp = O + (size_t)row * ldc + col0;
                const f32x4* sp = (const f32x4*)(SS + (size_t)row * 16); const f32x4 s0 = sp[0], s1 = sp[1], s2 = sp[2], s3 = sp[3];
                const float tot = ((s0[0] + s0[1]) + (s0[2] + s0[3])) + ((s1[0] + s1[1]) + (s1[2] + s1[3])) + ((s2[0] + s2[1]) + (s2[2] + s2[3])) + ((s3[0] + s3[1]) + (s3[2] + s3[3]));
                const float rs = 1.0f / sqrtf(tot * (1.0f / 1024.0f) + eps);
#pragma unroll
                for (int bj = 0; bj < 2; ++bj) { const f32x4 v0 = acc[ai][bj][m][0] * rs, v1 = acc[ai][bj][m][1] * rs;
                    u32x4 w; w.x = cvt_pk_bf16(v0[0], v0[1]); w.y = cvt_pk_bf16(v0[2], v0[3]); w.z = cvt_pk_bf16(v1[0], v1[1]); w.w = cvt_pk_bf16(v1[2], v1[3]);
                    *(u32x4*)(rowp + bj * HALF) = w; } }
    }
};

struct EpiResidGN {
    static constexpr bool PERM = true, AFTER_DRAIN = false, MIDK = true;
    const float* resf; bf16_t* O; float* SS; const float* SSL; const float* SSA; int ldc; float eps;
    __device__ __forceinline__ float rsum8(const float* p) const { const f32x4 a = *(const f32x4*)p, b = *(const f32x4*)(p + 4); return ((a[0] + a[1]) + (a[2] + a[3])) + ((b[0] + b[1]) + (b[2] + b[3])); }
    __device__ __forceinline__ void mid(f32x4 (&acc)[2][2][4][2], const Unit& u, int wr, int wc, int fr, int fq) const {
        int row0 = u.pm * BM + wr * 64 + fr; asm volatile("" : "+v"(row0));
#pragma unroll
        for (int ai = 0; ai < 2; ++ai)
#pragma unroll
            for (int m = 0; m < 4; ++m) { const int row = row0 + ai * HALF + m * 16;
                const float rl = 1.0f / sqrtf(rsum8(SSL + (size_t)row * 8) * (1.0f / 512.0f) + eps), rh = 1.0f / sqrtf(rsum8(SSA + (size_t)row * 8) * (1.0f / 512.0f) + eps); const float ratio = rl / rh;
#pragma unroll
                for (int bj = 0; bj < 2; ++bj) { acc[ai][bj][m][0] = acc[ai][bj][m][0] * ratio; acc[ai][bj][m][1] = acc[ai][bj][m][1] * ratio; }
                asm volatile("" ::: "memory"); }
    }
    __device__ __forceinline__ void operator()(const f32x4 (&acc)[2][2][4][2], const Unit& u, int wr, int wc, int fr, int fq) const {
        int row0 = u.pm * BM + wr * 64 + fr; asm volatile("" : "+v"(row0)); const int col0 = u.pn * BM + wc * 32 + 8 * fq;
#pragma unroll
        for (int ai = 0; ai < 2; ++ai)
#pragma unroll
            for (int m = 0; m < 4; ++m) { const int row = row0 + ai * HALF + m * 16; const size_t off = (size_t)row * ldc + col0; float ss = 0.f;
                const float rh = 1.0f / sqrtf(rsum8(SSA + (size_t)row * 8) * (1.0f / 512.0f) + eps);
#pragma unroll
                for (int bj = 0; bj < 2; ++bj) { const f32x4 r0 = *(const f32x4*)(resf + off + bj * HALF), r1 = *(const f32x4*)(resf + off + bj * HALF + 4);
                    const f32x4 v0 = acc[ai][bj][m][0] * rh + r0, v1 = acc[ai][bj][m][1] * rh + r1;
                    ss += (v0[0] * v0[0] + v0[1] * v0[1]) + (v0[2] * v0[2] + v0[3] * v0[3]) + (v1[0] * v1[0] + v1[1] * v1[1]) + (v1[2] * v1[2] + v1[3] * v1[3]);
                    u32x4 w; w.x = cvt_pk_bf16(v0[0], v0[1]); w.y = cvt_pk_bf16(v0[2], v0[3]); w.z = cvt_pk_bf16(v1[0], v1[1]); w.w = cvt_pk_bf16(v1[2], v1[3]);
                    *(u32x4*)(O + off + bj * HALF) = w; }
                ss += __shfl_xor(ss, 16); ss += __shfl_xor(ss, 32);
                if (fq == 0) SS[(size_t)row * 16 + u.pn * 4 + wc] = ss; }
    }
};

template <class Epi, class Sched, bool ALIGN_EPI = false, bool SP2 = false>
__device__ __forceinline__ void gemm_phase(PG8_LAS unsigned char* lds, const Gemm g, const Sched& S, const Epi& E) {
    const int tid = threadIdx.x, wid = __builtin_amdgcn_readfirstlane(tid >> 6), lane = tid & 63, wr = wid >> 2, wc = wid & 3, fr = lane & 15, fq = lane >> 4;
    const int K = g.K, nt = K / BK;
    unsigned voffA[2], voffB[2];
#pragma unroll
    for (int i = 0; i < 2; ++i) { int R, C; stage_rc(tid * 16 + i * 8192, R, C); const int Rb = Epi::PERM ? ((R & ~31) + perm32(R & 31)) : R;
        voffA[i] = (unsigned)(R * K + C) * 2u; voffB[i] = (unsigned)(Rb * K + C) * 2u; }
    const size_t kstep = (size_t)(BK * 2);
    const size_t hstep = (size_t)HALF * K * 2;
    const size_t tstep = 2 * hstep;
    const unsigned ldsw = (unsigned)wid * 1024u;
    const int aoff = lds_byte(wr * 64 + fr, fq * 8), boff = lds_byte(wc * 32 + fr, fq * 8);
#define PG8_SA(b, h) (((b) * 2 + (h)) * HTB)
#define PG8_SB(b, h) ((4 + (b) * 2 + (h)) * HTB)
#define PG8_STAGE(bufoff, gbase, voff) do { _Pragma("unroll") for (int _i = 0; _i < 2; ++_i) \
        __builtin_amdgcn_global_load_lds((const unsigned*)((const char*)(gbase) + (voff)[_i]), (PG8_LAS unsigned*)(lds + (bufoff) + ldsw + _i * 8192), 16, 0, 0); } while (0)
#define PG8_LDA(dst, b, h) do { _Pragma("unroll") for (int m = 0; m < 4; ++m) _Pragma("unroll") for (int k = 0; k < 2; ++k) dst[m][k] = *(const PG8_LAS bf16x8*)(lds + PG8_SA(b, h) + aoff + m * 2048 + k * 1024); } while (0)
#define PG8_LDB(dst, b, h) do { _Pragma("unroll") for (int n = 0; n < 2; ++n) _Pragma("unroll") for (int k = 0; k < 2; ++k) dst[n][k] = *(const PG8_LAS bf16x8*)(lds + PG8_SB(b, h) + boff + n * 2048 + k * 1024); } while (0)
#define PG8_MMA(ai, bj, At, Bt) do { __builtin_amdgcn_s_setprio(1); _Pragma("unroll") for (int m = 0; m < 4; ++m) _Pragma("unroll") for (int n = 0; n < 2; ++n) _Pragma("unroll") for (int k = 0; k < 2; ++k) \
        acc[ai][bj][m][n] = __builtin_amdgcn_mfma_f32_16x16x32_bf16(Bt[n][k], At[m][k], acc[ai][bj][m][n], 0, 0, 0); __builtin_amdgcn_s_setprio(0); } while (0)
#define PG8_WAIT_V(n) asm volatile("s_waitcnt vmcnt(" #n ")" ::: "memory")
#define PG8_WAIT_L(n) asm volatile("s_waitcnt lgkmcnt(" #n ")" ::: "memory")
#define PG8_BAR __builtin_amdgcn_s_barrier()
#define PG8_SCHED __builtin_amdgcn_sched_barrier(0)
    Unit cur, nxt; int ui = 0;
    if (!S.next(0, cur)) return;
    f32x4 acc[2][2][4][2];
#pragma unroll
    for (int a = 0; a < 2; ++a)
#pragma unroll
        for (int b = 0; b < 2; ++b)
#pragma unroll
            for (int m = 0; m < 4; ++m)
#pragma unroll
                for (int n = 0; n < 2; ++n) acc[a][b][m][n] = (f32x4){0.f, 0.f, 0.f, 0.f};
    bf16x8 At[4][2], B0[2][2], B1[2][2];
    const char* cA = (const char*)g.A + (size_t)cur.pm * tstep; const char* cB = (const char*)g.Bt + (size_t)cur.pn * tstep;
    S.a_ready(cur);
    if constexpr (SP2) {
        PG8_STAGE(PG8_SB(0, 0), cB, voffB); PG8_STAGE(PG8_SB(0, 1), cB + hstep, voffB); PG8_STAGE(PG8_SA(0, 0), cA, voffA); PG8_STAGE(PG8_SA(0, 1), cA + hstep, voffA);
        if (wr == 1) PG8_BAR;
        PG8_WAIT_V(2); PG8_BAR;
        PG8_STAGE(PG8_SB(1, 0), cB + kstep, voffB); PG8_STAGE(PG8_SA(1, 0), cA + kstep, voffA); PG8_STAGE(PG8_SB(1, 1), cB + hstep + kstep, voffB);
        PG8_WAIT_V(6); PG8_BAR;
    } else {
        PG8_STAGE(PG8_SB(0, 0), cB, voffB); PG8_STAGE(PG8_SA(0, 0), cA, voffA); PG8_STAGE(PG8_SB(0, 1), cB + hstep, voffB); PG8_STAGE(PG8_SA(0, 1), cA + hstep, voffA);
        if (wr == 1) PG8_BAR;
        PG8_WAIT_V(4); PG8_BAR;
        PG8_STAGE(PG8_SB(1, 0), cB + kstep, voffB); PG8_STAGE(PG8_SA(1, 0), cA + kstep, voffA); PG8_STAGE(PG8_SB(1, 1), cB + hstep + kstep, voffB);
        PG8_WAIT_V(6); PG8_BAR;
    }
    for (;;) {
        const bool has_next = S.next(ui + 1, nxt);
        const char* nA = has_next ? (const char*)g.A + (size_t)nxt.pm * tstep : cA; const char* nB = has_next ? (const char*)g.Bt + (size_t)nxt.pn * tstep : cB;
        for (int t = 0; t < nt; t += 2) {
            const bool last = (t == nt - 2);
            const char* a1 = cA + (size_t)(t + 1) * kstep;
            const char* a2 = last ? nA : cA + (size_t)(t + 2) * kstep; const char* b2 = last ? nB : cB + (size_t)(t + 2) * kstep;
            const char* a3 = a2 + kstep; const char* b3 = b2 + kstep;
            if constexpr (Epi::MIDK) { if (t == (nt >> 1)) E.mid(acc, cur, wr, wc, fr, fq); }
            if (last && has_next) S.a_ready(nxt);
            if constexpr (SP2) {
            PG8_LDB(B0, 0, 0); PG8_LDB(B1, 0, 1); PG8_SCHED; PG8_LDA(At, 0, 0); PG8_STAGE(PG8_SA(1, 1), a1 + hstep, voffA);
            PG8_WAIT_V(8); PG8_WAIT_L(0); PG8_BAR; PG8_MMA(0, 0, At, B0); PG8_MMA(0, 1, At, B1); PG8_BAR; PG8_SCHED;
            PG8_LDA(At, 0, 1); PG8_STAGE(PG8_SB(0, 0), b2, voffB); PG8_STAGE(PG8_SB(0, 1), b2 + hstep, voffB); PG8_STAGE(PG8_SA(0, 0), a2, voffA);
            PG8_WAIT_V(8); PG8_WAIT_L(0); PG8_BAR; PG8_MMA(1, 0, At, B0); PG8_MMA(1, 1, At, B1); PG8_BAR; PG8_SCHED;
            PG8_LDB(B0, 1, 0); PG8_LDB(B1, 1, 1); PG8_SCHED; PG8_LDA(At, 1, 0); PG8_STAGE(PG8_SA(0, 1), a2 + hstep, voffA);
            PG8_WAIT_V(8); PG8_WAIT_L(0); PG8_BAR; PG8_MMA(0, 0, At, B0); PG8_MMA(0, 1, At, B1); PG8_BAR; PG8_SCHED;
            PG8_LDA(At, 1, 1); PG8_STAGE(PG8_SB(1, 0), b3, voffB); PG8_STAGE(PG8_SB(1, 1), b3 + hstep, voffB); PG8_STAGE(PG8_SA(1, 0), a3, voffA);
            PG8_WAIT_V(8); PG8_WAIT_L(0); PG8_BAR; PG8_MMA(1, 0, At, B0); PG8_MMA(1, 1, At, B1); PG8_BAR; PG8_SCHED;
            } else {
            PG8_LDB(B0, 0, 0); PG8_SCHED; PG8_LDA(At, 0, 0); PG8_STAGE(PG8_SA(1, 1), a1 + hstep, voffA);
            PG8_WAIT_L(8); PG8_BAR; PG8_WAIT_L(0); PG8_MMA(0, 0, At, B0); PG8_BAR; PG8_SCHED;
            PG8_LDB(B1, 0, 1); PG8_STAGE(PG8_SB(0, 0), b2, voffB);
            PG8_BAR; PG8_WAIT_L(0); PG8_MMA(0, 1, At, B1); PG8_BAR;
            PG8_LDA(At, 0, 1); PG8_STAGE(PG8_SA(0, 0), a2, voffA);
            PG8_BAR; PG8_WAIT_L(0); PG8_MMA(1, 0, At, B0); PG8_BAR; PG8_SCHED;
            PG8_STAGE(PG8_SB(0, 1), b2 + hstep, voffB);
            PG8_WAIT_V(6); PG8_BAR; PG8_MMA(1, 1, At, B1); PG8_BAR;
            PG8_LDB(B0, 1, 0); PG8_SCHED; PG8_LDA(At, 1, 0); PG8_STAGE(PG8_SA(0, 1), a2 + hstep, voffA);
            PG8_WAIT_L(8); PG8_BAR; PG8_WAIT_L(0); PG8_MMA(0, 0, At, B0); PG8_BAR; PG8_SCHED;
            PG8_LDB(B1, 1, 1); PG8_STAGE(PG8_SB(1, 0), b3, voffB);
            PG8_BAR; PG8_WAIT_L(0); PG8_MMA(0, 1, At, B1); PG8_BAR;
            PG8_LDA(At, 1, 1); PG8_STAGE(PG8_SA(1, 0), a3, voffA);
            PG8_BAR; PG8_WAIT_L(0); PG8_MMA(1, 0, At, B0); PG8_BAR; PG8_SCHED;
            PG8_STAGE(PG8_SB(1, 1), b3 + hstep, voffB);
            PG8_WAIT_V(6); PG8_BAR; PG8_MMA(1, 1, At, B1); PG8_BAR;
            }
        }
        if constexpr (ALIGN_EPI) { if (wr == 0) PG8_BAR; }
        if constexpr (!Epi::AFTER_DRAIN) { E(acc, cur, wr, wc, fr, fq); S.done(cur); }
        if (!has_next) break;
#pragma unroll
        for (int a = 0; a < 2; ++a)
#pragma unroll
            for (int b = 0; b < 2; ++b)
#pragma unroll
                for (int m = 0; m < 4; ++m)
#pragma unroll
                    for (int n = 0; n < 2; ++n) acc[a][b][m][n] = (f32x4){0.f, 0.f, 0.f, 0.f};
        cur = nxt; cA = nA; cB = nB; ++ui;
        if constexpr (ALIGN_EPI) { if (wr == 1) PG8_BAR; }
    }
    PG8_WAIT_V(0);
    if constexpr (!ALIGN_EPI) { if (wr == 0) PG8_BAR; }
    PG8_BAR;
    if constexpr (Epi::AFTER_DRAIN) { E.fused(acc, cur, wr, wc, fr, fq, lds, wid, lane); S.done(cur); }
#undef PG8_SA
#undef PG8_SB
#undef PG8_STAGE
#undef PG8_LDA
#undef PG8_LDB
#undef PG8_MMA
#undef PG8_WAIT_V
#undef PG8_WAIT_L
#undef PG8_BAR
#undef PG8_SCHED
}
}
#define GAS __attribute__((address_space(1)))
#define LAS __attribute__((address_space(3)))
typedef unsigned short bf16;
typedef unsigned v4u __attribute__((ext_vector_type(4)));
typedef float f32x4 __attribute__((ext_vector_type(4)));
typedef short bf16x8 __attribute__((ext_vector_type(8)));
typedef GAS unsigned gu32;
typedef GAS unsigned long long gu64;
#define RLX_AGENT __ATOMIC_RELAXED, __HIP_MEMORY_SCOPE_AGENT
#define LDS_WAIT() asm volatile("s_waitcnt lgkmcnt(0)" ::: "memory")
#define VM_WAIT() asm volatile("s_waitcnt vmcnt(0)" ::: "memory")
__device__ __forceinline__ unsigned long long rt() { return __builtin_amdgcn_s_memrealtime(); }
__device__ __forceinline__ unsigned f2bf(float f) { unsigned u = __builtin_bit_cast(unsigned, f); return (u + 0x7fffu + ((u >> 16) & 1u)) >> 16; }
__device__ __forceinline__ unsigned pk2(float lo, float hi) { return f2bf(lo) | (f2bf(hi) << 16); }

#define XB_TMO      128
#define XB_XCNT(j)  (256  + 64 * (j))
#define XB_XSUB(j)  (1280 + 64 * (j))
#define XB_XGEN(j)  (2304 + 64 * (j))
#define XB_TOP      3328
#define XB_TOPGEN   3392
#define XCD_BAR_WORDS 3456
#define XB_SPIN_CAP (1u << 18)

__device__ __forceinline__ unsigned xb_ld(unsigned* p)              { return __hip_atomic_load(p, __ATOMIC_RELAXED, __HIP_MEMORY_SCOPE_AGENT); }
__device__ __forceinline__ unsigned xb_add(unsigned* p, unsigned v) { return __hip_atomic_fetch_add(p, v, __ATOMIC_RELAXED, __HIP_MEMORY_SCOPE_AGENT); }
__device__ __forceinline__ unsigned xb_xcc_id() { return (unsigned)__builtin_amdgcn_s_getreg((3 << 11) | 20) & 0xFu; }
#define XB_SPIN(cond, bar) do { unsigned _sp = 0; while (cond) { __builtin_amdgcn_s_sleep(1); \
    if ((++_sp & 255u) == 0u) { if (xb_ld(&(bar)[XB_TMO])) break; if (_sp > XB_SPIN_CAP) { atomicAdd(&(bar)[XB_TMO], 1u); break; } } } } while (0)

struct XcdBarrier {
    unsigned* bar; unsigned x;
    volatile LAS unsigned* st;
};

__device__ __forceinline__ XcdBarrier xcd_barrier_post(unsigned* bar, volatile LAS unsigned* st) {
    XcdBarrier b; b.bar = bar; b.x = xb_xcc_id(); b.st = st;
    if (threadIdx.x == 0) { const unsigned r_ = xb_add(&bar[XB_XCNT(b.x)], 1u); st[2] = r_; st[3] = b.x; }
    return b;
}
__device__ __forceinline__ void xcd_barrier_complete(unsigned* bar, unsigned x, unsigned& nloc, unsigned& nx) {
    const unsigned G = gridDim.x * gridDim.y * gridDim.z;
    unsigned sum, cnt, mine, sp = 0u;
    for (;;) {
        sum = 0u; cnt = 0u; mine = 0u;
#pragma unroll
        for (unsigned j = 0; j < 16; ++j) { const unsigned c = xb_ld(&bar[XB_XCNT(j)]); sum += c; cnt += (c > 0u) ? 1u : 0u; mine = (j == x) ? c : mine; }
        if (sum == G) break;
        __builtin_amdgcn_s_sleep(1);
        if ((++sp & 255u) == 0u) { if (xb_ld(&bar[XB_TMO])) break; if (sp > XB_SPIN_CAP) { atomicAdd(&bar[XB_TMO], 1u); break; } }
    }
    nloc = mine > 0u ? mine : 1u; nx = cnt > 0u ? cnt : 1u;
}

__device__ __forceinline__ void xcd_barrier(const XcdBarrier& b) {
    asm volatile("s_waitcnt vmcnt(0)" ::: "memory");
    __syncthreads();
    if (threadIdx.x == 0) {
        unsigned* bar = b.bar;
        __builtin_amdgcn_s_waitcnt(0);
        unsigned nloc = b.st[0], nx = b.st[1];
        if (nloc == 0u) { xcd_barrier_complete(bar, b.x, nloc, nx); b.st[0] = nloc; b.st[1] = nx; }
        const unsigned old = xb_add(&bar[XB_XSUB(b.x)], 1u);
        const unsigned gen = old / nloc;
        if (old + 1u == (gen + 1u) * nloc) {
            __builtin_amdgcn_fence(__ATOMIC_RELEASE, "agent");
            asm volatile("s_waitcnt vmcnt(0)" ::: "memory");
            const unsigned og = xb_add(&bar[XB_TOP], 1u);
            const unsigned tg = og / nx;
            if (og + 1u == (tg + 1u) * nx) xb_add(&bar[XB_TOPGEN], 1u);
            else XB_SPIN(xb_ld(&bar[XB_TOPGEN]) == tg, bar);
            __builtin_amdgcn_fence(__ATOMIC_ACQUIRE, "agent");
            xb_add(&bar[XB_XGEN(b.x)], 1u);
            asm volatile("s_waitcnt vmcnt(0)" ::: "memory");
        } else {
            XB_SPIN(xb_ld(&bar[XB_XGEN(b.x)]) == gen, bar);
            __builtin_amdgcn_fence(__ATOMIC_ACQUIRE, "agent");
            asm volatile("s_waitcnt vmcnt(0)" ::: "memory");
        }
    }
    __syncthreads();
}

constexpr int NWAVES = 8;
constexpr int BATCH = 16, SEQ = 2048, T = BATCH * SEQ, D = 1024, DIN = 2560, NMEM = 256, TM = BATCH * NMEM;
constexpr int DLRU = 512, LBLK = 8, LBD = 64;
constexpr int AH = 8, AD = 64, MOBA = 256, NB = SEQ / MOBA;
constexpr int CH = 4, CD = 256;
constexpr int PKEYS = 128, PHEADS = 8, PTOP = 16, PHALF = 128, PEXP = PHEADS * PTOP;
constexpr float EPS = 1e-6f;
constexpr int COL_LX = 0, COL_LG = 512, COL_Q = 1024, COL_K = 1536, COL_V = 2048;

constexpr size_t MiB = 1u << 20;
constexpr size_t WS_CTL = 0, CTL_ZERO_BYTES = 64 * 1024;
constexpr size_t WS_WIN = 2 * MiB, WS_WOUT = 7 * MiB, WS_WCQ = 9 * MiB, WS_WCKV = 11 * MiB, WS_WCO = 15 * MiB, WS_WPQ = 17 * MiB, WS_SUBK = 21 * MiB;
constexpr size_t WS_KMEAN = 23 * MiB;
constexpr size_t WS_MEMN = 24 * MiB;
constexpr size_t WS_KCVC = 32 * MiB;
constexpr size_t WS_SS1 = 48 * MiB, WS_SS2 = 50 * MiB;
constexpr size_t WS_IDS = 52 * MiB;
constexpr size_t WS_GATES = 60 * MiB;
constexpr size_t WS_A = 80 * MiB;
constexpr size_t WS_B = 144 * MiB;
constexpr size_t WS_C = 304 * MiB;
constexpr size_t WS_E = 368 * MiB;
constexpr size_t WS_SU = 76 * MiB;
constexpr size_t WS_SS3 = 77 * MiB;
constexpr size_t WS_HS = 78 * MiB;
constexpr size_t WS_SSL = 79 * MiB, WS_SSA = 22 * MiB;
constexpr size_t WS_XQ = 144 * MiB;
constexpr size_t WS_VQ = 272 * MiB;
constexpr size_t WS_ACTW = 288 * MiB;
constexpr size_t WS_UQ = 496 * MiB;
constexpr size_t WS_END = 512 * MiB;
constexpr int XQ_LD = 2048;
constexpr int CW_TMO = 0, CW_BAR = 4096, CW_QUAD = 8192  , CW_XID = 12288  , CW_G32 = 12800  , CW_WCNT = 13312  ;

constexpr int RING_OFF = 0, RING_BYTES = 131072;
constexpr int STREAM_OFF = 81920, STREAM_WAVE_BYTES = 8192;
constexpr int LDSCTL_OFF = 155648, MISC_OFF = LDSCTL_OFF + 320;
constexpr int LDS_BYTES = 163840;

__device__ __forceinline__ float bf2f(bf16 b) { return __uint_as_float(((unsigned)b) << 16); }
__device__ __forceinline__ float bflo(unsigned w) { return __uint_as_float(w << 16); }
__device__ __forceinline__ float bfhi(unsigned w) { return __uint_as_float(w & 0xffff0000u); }
__device__ __forceinline__ float wave_sum(float v) {
#pragma unroll
    for (int o = 1; o < 64; o <<= 1) v += __shfl_xor(v, o);
    return v;
}
__device__ __forceinline__ float wave_max(float v) {
#pragma unroll
    for (int o = 1; o < 64; o <<= 1) v = fmaxf(v, __shfl_xor(v, o));
    return v;
}
__device__ __forceinline__ unsigned wave_umax(unsigned v) {
#pragma unroll
    for (int o = 1; o < 64; o <<= 1) { const unsigned w = (unsigned)__shfl_xor((int)v, o); v = v > w ? v : w; }
    return v;
}
__device__ __forceinline__ float gelu_erf(float v) { return 0.5f * v * (1.0f + erff(v * 0.70710678118654752f)); }
__device__ __forceinline__ float sigmoidf_(float v) { return 1.0f / (1.0f + __expf(-v)); }
__device__ __forceinline__ unsigned ordf(float f) { const unsigned u = __float_as_uint(f); return (u & 0x80000000u) ? ~u : (u | 0x80000000u); }

struct Frame {
    LAS unsigned char* lds;
    volatile LAS unsigned* MISC;
    gu32* ctl;
    int tid, lane, wave, vcu, G;
    const float* in[26]; float* out; unsigned char* ws;
};

__device__ __forceinline__ void p0_transpose_item(const float* W, int K, int N, bf16* WT, int row_off, LAS float* scr, int item, int lane, const float* g0, const float* g1) {
    const int nblk = N / 32, kb = item / nblk, nb = item % nblk, k0 = 64 * kb, n0 = 32 * nb;
#pragma unroll 8
    for (int i = 0; i < 32; ++i) { const int kk = 2 * i + (lane >> 5); const int k = k0 + kk; float gv = 1.f; if (g0) gv = (k < 512) ? g0[k] : g1[k - 512];
        scr[kk * 33 + (lane & 31)] = W[(size_t)k * N + n0 + (lane & 31)] * gv; }
    LDS_WAIT(); asm volatile("" ::: "memory");
    const int c = lane & 7;
#pragma unroll
    for (int j = 0; j < 4; ++j) { const int n = (lane >> 3) + 8 * j; const LAS float* s = scr + (8 * c) * 33 + n;
        v4u o; o.x = pk2(s[0 * 33], s[1 * 33]); o.y = pk2(s[2 * 33], s[3 * 33]); o.z = pk2(s[4 * 33], s[5 * 33]); o.w = pk2(s[6 * 33], s[7 * 33]);
        *(GAS v4u*)(WT + (size_t)(row_off + n0 + n) * K + k0 + 8 * c) = o; }
    LDS_WAIT(); asm volatile("" ::: "memory");
}
template <int R> __device__ __forceinline__ void rms_rows_to_bf16(int lane, const float* xrow, const float* g, bf16* orow) {
    f32x4 v[R][4]; float s[R];
#pragma unroll
    for (int r = 0; r < R; ++r) { const GAS f32x4* xr = (const GAS f32x4*)(xrow + (size_t)r * D) + lane;
#pragma unroll
        for (int j = 0; j < 4; ++j) v[r][j] = __builtin_nontemporal_load(xr + 64 * j); }
    const GAS f32x4* gr = (const GAS f32x4*)g + lane; f32x4 gg[4];
#pragma unroll
    for (int j = 0; j < 4; ++j) gg[j] = gr[64 * j];
#pragma unroll
    for (int r = 0; r < R; ++r) { float a = 0.f;
#pragma unroll
        for (int j = 0; j < 4; ++j) a += (v[r][j].x * v[r][j].x + v[r][j].y * v[r][j].y) + (v[r][j].z * v[r][j].z + v[r][j].w * v[r][j].w);
        s[r] = a; }
#pragma unroll
    for (int o = 1; o < 64; o <<= 1) {
#pragma unroll
        for (int r = 0; r < R; ++r) s[r] += __shfl_xor(s[r], o); }
#pragma unroll
    for (int r = 0; r < R; ++r) { const float rs = 1.f / sqrtf(s[r] * (1.f / D) + EPS); GAS unsigned long long* o8 = (GAS unsigned long long*)(orow + (size_t)r * D) + lane;
#pragma unroll
        for (int j = 0; j < 4; ++j) o8[64 * j] = (unsigned long long)pk2(v[r][j].x * rs * gg[j].x, v[r][j].y * rs * gg[j].y) | ((unsigned long long)pk2(v[r][j].z * rs * gg[j].z, v[r][j].w * rs * gg[j].w) << 32); }
}
__device__ __forceinline__ void p0_prologue(Frame& F, bool split) {
    LAS float* scr = (LAS float*)(F.lds + RING_OFF + F.wave * 16384);
    const int gw = F.vcu * NWAVES + F.wave, NGW = F.G * NWAVES;
    bf16* Win_t = (bf16*)(F.ws + WS_WIN); bf16* Wout_t = (bf16*)(F.ws + WS_WOUT); bf16* Wcq_t = (bf16*)(F.ws + WS_WCQ); bf16* Wckv_t = (bf16*)(F.ws + WS_WCKV);
    bf16* Wco_t = (bf16*)(F.ws + WS_WCO); bf16* Wpq_t = (bf16*)(F.ws + WS_WPQ);
    constexpr int I_IN = (D / 64) * (DIN / 32), I_SQ = (D / 64) * (D / 32), I_PQ = (D / 64) * (2048 / 32);
    constexpr int NITEMS = I_IN + 5 * I_SQ + I_PQ;
    for (int it = gw; it < NITEMS; it += NGW) {
        int r = it;
        if (r < I_IN) { p0_transpose_item(F.in[3], D, DIN, Win_t, 0, scr, r, F.lane, nullptr, nullptr); continue; } r -= I_IN;
        if (r < I_SQ) { p0_transpose_item(F.in[13], D, D, Wout_t, 0, scr, r, F.lane, F.in[11], F.in[12]); continue; } r -= I_SQ;
        if (r < I_SQ) { p0_transpose_item(F.in[16], D, D, Wcq_t, 0, scr, r, F.lane, F.in[14], F.in[14] + 512); continue; } r -= I_SQ;
        if (r < I_SQ) { p0_transpose_item(F.in[17], D, D, Wckv_t, 0, scr, r, F.lane, nullptr, nullptr); continue; } r -= I_SQ;
        if (r < I_SQ) { p0_transpose_item(F.in[18], D, D, Wckv_t, D, scr, r, F.lane, nullptr, nullptr); continue; } r -= I_SQ;
        if (r < I_SQ) { p0_transpose_item(F.in[19], D, D, Wco_t, 0, scr, r, F.lane, nullptr, nullptr); continue; } r -= I_SQ;
        p0_transpose_item(F.in[21], D, 2048, Wpq_t, 0, scr, r, F.lane, F.in[20], F.in[20] + 512);
    }
    bf16* H = (bf16*)(F.ws + WS_A); bf16* MEMN = (bf16*)(F.ws + WS_MEMN);
    for (int m = 2 * gw; m < TM; m += 2 * NGW) rms_rows_to_bf16<2>(F.lane, F.in[1] + (size_t)m * D, F.in[15], MEMN + (size_t)m * D);
    { bf16* SUBK = (bf16*)(F.ws + WS_SUBK); const float* sk = F.in[22]; const int gt = F.vcu * (NWAVES * 64) + F.tid, NGT = F.G * NWAVES * 64;
      for (int i = gt; i < PHEADS * 2 * PKEYS * PHALF / 4; i += NGT) { const f32x4 v = ((const GAS f32x4*)sk)[i]; ((GAS unsigned long long*)SUBK)[i] = (unsigned long long)pk2(v.x, v.y) | ((unsigned long long)pk2(v.z, v.w) << 32); } }
    if (split) {
        asm volatile("s_waitcnt vmcnt(0)" ::: "memory"); __syncthreads();
        if (F.tid == 0) { __builtin_amdgcn_fence(__ATOMIC_RELEASE, "agent"); asm volatile("s_waitcnt vmcnt(0)" ::: "memory"); __hip_atomic_fetch_add(F.ctl + CW_WCNT, 1u, RLX_AGENT); }
        const int lw = ((int)blockIdx.x >> 3) * NWAVES + F.wave, nlw = (F.G >> 3) * NWAVES, r0 = ((int)blockIdx.x & 7) * (T / 8);
        for (int m = 4 * lw; m < T / 8; m += 4 * nlw) rms_rows_to_bf16<4>(F.lane, F.in[0] + (size_t)(r0 + m) * D, F.in[2], H + (size_t)(r0 + m) * D);
    } else
        for (int m = 4 * gw; m < T; m += 4 * NGW) rms_rows_to_bf16<4>(F.lane, F.in[0] + (size_t)m * D, F.in[2], H + (size_t)m * D);
}

typedef float f32x2_ __attribute__((ext_vector_type(2)));
struct PeerStream {
    int k, count; int lane;
    bool local; int gbase, gstep, xb0, xb1, vbase;
    __device__ __forceinline__ int item_of(int kk) const { return local ? (kk >= 8 ? 16384 + (((kk - 8) >> 1) ? xb1 : xb0) + (kk & 1) : vbase + 8 * kk) : gbase + kk * gstep; }
    const float* U; const float* V; const float* gf; signed char* UQ; float* SU; unsigned char* VQ;
    const bf16* X2; const float* SS2; signed char* XQ; float* HS;
    LAS unsigned char* buf; LAS unsigned char* sbuf;
    __device__ __forceinline__ void issue(int kk) { const int item = item_of(kk);
        if (item < 16384) {
#pragma unroll
            for (int j = 0; j < 4; ++j) __builtin_amdgcn_global_load_lds((const unsigned*)(V + (size_t)item * D + j * 256 + 4 * lane), (LAS unsigned*)(buf + 4096 + j * 1024), 16, 0, 0);
        } else { const int t = 4 * (item - 16384);
#pragma unroll
            for (int j = 0; j < 8; ++j) __builtin_amdgcn_global_load_lds((const unsigned*)(X2 + (size_t)(t + (j >> 1)) * D + (j & 1) * 512 + 8 * lane), (LAS unsigned*)(buf + j * 1024), 16, 0, 0);
            __builtin_amdgcn_global_load_lds((const unsigned*)(SS2 + (size_t)(t + (lane >> 4)) * 16 + (lane & 15)), (LAS unsigned*)sbuf, 4, 0, 0);
        }
    }
    template <bool WAIT = true> __device__ __forceinline__ void finish(int kk) { const int item = item_of(kk);
        if constexpr (WAIT) asm volatile("s_waitcnt vmcnt(0)" ::: "memory");
        if (item < 16384) { const int e = item;
            v4u o2;
#pragma unroll
            for (int i = 0; i < 4; ++i) { const f32x4 w = *(const LAS f32x4*)(buf + 4096 + 64 * lane + 16 * i) * 16.0f;
                int p = __builtin_amdgcn_cvt_pk_fp8_f32(w[0], w[1], 0, false); p = __builtin_amdgcn_cvt_pk_fp8_f32(w[2], w[3], p, true); o2[i] = (unsigned)p; }
            *(v4u*)(VQ + ((size_t)(lane >> 3) * (PKEYS * PKEYS) + e) * 128 + 16 * (lane & 7)) = o2;
        } else { const int t = 4 * (item - 16384);
#pragma unroll
            for (int q = 0; q < 4; ++q) { const v4u wa = *(const LAS v4u*)(buf + 2048 * q + 32 * lane), wb = *(const LAS v4u*)(buf + 2048 * q + 32 * lane + 16); const unsigned w[8] = {wa.x, wa.y, wa.z, wa.w, wb.x, wb.y, wb.z, wb.w};
                float am = 0.f;
#pragma unroll
                for (int i = 0; i < 8; ++i) am = fmaxf(am, fmaxf(fabsf(bflo(w[i])), fabsf(bfhi(w[i]))));
                am = wave_max(am); const float inv = am > 0.f ? 127.0f / am : 0.f;
                v4u o;
#pragma unroll
                for (int i = 0; i < 4; ++i) { const int q0 = (int)rintf(bflo(w[2 * i]) * inv), q1 = (int)rintf(bfhi(w[2 * i]) * inv), q2 = (int)rintf(bflo(w[2 * i + 1]) * inv), q3 = (int)rintf(bfhi(w[2 * i + 1]) * inv);
                    o[i] = (unsigned)(q0 & 0xff) | ((unsigned)(q1 & 0xff) << 8) | ((unsigned)(q2 & 0xff) << 16) | ((unsigned)(q3 & 0xff) << 24); }
                *(v4u*)(XQ + (size_t)(t + q) * XQ_LD + 16 * lane) = o;
                float a = *(const LAS float*)(sbuf + 64 * q + 4 * (lane & 15)); a += __shfl_xor(a, 1); a += __shfl_xor(a, 2); a += __shfl_xor(a, 4); a += __shfl_xor(a, 8);
                if (lane == 0) HS[t + q] = (1.f / sqrtf(a * (1.f / D) + EPS)) * am * (1.0f / 127.0f); }
        }
        asm volatile("s_waitcnt lgkmcnt(0)" ::: "memory");
    }
};
template <int WHICH> __device__ __forceinline__ void convert_rows(Frame& F, int i0, int i1) {
    const float* SRC = WHICH ? F.in[24] : F.in[23]; signed char* UQ = (signed char*)(F.ws + WS_UQ); float* SU = (float*)(F.ws + WS_SU); unsigned char* VQ = F.ws + WS_VQ;
    int lane = F.lane; asm volatile("" : "+v"(lane));
    f32x4 gg[4];
#pragma unroll
    for (int i = 0; i < 4; ++i) gg[i] = WHICH ? (f32x4){16.f, 16.f, 16.f, 16.f} : *(const f32x4*)(F.in[20] + 16 * lane + 4 * i);
    asm volatile("s_waitcnt vmcnt(0)" ::: "memory");
    LAS unsigned char* const b0 = F.lds + RING_OFF + F.wave * 16384;
#define CT_ISSUE(item, buf) do { _Pragma("unroll") for (int j = 0; j < 4; ++j) \
        __builtin_amdgcn_global_load_lds((const unsigned*)(SRC + (size_t)(item) * D + j * 256 + 4 * lane), (LAS unsigned*)((buf) + j * 1024), 16, 0, 0); } while (0)
    int it = i0 + F.wave, par = 0;
#pragma unroll
    for (int k = 0; k < 3; ++k) if (it + 8 * k < i1) CT_ISSUE(it + 8 * k, b0 + k * 4096);
    for (; it < i1; it += 8, par = (par + 1) & 3) {
        LAS unsigned char* const buf = b0 + par * 4096;
        if (it + 24 < i1) { CT_ISSUE(it + 24, b0 + ((par + 3) & 3) * 4096); asm volatile("s_waitcnt vmcnt(12)" ::: "memory"); }
        else if (it + 16 < i1) asm volatile("s_waitcnt vmcnt(8)" ::: "memory");
        else if (it + 8 < i1) asm volatile("s_waitcnt vmcnt(4)" ::: "memory");
        else asm volatile("s_waitcnt vmcnt(0)" ::: "memory");
        const int e = it; f32x4 v[4];
#pragma unroll
        for (int i = 0; i < 4; ++i) v[i] = *(const LAS f32x4*)(buf + 64 * lane + 16 * i) * gg[i];
        v4u o;
        if constexpr (WHICH == 0) { float am = 0.f;
#pragma unroll
            for (int i = 0; i < 4; ++i) am = fmaxf(am, fmaxf(fmaxf(fabsf(v[i][0]), fabsf(v[i][1])), fmaxf(fabsf(v[i][2]), fabsf(v[i][3]))));
            am = wave_max(am); const float inv = am > 0.f ? 127.0f / am : 0.f;
#pragma unroll
            for (int i = 0; i < 4; ++i) { const int q0 = (int)rintf(v[i][0] * inv), q1 = (int)rintf(v[i][1] * inv), q2 = (int)rintf(v[i][2] * inv), q3 = (int)rintf(v[i][3] * inv);
                o[i] = (unsigned)(q0 & 0xff) | ((unsigned)(q1 & 0xff) << 8) | ((unsigned)(q2 & 0xff) << 16) | ((unsigned)(q3 & 0xff) << 24); }
            *(v4u*)(UQ + ((size_t)(lane >> 3) * (PKEYS * PKEYS) + e) * 128 + 16 * (lane & 7)) = o;
            if (lane == 0) SU[e] = am * (1.0f / 127.0f);
        } else {
#pragma unroll
            for (int i = 0; i < 4; ++i) { int p = __builtin_amdgcn_cvt_pk_fp8_f32(v[i][0], v[i][1], 0, false); p = __builtin_amdgcn_cvt_pk_fp8_f32(v[i][2], v[i][3], p, true); o[i] = (unsigned)p; }
            *(v4u*)(VQ + ((size_t)(lane >> 3) * (PKEYS * PKEYS) + e) * 128 + 16 * (lane & 7)) = o;
        }
        asm volatile("s_waitcnt lgkmcnt(0)" ::: "memory");
    }
#undef CT_ISSUE
    asm volatile("s_waitcnt vmcnt(0) lgkmcnt(0)\n\ts_barrier" ::: "memory");
}
__device__ __forceinline__ void table_share(const Frame& F, int k, int n, int& i0, int& i1) {
    const int per = (PKEYS * PKEYS + F.G - 1) / F.G, lo = (int)blockIdx.x * per, hi = (lo + per < PKEYS * PKEYS) ? lo + per : PKEYS * PKEYS;
    i0 = lo + (k * per) / n; i1 = lo + ((k + 1) * per) / n; if (i0 > hi) i0 = hi; if (i1 > hi) i1 = hi;
}
__device__ __forceinline__ void xcd_split(Frame& F, bool census, int& part, int& rank, int& nrank) {
    part = (int)(blockIdx.x & 7); rank = (int)(blockIdx.x >> 3); nrank = (F.G - part + 7) >> 3;
    if (census && (F.G & 7) == 0) { const unsigned x = F.MISC[11], r = F.MISC[10]; unsigned pre = 0u; gu32* bar = F.ctl + CW_BAR;
#pragma unroll
        for (unsigned j = 0; j < 16; ++j) { const unsigned c = __hip_atomic_load(bar + XB_XCNT(j), RLX_AGENT); pre += (j < x) ? c : 0u; }
        const unsigned gi = pre + r, per = (unsigned)F.G >> 3; part = (int)(gi / per); rank = (int)(gi % per); nrank = (int)per; }
}
template <int CTRL> __device__ __forceinline__ int dpp_i(int x) { return __builtin_amdgcn_update_dpp(0, x, CTRL, 0xf, 0xf, true); }
template <int CTRL> __device__ __forceinline__ float dpp_f(float x) { return __int_as_float(__builtin_amdgcn_update_dpp(0, __float_as_int(x), CTRL, 0xf, 0xf, true)); }
constexpr int DPP_XOR1 = 0xB1  , DPP_XOR2 = 0x4E  , DPP_HMIRROR = 0x141  , DPP_ROR8 = 0x128  ;
__device__ __forceinline__ float swap32_add(float a, float b) { const auto r = __builtin_amdgcn_permlane32_swap(__float_as_uint(a), __float_as_uint(b), false, false); return __uint_as_float(r[0]) + __uint_as_float(r[1]); }
__device__ __forceinline__ float swap16_add(float a, float b) { const auto r = __builtin_amdgcn_permlane16_swap(__float_as_uint(a), __float_as_uint(b), false, false); return __uint_as_float(r[0]) + __uint_as_float(r[1]); }
struct PuMeta { v4u ida, idb; v4u xq; };
__device__ __forceinline__ void pu_load(PuMeta& m, int t, int g, int col16, const unsigned short* IDS, const signed char* XQ) {
    const v4u* ip = (const v4u*)(IDS + (size_t)t * PEXP + g * 16); m.ida = ip[0]; m.idb = ip[1]; m.xq = *(const v4u*)(XQ + (size_t)t * XQ_LD + col16);
}
__device__ __forceinline__ unsigned pu_id(const PuMeta& m, int i) { const unsigned w = (i < 8) ? m.ida[(i & 7) >> 1] : m.idb[(i & 7) >> 1]; return (i & 1) ? (w >> 16) : (w & 0xffffu); }
__device__ __forceinline__ void peer_u(Frame& F, bool census) {
    const unsigned short* IDS = (const unsigned short*)(F.ws + WS_IDS); const signed char* XQ = (const signed char*)(F.ws + WS_XQ); const signed char* UQ = (const signed char*)(F.ws + WS_UQ); int* PD = (int*)(F.ws + WS_E);
    int part, rank, nrank; xcd_split(F, census, part, rank, nrank); const int lane = F.lane, g = lane >> 3, l7 = lane & 7;
    const signed char* slab = UQ + (size_t)part * (PKEYS * PKEYS) * 128 + 16 * l7; const int col16 = 128 * part + 16 * l7;
    const bool b4 = (lane & 4) != 0, b2 = (lane & 2) != 0, b1 = (lane & 1) != 0;
    const int t0 = rank * NWAVES + F.wave, tstep = nrank * NWAVES;
    PuMeta m[2]; v4u q[2][16]; v4u xc[2];
#pragma unroll
    for (int k = 0; k < 2; ++k) { const int t = t0 + k * tstep; pu_load(m[k], t < T ? t : t0, g, col16, IDS, XQ); }
#define PU_ISSUE(buf, mk) do { _Pragma("unroll") for (int i_ = 0; i_ < 16; ++i_) q[buf][i_] = *(const v4u*)(slab + (size_t)pu_id((mk), i_) * 128); xc[buf] = (mk).xq; } while (0)
    PU_ISSUE(0, m[0]);
    { const int tp = t0 + 2 * tstep; if (tp < T) pu_load(m[0], tp, g, col16, IDS, XQ); }
    for (int tb = t0; tb < T; tb += 2 * tstep) {
#pragma unroll
        for (int k = 0; k < 2; ++k) {
            const int t = tb + k * tstep;
            if (t < T) {
                const int tn = t + tstep;
                if (tn < T) PU_ISSUE(k ^ 1, m[k ^ 1]);
                { const int tp = t + 3 * tstep; if (tp < T) pu_load(m[k ^ 1], tp, g, col16, IDS, XQ); }
                int d[16];
#pragma unroll
                for (int i = 0; i < 16; ++i) { const v4u uu = q[k][i]; const v4u xx = xc[k];
                    int a = __builtin_amdgcn_sdot4((int)uu.x, (int)xx.x, 0, false); a = __builtin_amdgcn_sdot4((int)uu.y, (int)xx.y, a, false); a = __builtin_amdgcn_sdot4((int)uu.z, (int)xx.z, a, false); d[i] = __builtin_amdgcn_sdot4((int)uu.w, (int)xx.w, a, false); }
                int r8[8], r4[4], r2[2];
#pragma unroll
                for (int i = 0; i < 8; ++i) { const int sa = d[i] + dpp_i<DPP_HMIRROR>(d[i]), sb = d[i + 8] + dpp_i<DPP_HMIRROR>(d[i + 8]); r8[i] = b4 ? sb : sa; }
#pragma unroll
                for (int i = 0; i < 4; ++i) { const int sa = r8[i] + dpp_i<DPP_XOR2>(r8[i]), sb = r8[i + 4] + dpp_i<DPP_XOR2>(r8[i + 4]); r4[i] = b2 ? sb : sa; }
#pragma unroll
                for (int i = 0; i < 2; ++i) { const int sa = r4[i] + dpp_i<DPP_XOR1>(r4[i]), sb = r4[i + 2] + dpp_i<DPP_XOR1>(r4[i + 2]); r2[i] = b1 ? sb : sa; }
                { const int q0_ = (r2[0] + 32) >> 6, q1_ = (r2[1] + 32) >> 6;
                  PD[((size_t)t * 8 + part) * 64 + lane] = (int)(((unsigned)q0_ & 0xffffu) | ((unsigned)q1_ << 16)); }
            }
        }
    }
#undef PU_ISSUE
}
__device__ __forceinline__ void peer_combine(Frame& F) {
    const int* PD = (const int*)(F.ws + WS_E); const unsigned short* IDS = (const unsigned short*)(F.ws + WS_IDS); const float* GATES = (const float*)(F.ws + WS_GATES); const float* SU = (const float*)(F.ws + WS_SU);
    const float* HS = (const float*)(F.ws + WS_HS); unsigned* PK = (unsigned*)(F.ws + WS_ACTW);
    const int gw = F.vcu * NWAVES + F.wave, NGW = F.G * NWAVES, lane = F.lane, g = lane >> 3, l7 = lane & 7;
    const int ii0 = 2 * (l7 & 1) + 4 * ((l7 >> 1) & 1) + 8 * ((l7 >> 2) & 1), p0 = 8 * ii0 + g, p1 = 8 * (ii0 + 1) + g, q0 = g * 16 + ii0, q1 = q0 + 1;
    for (int t = 2 * gw; t < T; t += 2 * NGW) {
        uint2 v[2][8]; float hs[2], g0[2], g1[2]; int id0[2], id1[2];
#pragma unroll
        for (int r = 0; r < 2; ++r) {
#pragma unroll
            for (int x = 0; x < 8; ++x) { const int w_ = PD[((size_t)(t + r) * 8 + x) * 64 + lane]; v[r][x] = make_uint2((unsigned)((w_ << 16) >> 16), (unsigned)(w_ >> 16)); }
            hs[r] = HS[t + r]; id0[r] = IDS[(size_t)(t + r) * PEXP + q0]; id1[r] = IDS[(size_t)(t + r) * PEXP + q1]; g0[r] = GATES[(size_t)(t + r) * PEXP + p0]; g1[r] = GATES[(size_t)(t + r) * PEXP + p1]; }
        float su0[2], su1[2];
#pragma unroll
        for (int r = 0; r < 2; ++r) { su0[r] = SU[id0[r]]; su1[r] = SU[id1[r]]; }
#pragma unroll
        for (int r = 0; r < 2; ++r) { int s0 = 0, s1 = 0;
#pragma unroll
            for (int x = 0; x < 8; ++x) { s0 += (int)v[r][x].x; s1 += (int)v[r][x].y; }
            const float w0 = g0[r] * gelu_erf(hs[r] * su0[r] * (64.0f * (float)s0)) * 0.0625f, w1 = g1[r] * gelu_erf(hs[r] * su1[r] * (64.0f * (float)s1)) * 0.0625f;
            *(uint2*)(PK + (size_t)(t + r) * PEXP + q0) = make_uint2((f2bf(w0) << 16) | (unsigned)id0[r], (f2bf(w1) << 16) | (unsigned)id1[r]); }
    }
}
struct PvMeta { v4u pk[4]; unsigned xw; };
__device__ __forceinline__ void pv_load(PvMeta& m, int t, int g, int col, const unsigned* PK, const bf16* X2) {
    const v4u* pp = (const v4u*)(PK + (size_t)t * PEXP + g * 16);
#pragma unroll
    for (int i = 0; i < 4; ++i) m.pk[i] = pp[i];
    m.xw = *(const unsigned*)(X2 + (size_t)t * D + col);
}
__device__ __forceinline__ void peer_v(Frame& F, bool census) {
    const bf16* X2 = (const bf16*)(F.ws + WS_C); const unsigned* PK = (const unsigned*)(F.ws + WS_ACTW);
    const unsigned char* VQ = F.ws + WS_VQ; bf16* X3 = (bf16*)(F.ws + WS_A);
    int part, rank, nrank; xcd_split(F, census, part, rank, nrank); const int lane = F.lane, g = lane >> 3, l7 = lane & 7;
    const unsigned char* slab = VQ + (size_t)part * (PKEYS * PKEYS) * 128 + 16 * l7;
    const bool hi = lane >= 32, b16 = (lane & 16) != 0, b8 = (lane & 8) != 0;
    const int col = 128 * part + 16 * l7 + 2 * g;
    const int t0 = rank * NWAVES + F.wave, tstep = nrank * NWAVES;
    PvMeta m[2]; v4u qa[8], qb[8]; float wa[8], wb[8];
#pragma unroll
    for (int k = 0; k < 2; ++k) { const int t = t0 + k * tstep; pv_load(m[k], t < T ? t : t0, g, col, PK, X2); }
#define PV_ISSUE(qx, wx, mk, h_) do { _Pragma("unroll") for (int i_ = 0; i_ < 8; ++i_) { const unsigned p_ = (mk).pk[2 * (h_) + (i_ >> 2)][i_ & 3]; wx[i_] = __uint_as_float(p_ & 0xffff0000u); qx[i_] = *(const v4u*)(slab + (size_t)(p_ & 0xffffu) * 128); } } while (0)
#define PV_HALF(qx, wx) do { _Pragma("unroll") for (int i_ = 0; i_ < 8; ++i_) { const float w_ = wx[i_]; \
        _Pragma("unroll") for (int kk = 0; kk < 4; ++kk) { const f32x2_ lo = __builtin_amdgcn_cvt_pk_f32_fp8((int)qx[i_][kk], false), hi2 = __builtin_amdgcn_cvt_pk_f32_fp8((int)qx[i_][kk], true); \
            acc2[2 * kk] += lo * w_; acc2[2 * kk + 1] += hi2 * w_; } } } while (0)
    PV_ISSUE(qa, wa, m[0], 0);
    for (int tb = t0; tb < T; tb += 2 * tstep) {
#pragma unroll
        for (int k = 0; k < 2; ++k) {
            const int t = tb + k * tstep;
            if (t < T) {
                PV_ISSUE(qb, wb, m[k], 1); const unsigned xw = m[k].xw;
                f32x2_ acc2[8];
#pragma unroll
                for (int i = 0; i < 8; ++i) acc2[i] = (f32x2_){0.f, 0.f};
                PV_HALF(qa, wa);
                const int tn = t + tstep;
                if (tn < T) { PV_ISSUE(qa, wa, m[k ^ 1], 0); }
                { const int tp = t + 2 * tstep; if (tp < T) pv_load(m[k], tp, g, col, PK, X2); }
                PV_HALF(qb, wb);
                float acc[16];
#pragma unroll
                for (int i = 0; i < 8; ++i) { acc[2 * i] = acc2[i].x; acc[2 * i + 1] = acc2[i].y; }
                float r8[8], r4[4], r2[2];
#pragma unroll
                for (int i = 0; i < 8; ++i) r8[i] = swap32_add(acc[i], acc[i + 8]);
#pragma unroll
                for (int i = 0; i < 4; ++i) r4[i] = swap16_add(r8[i], r8[i + 4]);
#pragma unroll
                for (int i = 0; i < 2; ++i) { const float sa = r4[i] + dpp_f<DPP_ROR8>(r4[i]), sb = r4[i + 2] + dpp_f<DPP_ROR8>(r4[i + 2]); r2[i] = b8 ? sb : sa; }
                const float y0 = bflo(xw) + r2[0], y1 = bfhi(xw) + r2[1];
                *(unsigned*)(X3 + (size_t)t * D + col) = pk2(y0, y1);
            }
        }
    }
#undef PV_ISSUE
#undef PV_HALF
}
__device__ __forceinline__ void final_norm(Frame& F) {
    const bf16* X3 = (const bf16*)(F.ws + WS_A); const float* SS3 = (const float*)(F.ws + WS_SS3); const float* gfin = F.in[25];
    int tid_ = threadIdx.x; asm volatile("" : "+v"(tid_)); const int lane = tid_ & 63;
    const int gw = F.vcu * NWAVES + F.wave, NGW = F.G * NWAVES;
    f32x4 gg[4];
#pragma unroll
    for (int i = 0; i < 4; ++i) gg[i] = *(const f32x4*)(gfin + 256 * i + 4 * lane);
    for (int t = 4 * gw; t < T; t += 4 * NGW) {
        uint2 v[4][4]; float tot[4];
#pragma unroll
        for (int r = 0; r < 4; ++r)
#pragma unroll
            for (int i = 0; i < 4; ++i) v[r][i] = *(const uint2*)(X3 + (size_t)(t + r) * D + 256 * i + 4 * lane);
#pragma unroll
        for (int r = 0; r < 4; ++r) { float a = 0.f;
#pragma unroll
            for (int i = 0; i < 4; ++i) { const float x0 = bflo(v[r][i].x), x1 = bfhi(v[r][i].x), x2 = bflo(v[r][i].y), x3 = bfhi(v[r][i].y); a += (x0 * x0 + x1 * x1) + (x2 * x2 + x3 * x3); }
            tot[r] = a; }
#pragma unroll
        for (int o = 1; o < 64; o <<= 1)
#pragma unroll
            for (int r = 0; r < 4; ++r) tot[r] += __shfl_xor(tot[r], o);
#pragma unroll
        for (int r = 0; r < 4; ++r) { const float rs = 1.f / sqrtf(tot[r] * (1.f / D) + EPS);
#pragma unroll
            for (int i = 0; i < 4; ++i) { f32x4 o; o[0] = bflo(v[r][i].x) * rs * gg[i][0]; o[1] = bfhi(v[r][i].x) * rs * gg[i][1]; o[2] = bflo(v[r][i].y) * rs * gg[i][2]; o[3] = bfhi(v[r][i].y) * rs * gg[i][3];
                __builtin_nontemporal_store(o, (f32x4*)(F.out + (size_t)(t + r) * D + 256 * i + 4 * lane)); } }
    }
}

#include <hip/hip_bf16.h>
#include <cmath>
namespace attn_body {
using bf16=__hip_bfloat16;
using bf16x8=__attribute__((ext_vector_type(8)))short;
using s16x4=__attribute__((ext_vector_type(4)))short;
using f32x16=__attribute__((ext_vector_type(16)))float;
using u32x4=__attribute__((ext_vector_type(4)))unsigned;
constexpr int BATCH=16,NHEAD=8,SEQ=2048,D=64,DM=2560,DMO=1024;
constexpr int NW=8,QBLK=32,QB=QBLK*NW,KVBLK=64,NQB=SEQ/QB;
constexpr int ATTN_PITCH=DM, ATTN_UNIT_ROWS=QB;
__device__ __forceinline__ int crow(int r,int hi){return (r&3)+8*(r>>2)+4*hi;}
#define SBAR() __builtin_amdgcn_sched_barrier(0)
__device__ __forceinline__ void cmask(f32x16&p0,f32x16&p1,int jb,int qrel,int hi){
  const float NEG=-INFINITY; int kb=64*jb+4*hi;
  #pragma unroll
  for(int r=0;r<16;++r){int kv=kb+(r&3)+8*(r>>2); if(kv>qrel)p0[r]=NEG; if(kv+32>qrel)p1[r]=NEG;}
}

constexpr int NSLOT=3, SLOTB=8192;
constexpr int LDS_K=0, LDS_V=NSLOT*SLOTB, LDS_WS=2*NSLOT*SLOTB, LDS_OST=LDS_WS+NW*128*4, LDS_SEL=LDS_OST+NW*4096, LDS_BYTES=LDS_SEL+16*QB*4;
constexpr float C2=0.125f*1.4426950408889634f;
__device__ __forceinline__ void glds16(const void*gsrc,unsigned lds_dst){unsigned keep;
  asm volatile("s_mov_b32 %0, m0\n\ts_mov_b32 m0, %2\n\ts_nop 0\n\tglobal_load_lds_dwordx4 %1, off\n\ts_mov_b32 m0, %0":"=&s"(keep):"v"(gsrc),"s"(lds_dst):"memory");}
__device__ __forceinline__ float max3f(float a,float b,float c){float r;asm("v_max3_f32 %0, %1, %2, %3":"=v"(r):"v"(a),"v"(b),"v"(c));return r;}
__device__ __forceinline__ float max2f(float a,float b){float r;asm("v_max_f32_e32 %0, %1, %2":"=v"(r):"v"(a),"v"(b));return r;}
__device__ __forceinline__ float fadd_s(float a,float b){float r;asm("v_add_f32_e32 %0, %1, %2":"=v"(r):"v"(a),"v"(b));return r;}
__device__ __forceinline__ float fsub_s(float a,float b){float r;asm("v_sub_f32_e32 %0, %1, %2":"=v"(r):"v"(a),"v"(b));return r;}
typedef float f32x2_t __attribute__((ext_vector_type(2))); typedef __bf16 bf16x2_t __attribute__((ext_vector_type(2)));
__device__ __forceinline__ unsigned cvtpk_s(float lo,float hi){f32x2_t v={lo,hi};bf16x2_t b=__builtin_convertvector(v,bf16x2_t);return __builtin_bit_cast(unsigned,b);}
#define WAIT_BAR(N) asm volatile("s_waitcnt vmcnt(" #N ") lgkmcnt(0)\n\ts_barrier":::"memory")

__device__ __forceinline__ void qkt(f32x16&p0,f32x16&p1,const char*Kslot,const bf16x8*qr,const f32x16&negm,int r32,int hi){
  const char*kb=Kslot+hi*1024+r32*16;
  #pragma unroll
  for(int d0=0;d0<4;++d0){
    const bf16x8 b0=*reinterpret_cast<const bf16x8*>(kb+d0*2048);
    const bf16x8 b1=*reinterpret_cast<const bf16x8*>(kb+d0*2048+512);
    if(d0==0){p0=__builtin_amdgcn_mfma_f32_32x32x16_bf16(b0,qr[0],negm,0,0,0);p1=__builtin_amdgcn_mfma_f32_32x32x16_bf16(b1,qr[0],negm,0,0,0);}
    else{p0=__builtin_amdgcn_mfma_f32_32x32x16_bf16(b0,qr[d0],p0,0,0,0);p1=__builtin_amdgcn_mfma_f32_32x32x16_bf16(b1,qr[d0],p1,0,0,0);}}
}
typedef __attribute__((address_space(3))) const char* lds_cptr;
typedef short v4i16_t __attribute__((ext_vector_type(4)));
__device__ __forceinline__ void kload8(bf16x8*kf,lds_cptr kp){
  kf[0]=*(const __attribute__((address_space(3))) bf16x8*)(kp);      kf[1]=*(const __attribute__((address_space(3))) bf16x8*)(kp+512);
  kf[2]=*(const __attribute__((address_space(3))) bf16x8*)(kp+2048); kf[3]=*(const __attribute__((address_space(3))) bf16x8*)(kp+2560);
  kf[4]=*(const __attribute__((address_space(3))) bf16x8*)(kp+4096); kf[5]=*(const __attribute__((address_space(3))) bf16x8*)(kp+4608);
  kf[6]=*(const __attribute__((address_space(3))) bf16x8*)(kp+6144); kf[7]=*(const __attribute__((address_space(3))) bf16x8*)(kp+6656);
}
__device__ __forceinline__ void kload2(bf16x8*kf,lds_cptr kp,int j){ kf[2*j]=*(const __attribute__((address_space(3))) bf16x8*)(kp+j*2048); kf[2*j+1]=*(const __attribute__((address_space(3))) bf16x8*)(kp+j*2048+512); }
__device__ __forceinline__ s16x4 vtr(lds_cptr p){ return __builtin_bit_cast(s16x4,__builtin_amdgcn_ds_read_tr16_b64_v4i16((__attribute__((address_space(3))) v4i16_t*)p)); }
__device__ __forceinline__ float rowmax(const f32x16&p0,const f32x16&p1){
  float a=max3f(p0[0],p0[1],p1[0]),b=max3f(p0[2],p0[3],p1[1]);a=max3f(a,p1[2],p1[3]);
  #pragma unroll
  for(int r=4;r<16;r+=4){a=max3f(a,p0[r],p0[r+1]);b=max3f(b,p0[r+2],p0[r+3]);a=max3f(a,p1[r],p1[r+1]);b=max3f(b,p1[r+2],p1[r+3]);}
  const float m=max2f(a,b);
  auto rr=__builtin_amdgcn_permlane32_swap(__float_as_uint(m),__float_as_uint(m),false,false);
  return max2f(__uint_as_float(rr[0]),__uint_as_float(rr[1]));
}
__device__ __forceinline__ void pv(f32x16*o,int vb,bf16x8 pa0,bf16x8 pa1,bf16x8 pa2,bf16x8 pa3){
  #pragma unroll
  for(int d0=0;d0<2;++d0){s16x4 lo[4],hi[4];
    #pragma unroll
    for(int ks=0;ks<4;++ks){
      asm volatile("ds_read_b64_tr_b16 %0,%1 offset:%c2":"=&v"(lo[ks]):"v"(vb),"i"(d0*4096+ks*1024):"memory");
      asm volatile("ds_read_b64_tr_b16 %0,%1 offset:%c2":"=&v"(hi[ks]):"v"(vb),"i"(d0*4096+ks*1024+512):"memory");}
    asm volatile("s_waitcnt lgkmcnt(0)":::"memory");SBAR();
    #define PK(k) (bf16x8){lo[k][0],lo[k][1],lo[k][2],lo[k][3],hi[k][0],hi[k][1],hi[k][2],hi[k][3]}
    o[d0]=__builtin_amdgcn_mfma_f32_32x32x16_bf16(pa0,PK(0),o[d0],0,0,0);
    o[d0]=__builtin_amdgcn_mfma_f32_32x32x16_bf16(pa1,PK(1),o[d0],0,0,0);
    o[d0]=__builtin_amdgcn_mfma_f32_32x32x16_bf16(pa2,PK(2),o[d0],0,0,0);
    o[d0]=__builtin_amdgcn_mfma_f32_32x32x16_bf16(pa3,PK(3),o[d0],0,0,0);
    #undef PK
  }
}

#ifndef ATTN_STORE16
#define ATTN_STORE16(p,v) (*(u32x4*)(p)=(v))
#endif
template<int THRL> __device__ __forceinline__ void attn_unit(int b,int h,int qb,const bf16*Q,const bf16*__restrict__ K,const bf16*__restrict__ V,bf16*O,float*SSA,int ui,char*shm){
  int tid_=threadIdx.x; asm volatile("":"+v"(tid_)); const int tid=tid_,lane=tid&63,r32=lane&31,hi=lane>>5; const int wid=__builtin_amdgcn_readfirstlane(tid>>6);
  const long rowbase=(long)b*SEQ; const int q0=qb*QB;
  const bf16*Qw=Q+(rowbase+q0+wid*QBLK)*DM+h*D;
  const bf16*Kh=K+rowbase*DM+h*D,*Vh=V+rowbase*DM+h*D;
  const unsigned lds0=(unsigned)(uintptr_t)shm;
  float*wsf=(float*)(shm+LDS_WS)+wid*128; const unsigned*selp=(const unsigned*)(shm+LDS_SEL)+ui*QB+wid*QBLK+r32;

  const bf16*ksrc=Kh+(long)lane*DM+wid*8;
  const bf16*vsrc=Vh+(long)(16*(wid&3)+(lane>>2))*DM+(wid>>2)*32+(lane&3)*8;
  const unsigned kdst=lds0+LDS_K+wid*1024, vdst=lds0+LDS_V+wid*1024;
  const int tb4=4*qb;
  #define PHYS(t) (((t)<4)?(tb4+(t)):((t)-4))
  #define DMA_K(t,slot) glds16(ksrc+(long)PHYS(t)*KVBLK*DM,(unsigned)__builtin_amdgcn_readfirstlane(kdst+(slot)))
  #define DMA_V(t,slot) glds16(vsrc+(long)PHYS(t)*KVBLK*DM,(unsigned)__builtin_amdgcn_readfirstlane(vdst+(slot)))
  const int vb0=(int)(lds0+LDS_V)+((lane>>4)&1)*32+(lane&3)*8+(4*hi+((lane&15)>>2))*64;
  const char*Kbase=shm+LDS_K; bf16x8 kf[8];
  const lds_cptr shm3=(lds_cptr)shm; const lds_cptr kp0=shm3+LDS_K+hi*1024+r32*16; const lds_cptr vp0=shm3+LDS_V+((lane>>4)&1)*32+(lane&3)*8+(4*hi+((lane&15)>>2))*64;
  const int NT=(q0+QB)/KVBLK;
  DMA_K(0,0);DMA_V(0,0);DMA_K(1,SLOTB);
  bf16x8 qr[4];
  #pragma unroll
  for(int d0=0;d0<4;++d0)qr[d0]=*reinterpret_cast<const bf16x8*>(&Qw[(long)r32*DM+d0*16+hi*8]);

  float mhat=0.f,l_reg=0.f;f32x16 o[2];o[0]=f32x16{};o[1]=f32x16{};const f32x16 negm0=f32x16{};
  const int qrel=wid*QBLK+r32;
  #define CMASK(P0,P1,t) do{ if((t)<4){cmask(P0,P1,(t),qrel,hi);} }while(0)
  bool resc=false;
  #define START(P0,P1) do{ const float rm=rowmax(P0,P1); resc=false; \
    { const float dl=rm; mhat=fadd_s(mhat,dl); \
      _Pragma("unroll") for(int r=0;r<16;++r){P0[r]=fsub_s(P0[r],dl);P1[r]=fsub_s(P1[r],dl);} \
    } \
    _Pragma("unroll") for(int r=0;r<16;++r)P0[r]=__builtin_amdgcn_exp2f(P0[r]); }while(0)
  #define RESC() do{ if(resc){ asm volatile("s_waitcnt lgkmcnt(0)":::"memory"); \
      _Pragma("unroll") for(int d_=0;d_<2;++d_) _Pragma("unroll") for(int r=0;r<16;++r)o[d_][r]*=wsf[crow(r,hi)]; } }while(0)
  f32x16 pA0,pA1,pB0,pB1;
  int sl_prev=0,sl_cur=0,sl_next=SLOTB;
  #define ROT() do{sl_prev=sl_cur;sl_cur=sl_next;sl_next=(sl_next==(NSLOT-1)*SLOTB)?0:sl_next+SLOTB;}while(0)
  DMA_K(2,2*SLOTB);
  WAIT_BAR(3);
  qkt(pA0,pA1,Kbase,qr,negm0,r32,hi);asm volatile("s_nop 15\n\ts_nop 7":"+v"(pA0),"+v"(pA1));CMASK(pA0,pA1,0);
  START(pA0,pA1);
  _Pragma("unroll") for(int r=0;r<16;++r)pA1[r]=__builtin_amdgcn_exp2f(pA1[r]);
  WAIT_BAR(0);
  DMA_K(3,0);DMA_V(1,SLOTB);
  ROT();
  kload8(kf,kp0+sl_cur);
  WAIT_BAR(2);
  s16x4 vlo[8],vhi[8]; u32x4 pw0,pw1,pw2,pw3;
  #define PKW(P,B) cvtpk_s(P[B],P[B+1])
  #define PAF(k) __builtin_bit_cast(bf16x8,pw##k)
  #define VFR(i) (bf16x8){vlo[i][0],vlo[i][1],vlo[i][2],vlo[i][3],vhi[i][0],vhi[i][1],vhi[i][2],vhi[i][3]}
  #define PIN(x) asm volatile("":"+v"(x))
  #define MX3(a,b,c) __builtin_fmaxf(__builtin_fmaxf((a),(b)),(c))
  #define GAPA(MF,A0,A1,A2,A3,W0,W1,PW) do{ MF; sacc+=A0; sacc+=A1; sacc+=A2; sacc+=A3; PIN(sacc); W0; W1; PIN(PW); SBAR(); }while(0)
  #define EX(v) __builtin_amdgcn_exp2f(v)
  #define GAPB(MF,X,B) do{ MF; X[B]=EX(X[B]); X[B+1]=EX(X[B+1]); X[B+2]=EX(X[B+2]); X[B+3]=EX(X[B+3]); PIN(X); SBAR(); }while(0)
  #define VRD(i) do{ vlo[i]=vtr(vp_+(((i)>>2)*4096+((i)&3)*1024)); vhi[i]=vtr(vp_+(((i)>>2)*4096+((i)&3)*1024+512)); }while(0)
  #define KRD(G,j) do{ if(G){ kload2(kf,kp0+sl_next,j); SBAR(); } }while(0)
  #define STEP(C0,C1,P0,P1,t,GK,GV,GL) do{ SBAR(); \
    const lds_cptr vp_=vp0+sl_prev; \
    float sacc; { const unsigned sw_=*selp; const float nm_=((sw_>>(((t)<4)?31:((((t)-4)>>2)&7)))&1u)?-mhat:-1.0e30f; f32x16 negm; _Pragma("unroll") for(int r=0;r<16;++r)negm[r]=nm_; asm volatile("":"+v"(negm)); \
    VRD(0); SBAR(); sacc=(P0[0]+P0[1]); \
    GAPA(C0=__builtin_amdgcn_mfma_f32_32x32x16_bf16(kf[0],qr[0],negm,0,0,0), P0[2],P0[3],P0[4],P0[5],     pw0[0]=PKW(P0,0), pw0[1]=PKW(P0,2), pw0); \
    VRD(4); SBAR(); GAPA(C1=__builtin_amdgcn_mfma_f32_32x32x16_bf16(kf[1],qr[0],negm,0,0,0), P0[6],P0[7],P0[8],P0[9],     pw0[2]=PKW(P0,4), pw0[3]=PKW(P0,6), pw0); \
    } \
    VRD(1); SBAR(); GAPA(C0=__builtin_amdgcn_mfma_f32_32x32x16_bf16(kf[2],qr[1],C0,0,0,0),   P0[10],P0[11],P0[12],P0[13], pw1[0]=PKW(P0,8), pw1[1]=PKW(P0,10), pw1); \
    VRD(5); SBAR(); GAPA(C1=__builtin_amdgcn_mfma_f32_32x32x16_bf16(kf[3],qr[1],C1,0,0,0),   P0[14],P0[15],P1[0],P1[1],   pw1[2]=PKW(P0,12),pw1[3]=PKW(P0,14), pw1); \
    VRD(2); SBAR(); GAPA(C0=__builtin_amdgcn_mfma_f32_32x32x16_bf16(kf[4],qr[2],C0,0,0,0),   P1[2],P1[3],P1[4],P1[5],     pw2[0]=PKW(P1,0), pw2[1]=PKW(P1,2), pw2); \
    VRD(6); SBAR(); GAPA(C1=__builtin_amdgcn_mfma_f32_32x32x16_bf16(kf[5],qr[2],C1,0,0,0),   P1[6],P1[7],P1[8],P1[9],     pw2[2]=PKW(P1,4), pw2[3]=PKW(P1,6), pw2); \
    VRD(3); SBAR(); GAPA(C0=__builtin_amdgcn_mfma_f32_32x32x16_bf16(kf[6],qr[3],C0,0,0,0),   P1[10],P1[11],P1[12],P1[13], pw3[0]=PKW(P1,8), pw3[1]=PKW(P1,10), pw3); \
    VRD(7); SBAR(); GAPA(C1=__builtin_amdgcn_mfma_f32_32x32x16_bf16(kf[7],qr[3],C1,0,0,0),   P1[14],P1[15],0.f,0.f,       pw3[2]=PKW(P1,12),pw3[3]=PKW(P1,14), pw3); \
    l_reg+=sacc; \
    if(GK){DMA_K((t)+3,sl_cur);} if(GV){DMA_V((t)+1,sl_next);} \
    CMASK(C0,C1,t); \
    { float a=MX3(C0[0],C0[1],C1[0]),b=MX3(C0[2],C0[3],C1[1]); a=MX3(a,C1[2],C1[3]); \
      _Pragma("unroll") for(int r=4;r<16;r+=4){a=MX3(a,C0[r],C0[r+1]);b=MX3(b,C0[r+2],C0[r+3]);a=MX3(a,C1[r],C1[r+1]);b=MX3(b,C1[r+2],C1[r+3]);} \
      float rm=__builtin_fmaxf(a,b); { auto rr=__builtin_amdgcn_permlane32_swap(__float_as_uint(rm),__float_as_uint(rm),false,false); rm=__builtin_fmaxf(__uint_as_float(rr[0]),__uint_as_float(rr[1])); } \
      resc=false; \
      if(__builtin_expect(__any(rm>(float)THRL),0)){ const float dl=__builtin_fmaxf(rm,0.f); mhat+=dl; \
        _Pragma("unroll") for(int r=0;r<16;++r){C0[r]-=dl;C1[r]-=dl;} \
        const float f=__builtin_amdgcn_exp2f(-dl); l_reg*=f; if(hi==0)wsf[r32]=f; resc=true; } } \
    SBAR(); \
    GAPB(o[0]=__builtin_amdgcn_mfma_f32_32x32x16_bf16(PAF(0),VFR(0),o[0],0,0,0), C0,0); \
    GAPB(o[1]=__builtin_amdgcn_mfma_f32_32x32x16_bf16(PAF(0),VFR(4),o[1],0,0,0), C0,4); \
    KRD(GL,0); GAPB(o[0]=__builtin_amdgcn_mfma_f32_32x32x16_bf16(PAF(1),VFR(1),o[0],0,0,0), C0,8); \
    KRD(GL,1); GAPB(o[1]=__builtin_amdgcn_mfma_f32_32x32x16_bf16(PAF(1),VFR(5),o[1],0,0,0), C0,12); \
    KRD(GL,2); GAPB(o[0]=__builtin_amdgcn_mfma_f32_32x32x16_bf16(PAF(2),VFR(2),o[0],0,0,0), C1,0); \
    KRD(GL,3); GAPB(o[1]=__builtin_amdgcn_mfma_f32_32x32x16_bf16(PAF(2),VFR(6),o[1],0,0,0), C1,4); \
    GAPB(o[0]=__builtin_amdgcn_mfma_f32_32x32x16_bf16(PAF(3),VFR(3),o[0],0,0,0), C1,8); \
    GAPB(o[1]=__builtin_amdgcn_mfma_f32_32x32x16_bf16(PAF(3),VFR(7),o[1],0,0,0), C1,12); \
    }while(0)
  int t=1;
  for(;t+5<NT;t+=2){
    STEP(pB0,pB1,pA0,pA1,t,true,true,true);     WAIT_BAR(2); RESC(); ROT();
    STEP(pA0,pA1,pB0,pB1,t+1,true,true,true);   WAIT_BAR(2); RESC(); ROT();
  }
  #define ENDW(tt) do{ if((tt)+3<NT){WAIT_BAR(2);} else if((tt)+2<NT){WAIT_BAR(1);} else {WAIT_BAR(0);} }while(0)
  for(;t+1<NT;t+=2){
    STEP(pB0,pB1,pA0,pA1,t,(t+3<NT),(t+1<NT),(t+1<NT));       ENDW(t);   RESC(); ROT();
    STEP(pA0,pA1,pB0,pB1,t+1,(t+4<NT),(t+2<NT),(t+2<NT));     ENDW(t+1); RESC(); ROT();
  }
  STEP(pB0,pB1,pA0,pA1,NT-1,false,false,false); RESC();
  { float sacc=pB0[0]+pB0[1]; _Pragma("unroll") for(int r=2;r<16;++r)sacc+=pB0[r]; _Pragma("unroll") for(int r=0;r<16;++r)sacc+=pB1[r]; l_reg+=sacc;
    pw0=(u32x4){PKW(pB0,0),PKW(pB0,2),PKW(pB0,4),PKW(pB0,6)};pw1=(u32x4){PKW(pB0,8),PKW(pB0,10),PKW(pB0,12),PKW(pB0,14)};pw2=(u32x4){PKW(pB1,0),PKW(pB1,2),PKW(pB1,4),PKW(pB1,6)};pw3=(u32x4){PKW(pB1,8),PKW(pB1,10),PKW(pB1,12),PKW(pB1,14)};
    SBAR(); pv(o,vb0+sl_cur,PAF(0),PAF(1),PAF(2),PAF(3)); }
  #undef PKW
  #undef PAF
  #undef VFR
  #undef PIN
  #undef MX3
  #undef GAPA
  #undef GAPB
  #undef EX
  #undef VRD
  #undef KRD
  #undef STEP
  #undef ENDW
  {auto rr=__builtin_amdgcn_permlane32_swap(__float_as_uint(l_reg),__float_as_uint(l_reg),false,false);l_reg=__uint_as_float(rr[0])+__uint_as_float(rr[1]);}
  if(hi==0)wsf[32+r32]=l_reg;asm volatile("s_waitcnt lgkmcnt(0)":::"memory");
  float rli[16];
  #pragma unroll
  for(int r=0;r<16;++r)rli[r]=__builtin_amdgcn_rcpf(wsf[32+crow(r,hi)]);
  bf16*Ow=O+(rowbase+q0+wid*QBLK)*DMO+h*D;
  { bf16*stg=(bf16*)(shm+LDS_OST)+wid*2048;
    #pragma unroll
    for(int r=0;r<16;++r){const int orow=crow(r,hi);
      #pragma unroll
      for(int d0=0;d0<2;++d0)stg[orow*64+d0*32+r32]=__float2bfloat16(o[d0][r]*rli[r]);}
    asm volatile("s_waitcnt lgkmcnt(0)":::"memory");
    #pragma unroll
    for(int i=0;i<4;++i){const int row=i*8+(lane>>3),ch=lane&7; const u32x4 v=*(const u32x4*)(stg+row*64+ch*8); ATTN_STORE16(Ow+(long)row*DMO+ch*8,v);
      float sq=0.f;
      #pragma unroll
      for(int e=0;e<4;++e){const float lo_=__uint_as_float(v[e]<<16),hi_=__uint_as_float(v[e]&0xffff0000u); sq+=lo_*lo_+hi_*hi_;}
      sq+=__shfl_xor(sq,1); sq+=__shfl_xor(sq,2); sq+=__shfl_xor(sq,4);
      if(ch==0)SSA[(rowbase+q0+wid*QBLK+row)*8+h]=sq; } }
  asm volatile("s_waitcnt lgkmcnt(0)\n\ts_barrier":::"memory");
  #undef DMA_K
  #undef DMA_V
  #undef PHYS
  #undef CMASK
  #undef START
  #undef RESC
  #undef ROT
}
constexpr int ATTN_LDS_BYTES=LDS_BYTES;
struct AttnTensors { const bf16* Q; const bf16* K; const bf16* V; bf16* O; const float* KM; float* SSA; };
struct AttnUnit { int bh; int qb; };
struct StaticOrder {
  int vcu,G;
  __device__ __forceinline__ explicit StaticOrder(int grid,int block):vcu((grid%8==0)?((block%8)*(grid/8)+block/8):block),G(grid){}
  __device__ __forceinline__ bool next(int i,AttnUnit&u)const{ const int it=(i>>2)*G+vcu; if(it>=2*BATCH*NHEAD)return false; const int j=i&3,s=it&1; u.bh=it>>1; u.qb=s?((j==0)?6:(j==1)?5:(j==2)?2:1):((j==0)?7:(j==1)?4:(j==2)?3:0); return true; }
  __device__ __forceinline__ void a_ready(const AttnUnit&)const{}
  __device__ __forceinline__ void done(const AttnUnit&)const{}
};
__device__ __forceinline__ void attn_select(int b,int h,int qb,const bf16*Q,const float*__restrict__ KM,int ui,char*shm){
  int tid_=threadIdx.x; asm volatile("":"+v"(tid_)); const int tid=tid_,lane=tid&63,r32=lane&31,hi=lane>>5; const int wid=__builtin_amdgcn_readfirstlane(tid>>6);
  unsigned*selw=(unsigned*)(shm+LDS_SEL)+ui*QB+wid*QBLK+r32; float*kml=(float*)(shm+LDS_K);
  unsigned word=0xffffffffu;
  if(qb>3){
    if(tid<qb*64){ const long ki=((long)(b*NHEAD+h)*8)*64+tid; kml[tid]=(KM[ki]+KM[(long)BATCH*NHEAD*8*64+ki])*(1.0f/256.0f); }
    const bf16*qrow=Q+((long)b*SEQ+qb*QB+wid*QBLK+r32)*DM+h*D+hi*8; uint4 qv[4];
    #pragma unroll
    for(int d0=0;d0<4;++d0)qv[d0]=*reinterpret_cast<const uint4*>(qrow+d0*16);
    asm volatile("s_waitcnt vmcnt(0) lgkmcnt(0)\n\ts_barrier":::"memory");
    float g1=-3.0e38f,g2=-3.0e38f,g3=-3.0e38f; int i1=0,i2=0,i3=0;
    #pragma unroll 1
    for(int n=0;n<qb;++n){ const float*km=kml+n*64+hi*8; float a=0.f;
      #pragma unroll
      for(int d0=0;d0<4;++d0){ const float4 k0=*(const float4*)(km+d0*16),k1=*(const float4*)(km+d0*16+4); const uint4 q4=qv[d0];
        a+=__uint_as_float(q4.x<<16)*k0.x+__uint_as_float(q4.x&0xffff0000u)*k0.y+__uint_as_float(q4.y<<16)*k0.z+__uint_as_float(q4.y&0xffff0000u)*k0.w
          +__uint_as_float(q4.z<<16)*k1.x+__uint_as_float(q4.z&0xffff0000u)*k1.y+__uint_as_float(q4.w<<16)*k1.z+__uint_as_float(q4.w&0xffff0000u)*k1.w; }
      a+=__shfl_xor(a,32);
      if(a>g1){g3=g2;i3=i2;g2=g1;i2=i1;g1=a;i1=n;} else if(a>g2){g3=g2;i3=i2;g2=a;i2=n;} else if(a>g3){g3=a;i3=n;} }
    word=0x80000000u|(1u<<i1)|(1u<<i2)|(1u<<i3); }
  if(hi==0)*selw=word;
  asm volatile("s_waitcnt lgkmcnt(0)\n\ts_barrier":::"memory");
}
__device__ __forceinline__ int attn_qb(int role,int j){ return role?((j==0)?5:(j==1)?4:(j==2)?2:0):((j==0)?7:(j==1)?6:(j==2)?3:1); }
template<int THRL=8> __device__ __forceinline__ void attn_item(char*lds,const AttnTensors&T,int it){
  const int bh=it>>1,role=it&1,b=bh/NHEAD,h=bh%NHEAD; const int nu=4;
  for(int j=0;j<nu;++j)attn_select(b,h,attn_qb(role,j),T.Q,T.KM,j,lds);
  for(int j=0;j<nu;++j)attn_unit<THRL>(b,h,attn_qb(role,j),T.Q,T.K,T.V,T.O,T.SSA,j,lds);
}
template<class Sched,int THRL=8> __device__ __forceinline__ void attn_phase(char*lds,const AttnTensors&T,const Sched&S){
  AttnUnit u;
  for(int i=0;i<16&&S.next(i,u);++i)attn_select(u.bh/NHEAD,u.bh%NHEAD,u.qb,T.Q,T.KM,i,lds);
  for(int i=0;i<16&&S.next(i,u);++i){ S.a_ready(u); attn_unit<THRL>(u.bh/NHEAD,u.bh%NHEAD,u.qb,T.Q,T.K,T.V,T.O,T.SSA,i,lds); S.done(u); }
}
#undef SBAR
#undef WAIT_BAR
}

namespace cross_body {
typedef short bf16x8 __attribute__((ext_vector_type(8)));
typedef float f32x4 __attribute__((ext_vector_type(4)));
typedef unsigned u32x2 __attribute__((ext_vector_type(2)));
typedef unsigned u32x4 __attribute__((ext_vector_type(4)));
#define CB_LAS __attribute__((address_space(3)))
constexpr int TILE_OFF = 0, PW_OFF = 65536, LDS_BYTES = 65536 + 8 * 8192;
#define CB_BAR() asm volatile("s_waitcnt lgkmcnt(0)\n\ts_barrier" ::: "memory")
#define CB_VMWAIT() asm volatile("s_waitcnt vmcnt(0)" ::: "memory")
__device__ __forceinline__ void cross_stage(CB_LAS unsigned char* buf, const unsigned short* KC, const unsigned short* VT, int b, int hd, int i, int wid, const unsigned (&voK)[4], const unsigned (&voV)[4]) {
    if (i < 4) { const unsigned short* base = KC + (size_t)(b * 256 + 64 * i) * 1024 + hd * 256;
#pragma unroll
        for (int q = 0; q < 4; ++q) __builtin_amdgcn_global_load_lds((const unsigned*)(base + voK[q]), (CB_LAS unsigned*)(buf + (wid * 4 + q) * 1024), 16, 0, 0);
    } else { const unsigned short* base = VT + (size_t)(hd * 256) * 4096 + b * 256 + 64 * (i - 4);
#pragma unroll
        for (int q = 0; q < 4; ++q) __builtin_amdgcn_global_load_lds((const unsigned*)(base + voV[q]), (CB_LAS unsigned*)(buf + (wid * 4 + q) * 1024), 16, 0, 0);
    }
}
__device__ __forceinline__ void cross_unit(CB_LAS unsigned char* lds, const unsigned short* QC, const unsigned short* KC, const unsigned short* VT, unsigned short* OC, int b, int hd, int t0, bf16x8 (&qf)[8], bool first, bool has_next, int nb_, int nhd, int nt0, int zz = 0) {
    const int tid = threadIdx.x + zz, lane = tid & 63, n = lane & 15, g = lane >> 4; const int wid = __builtin_amdgcn_readfirstlane(tid >> 6);
    CB_LAS unsigned char* pw = lds + PW_OFF + wid * 8192;
    unsigned voK[4], voV[4];
#pragma unroll
    for (int q = 0; q < 4; ++q) { const int off = (wid * 4 + q) * 1024 + lane * 16; { const int row = off >> 9, c = (off >> 4) & 31, sc = c ^ (row & 15); voK[q] = (unsigned)(row * 1024 + 8 * sc); }
        { const int row = off >> 7, c = (off >> 4) & 7, sc = c ^ ((row >> 1) & 7); voV[q] = (unsigned)(row * 4096 + 8 * sc); } }
    if (first) {
        CB_BAR();
        cross_stage(lds + TILE_OFF, KC, VT, b, hd, 0, wid, voK, voV);
        const unsigned short* qrow = QC + (size_t)(t0 + wid * 16 + n) * 1024 + hd * 256 + 8 * g;
#pragma unroll
        for (int ks = 0; ks < 8; ++ks) qf[ks] = *(const bf16x8*)(qrow + 32 * ks);
    }
    f32x4 s[16];
#pragma unroll
    for (int i = 0; i < 16; ++i) s[i] = (f32x4){0.f, 0.f, 0.f, 0.f};
#pragma unroll
    for (int kt = 0; kt < 4; ++kt) {
        CB_LAS unsigned char* tile = lds + TILE_OFF + (kt & 1) * 32768;
        CB_VMWAIT(); CB_BAR();
        cross_stage(lds + TILE_OFF + ((kt + 1) & 1) * 32768, KC, VT, b, hd, kt + 1, wid, voK, voV);
#pragma unroll
        for (int nb = 0; nb < 4; ++nb) { const int row = 16 * nb + n;
#pragma unroll
            for (int ks = 0; ks < 8; ++ks) { const bf16x8 kf = *(const CB_LAS bf16x8*)(tile + row * 512 + (((4 * ks + g) ^ (row & 15)) << 4));
                s[kt * 4 + nb] = __builtin_amdgcn_mfma_f32_16x16x32_bf16(kf, qf[ks], s[kt * 4 + nb], 0, 0, 0); }
            if (nb & 1) __builtin_amdgcn_sched_barrier(0); }
    }
    float mx = -3.0e38f;
#pragma unroll
    for (int i = 0; i < 16; ++i) mx = fmaxf(mx, fmaxf(fmaxf(s[i][0], s[i][1]), fmaxf(s[i][2], s[i][3])));
    mx = fmaxf(mx, __shfl_xor(mx, 16)); mx = fmaxf(mx, __shfl_xor(mx, 32));
    const float c2 = 0.0625f * 1.4426950408889634f; float l = 0.f;
#pragma unroll
    for (int i = 0; i < 16; ++i) {
        f32x4 p; p[0] = __builtin_amdgcn_exp2f((s[i][0] - mx) * c2); p[1] = __builtin_amdgcn_exp2f((s[i][1] - mx) * c2); p[2] = __builtin_amdgcn_exp2f((s[i][2] - mx) * c2); p[3] = __builtin_amdgcn_exp2f((s[i][3] - mx) * c2);
        l += (p[0] + p[1]) + (p[2] + p[3]);
        u32x2 w; w.x = pg8::cvt_pk_bf16(p[0], p[1]); w.y = pg8::cvt_pk_bf16(p[2], p[3]);
        *(CB_LAS u32x2*)(pw + n * 512 + (((2 * i + (g >> 1)) ^ n) << 4) + ((g & 1) << 3)) = w;
    }
    l += __shfl_xor(l, 16); l += __shfl_xor(l, 32);
    const float linv = 1.0f / l;
    f32x4 o[16];
#pragma unroll
    for (int i = 0; i < 16; ++i) o[i] = (f32x4){0.f, 0.f, 0.f, 0.f};
#pragma unroll
    for (int kt = 0; kt < 4; ++kt) {
        CB_LAS unsigned char* tile = lds + TILE_OFF + (kt & 1) * 32768;
        CB_VMWAIT(); CB_BAR();
        if (kt < 3) cross_stage(lds + TILE_OFF + ((kt + 1) & 1) * 32768, KC, VT, b, hd, 5 + kt, wid, voK, voV);
        else if (has_next) {
            cross_stage(lds + TILE_OFF, KC, VT, nb_, nhd, 0, wid, voK, voV);
            const unsigned short* qrow = QC + (size_t)(nt0 + wid * 16 + n) * 1024 + nhd * 256 + 8 * g;
#pragma unroll
            for (int ks = 0; ks < 8; ++ks) qf[ks] = *(const bf16x8*)(qrow + 32 * ks); }
        bf16x8 pf[2];
#pragma unroll
        for (int ks = 0; ks < 2; ++ks) pf[ks] = *(const CB_LAS bf16x8*)(pw + n * 512 + (((8 * kt + 4 * ks + g) ^ n) << 4));
#pragma unroll
        for (int db = 0; db < 16; ++db) { const int row = 16 * db + n;
#pragma unroll
            for (int ks = 0; ks < 2; ++ks) { const bf16x8 vf = *(const CB_LAS bf16x8*)(tile + row * 128 + (((4 * ks + g) ^ ((row >> 1) & 7)) << 4));
                o[db] = __builtin_amdgcn_mfma_f32_16x16x32_bf16(vf, pf[ks], o[db], 0, 0, 0); }
            if ((db & 7) == 7) __builtin_amdgcn_sched_barrier(0); }
    }
    asm volatile("s_waitcnt lgkmcnt(0)" ::: "memory");
#pragma unroll
    for (int db = 0; db < 16; ++db) { u32x2 w; w.x = pg8::cvt_pk_bf16(o[db][0] * linv, o[db][1] * linv); w.y = pg8::cvt_pk_bf16(o[db][2] * linv, o[db][3] * linv);
        *(CB_LAS u32x2*)(pw + n * 512 + (((2 * db + (g >> 1)) ^ n) << 4) + ((g & 1) << 3)) = w; }
    asm volatile("s_waitcnt lgkmcnt(0)" ::: "memory");
#pragma unroll
    for (int i = 0; i < 8; ++i) { const int row = 2 * i + (lane >> 5), c = lane & 31; const u32x4 v = *(const CB_LAS u32x4*)(pw + row * 512 + ((c ^ row) << 4));
        *(u32x4*)(OC + (size_t)(t0 + wid * 16 + row) * 1024 + hd * 256 + 8 * c) = v; }
    asm volatile("s_waitcnt lgkmcnt(0)" ::: "memory");
}
__device__ __forceinline__ void cross_phase(CB_LAS unsigned char* lds, const unsigned short* QC, const unsigned short* KC, const unsigned short* VT, unsigned short* OC, int vcu, int G) {
    bf16x8 qf[8]; bool first = true;
    for (int u = vcu; u < 16 * 4 * 16; u += G) { const int tt = u & 15, hd = (u >> 4) & 3, b = u >> 6; const int un = u + G; const bool hn = un < 16 * 4 * 16;
        cross_unit(lds, QC, KC, VT, OC, b, hd, b * 2048 + tt * 128, qf, first, hn, un >> 6, (un >> 4) & 3, (un >> 6) * 2048 + (un & 15) * 128); first = false; }
    CB_VMWAIT(); CB_BAR();
}
#undef CB_BAR
#undef CB_VMWAIT
#undef CB_LAS
}

namespace route_body {
typedef short bf16x8 __attribute__((ext_vector_type(8)));
typedef float f32x4 __attribute__((ext_vector_type(4)));
typedef unsigned u32x2 __attribute__((ext_vector_type(2)));
typedef unsigned u32x4 __attribute__((ext_vector_type(4)));
#define RB_LAS __attribute__((address_space(3)))
constexpr int SUB_OFF = 0, LIST_OFF = 65536, LDS_BYTES = 65536 + 8 * 2048;
__device__ __forceinline__ unsigned ordf(float f) { const unsigned u = __float_as_uint(f); return (u & 0x80000000u) ? ~u : (u | 0x80000000u); }
__device__ __forceinline__ float unordf(unsigned k) { return __uint_as_float((k & 0x80000000u) ? (k ^ 0x80000000u) : ~k); }
__device__ __forceinline__ unsigned umax_(unsigned a, unsigned b) { return a > b ? a : b; }
__device__ __forceinline__ unsigned umin_(unsigned a, unsigned b) { return a < b ? a : b; }
#define RB_CE(x, i, l) do { const unsigned hi_ = umax_(x[i], x[l]), lo_ = umin_(x[i], x[l]); x[i] = hi_; x[l] = lo_; } while (0)
#define RB_CEA(x, i, l) do { const unsigned hi_ = umax_(x[i], x[l]), lo_ = umin_(x[i], x[l]); x[i] = lo_; x[l] = hi_; } while (0)
__device__ __forceinline__ void sort16(unsigned (&x)[16]) {
#pragma unroll
    for (int p = 1; p < 16; p <<= 1)
#pragma unroll
        for (int k = p; k >= 1; k >>= 1)
#pragma unroll
            for (int j = k % p; j <= 15 - k; j += 2 * k)
#pragma unroll
                for (int i = 0; i <= ((k - 1) < (15 - j - k) ? (k - 1) : (15 - j - k)); ++i)
                    if ((i + j) / (2 * p) == (i + j + k) / (2 * p)) RB_CE(x, i + j, i + j + k);
}
__device__ __forceinline__ void bmerge16(unsigned (&x)[16]) {
#pragma unroll
    for (int j = 8; j > 0; j >>= 1)
#pragma unroll
        for (int i = 0; i < 16; ++i) { const int l = i ^ j; if (l > i) RB_CE(x, i, l); }
}
__device__ __forceinline__ void mergetop(unsigned (&a)[16], const unsigned (&b)[16]) {
#pragma unroll
    for (int i = 0; i < 16; ++i) a[i] = umax_(a[i], b[15 - i]);
    bmerge16(a);
}
__device__ __forceinline__ void xmergetop(unsigned (&a)[16], int mask) {
    unsigned b[16];
#pragma unroll
    for (int i = 0; i < 16; ++i) b[i] = (unsigned)__shfl_xor((int)a[i], mask);
    mergetop(a, b);
}
__device__ __forceinline__ unsigned cand(float fa, float fb, int i, int j) { return (ordf(fa + fb) & ~0xFFu) | (unsigned)(255 - (i * 16 + j)); }

struct StrideTiles { int first, step, n; __device__ __forceinline__ int count() const { return n; } __device__ __forceinline__ int at(int k) const { return first + k * step; } };
struct PanelTiles { int pm0, pm1; __device__ __forceinline__ int count() const { return 4; } __device__ __forceinline__ int at(int k) const { return 2 * ((k >> 1) ? pm1 : pm0) + (k & 1); } };
template <class ST, class TT> __device__ __forceinline__ void route_phase(RB_LAS unsigned char* lds, const unsigned short* PQ, const unsigned short* SUBK, unsigned short* IDS, float* GATES, int h, const TT& tts, ST& st, bool drain) {
    const int tid = threadIdx.x, lane = tid & 63, n = lane & 15, g = lane >> 4; const int wid = __builtin_amdgcn_readfirstlane(tid >> 6);
    RB_LAS unsigned char* sub = lds + SUB_OFF; RB_LAS unsigned* lst = (RB_LAS unsigned*)(lds + LIST_OFF + wid * 2048) + n * 32;
    __syncthreads();
#pragma unroll
    for (int i = 0; i < 8; ++i) { const int off = (wid * 8 + i) * 1024 + lane * 16, R = off >> 8, c = (off >> 4) & 15, sc = c ^ (R & 15);
        __builtin_amdgcn_global_load_lds((const unsigned*)(SUBK + ((size_t)h * 256 + R) * 128 + 8 * sc), (RB_LAS unsigned*)(sub + (wid * 8 + i) * 1024), 16, 0, 0); }
    asm volatile("s_waitcnt vmcnt(0)" ::: "memory");
    __syncthreads();
    for (int ti = 0; ti < tts.count(); ++ti) { const int tt = tts.at(ti);
        const int t = tt * 128 + wid * 16 + n;
        bf16x8 qf[8];
        { const unsigned short* qrow = PQ + (size_t)t * 2048 + h * 256 + 8 * g;
#pragma unroll
          for (int ks = 0; ks < 8; ++ks) qf[ks] = *(const bf16x8*)(qrow + 32 * ks); }
        unsigned key[2][2][16];
#pragma unroll
        for (int p = 0; p < 2; ++p)
#pragma unroll
            for (int kblk = 0; kblk < 8; ++kblk) { const int R = p * 128 + 16 * kblk + n; f32x4 s = (f32x4){0.f, 0.f, 0.f, 0.f};
#pragma unroll
                for (int ks = 0; ks < 4; ++ks) { const bf16x8 kf = *(const RB_LAS bf16x8*)(sub + R * 256 + (((4 * ks + g) ^ (R & 15)) << 4));
                    s = __builtin_amdgcn_mfma_f32_16x16x32_bf16(kf, qf[p * 4 + ks], s, 0, 0, 0); }
#pragma unroll
                for (int r = 0; r < 4; ++r) key[p][kblk >> 2][(kblk & 3) * 4 + r] = (ordf(s[r]) & ~0x7Fu) | (unsigned)(127 - (16 * kblk + 4 * g + r)); }
        const bool shave = st.k < st.count; if (shave) st.issue(st.k);
        unsigned top[2][16];
#pragma unroll
        for (int p = 0; p < 2; ++p) {
            sort16(key[p][0]); sort16(key[p][1]); mergetop(key[p][0], key[p][1]); xmergetop(key[p][0], 16); xmergetop(key[p][0], 32);
#pragma unroll
            for (int i = 0; i < 16; ++i) top[p][i] = key[p][0][i];
        }
#pragma unroll
        for (int r = 0; r < 4; ++r) { const unsigned va = g == 0 ? top[0][r] : g == 1 ? top[0][4 + r] : g == 2 ? top[0][8 + r] : top[0][12 + r];
            const unsigned vb = g == 0 ? top[1][r] : g == 1 ? top[1][4 + r] : g == 2 ? top[1][8 + r] : top[1][12 + r]; lst[4 * g + r] = va; lst[16 + 4 * g + r] = vb; }
        float fa[16], fb[16];
#pragma unroll
        for (int i = 0; i < 16; ++i) { fa[i] = unordf(top[0][i] & ~0x7Fu); fb[i] = unordf(top[1][i] & ~0x7Fu); }
        unsigned c[16];
#pragma unroll
        for (int i = 0; i < 16; ++i) c[i] = 0u;
        if (g == 0) {
#pragma unroll
            for (int j = 0; j < 16; ++j) c[j] = cand(fa[0], fb[j], 0, j);
        } else if (g == 1) {
#pragma unroll
            for (int j = 0; j < 8; ++j) c[j] = cand(fa[1], fb[j], 1, j);
#pragma unroll
            for (int j = 0; j < 3; ++j) c[8 + j] = cand(fa[4], fb[j], 4, j);
            c[11] = cand(fa[8], fb[0], 8, 0); c[12] = cand(fa[9], fb[0], 9, 0); c[13] = cand(fa[10], fb[0], 10, 0);
        } else if (g == 2) {
#pragma unroll
            for (int j = 0; j < 5; ++j) c[j] = cand(fa[2], fb[j], 2, j);
#pragma unroll
            for (int j = 0; j < 4; ++j) c[5 + j] = cand(fa[3], fb[j], 3, j);
#pragma unroll
            for (int i = 11; i < 16; ++i) c[9 + (i - 11)] = cand(fa[i], fb[0], i, 0);
        } else {
#pragma unroll
            for (int i = 5; i < 8; ++i) { c[2 * (i - 5)] = cand(fa[i], fb[0], i, 0); c[2 * (i - 5) + 1] = cand(fa[i], fb[1], i, 1); }
        }
        sort16(c); xmergetop(c, 16); xmergetop(c, 32);
        const float mxs = unordf(c[0] & ~0xFFu);
        asm volatile("s_waitcnt lgkmcnt(0)" ::: "memory");
        unsigned ids[4]; float pe[4]; float ls = 0.f;
#pragma unroll
        for (int r = 0; r < 4; ++r) { const unsigned key = g == 0 ? c[r] : g == 1 ? c[4 + r] : g == 2 ? c[8 + r] : c[12 + r]; const int pos = 255 - (int)(key & 0xFFu);
            const unsigned ka_ = lst[pos >> 4], kb_ = lst[16 + (pos & 15)];
            ids[r] = (127u - (ka_ & 0x7Fu)) * 128u + (127u - (kb_ & 0x7Fu));
            const float sv = unordf(ka_ & ~0x7Fu) + unordf(kb_ & ~0x7Fu); pe[r] = __builtin_amdgcn_exp2f((sv - mxs) * 1.4426950408889634f); ls += pe[r]; }
        ls += __shfl_xor(ls, 16); ls += __shfl_xor(ls, 32);
        const float linv = 1.0f / ls;
#pragma unroll
        for (int r = 0; r < 4; ++r) { const int k = 4 * g + r; IDS[(size_t)t * 128 + (k & 7) * 16 + 2 * h + (k >> 3)] = (unsigned short)ids[r]; }
        *(f32x4*)(GATES + (size_t)t * 128 + h * 16 + 4 * g) = (f32x4){pe[0] * linv, pe[1] * linv, pe[2] * linv, pe[3] * linv};
        asm volatile("s_waitcnt lgkmcnt(0)" ::: "memory");
        if (shave) { st.finish(st.k); ++st.k; }
    }
    __syncthreads();
    if (drain && st.k < st.count) {
        RB_LAS unsigned char* const bA = st.buf; RB_LAS unsigned char* const sA = st.sbuf; RB_LAS unsigned char* const bB = lds + SUB_OFF + wid * 8192; RB_LAS unsigned char* const sB = lds + LIST_OFF + wid * 256;
        st.issue(st.k);
        for (int par = 0; st.k < st.count; ++st.k, par ^= 1) {
            if (st.k + 1 < st.count) { st.buf = par ? bA : bB; st.sbuf = par ? sA : sB; st.issue(st.k + 1); if (st.item_of(st.k + 1) < 16384) asm volatile("s_waitcnt vmcnt(4)" ::: "memory"); else asm volatile("s_waitcnt vmcnt(9)" ::: "memory"); } else asm volatile("s_waitcnt vmcnt(0)" ::: "memory");
            st.buf = par ? bB : bA; st.sbuf = par ? sB : sA; st.template finish<false>(st.k); }
        st.buf = bA; st.sbuf = sA; }
    __syncthreads();
}
#undef RB_CE
#undef RB_CEA
#undef RB_LAS
}

namespace lru_body {
typedef short bf16x8 __attribute__((ext_vector_type(8)));
typedef float f32x4 __attribute__((ext_vector_type(4)));
typedef unsigned u32x4 __attribute__((ext_vector_type(4)));
#define LB_LAS __attribute__((address_space(3)))
#define LB_BAR() asm volatile("s_waitcnt lgkmcnt(0)\n\ts_barrier" ::: "memory")
#define LB_LDSWAIT() do { asm volatile("s_waitcnt lgkmcnt(0)" ::: "memory"); __builtin_amdgcn_sched_barrier(0); } while (0)
constexpr int XS_OFF = 0  , XC_OFF = 17408  , WT_OFF = 33792  , RI_OFF = 50176  , EX_OFF = 119808  , LDS_BYTES = 123904;
constexpr int RSTR = 68;
__device__ __forceinline__ float bf(unsigned short b) { return __uint_as_float(((unsigned)b) << 16); }
__device__ __forceinline__ float sigm(float v) { return __builtin_amdgcn_rcpf(1.0f + __builtin_amdgcn_exp2f(-1.4426950408889634f * v)); }
__device__ __forceinline__ float gelu_as(float v) {
    const float av = fabsf(v), t = __builtin_amdgcn_rcpf(1.0f + 0.2316418882f * av);
    float q = t * 0.5307027145f + (-0.7265760135f); q = q * t + 0.7107068705f; q = q * t + (-0.142248368f); q = q * t + 0.127414796f; q = q * t;
    const float e = __builtin_amdgcn_exp2f(v * v * (-0.72134752044f)); const float m = v * (q * e); return v < 0.f ? m : v - m;
}
typedef float f32x2 __attribute__((ext_vector_type(2)));
__device__ __forceinline__ f32x2 exp2_2(f32x2 v) { return (f32x2){__builtin_amdgcn_exp2f(v.x), __builtin_amdgcn_exp2f(v.y)}; }
__device__ __forceinline__ f32x2 rcp_2(f32x2 v) { return (f32x2){__builtin_amdgcn_rcpf(v.x), __builtin_amdgcn_rcpf(v.y)}; }
__device__ __forceinline__ f32x2 sqrt_2(f32x2 v) { return (f32x2){__builtin_amdgcn_sqrtf(v.x), __builtin_amdgcn_sqrtf(v.y)}; }
__device__ __forceinline__ f32x2 splat2(float v) { return (f32x2){v, v}; }
__device__ __forceinline__ f32x2 gelu_as2(f32x2 v) {
    const f32x2 av = (f32x2){fabsf(v.x), fabsf(v.y)}, t = rcp_2(splat2(1.0f) + splat2(0.2316418882f) * av);
    f32x2 q = t * splat2(0.5307027145f) + splat2(-0.7265760135f); q = q * t + splat2(0.7107068705f); q = q * t + splat2(-0.142248368f); q = q * t + splat2(0.127414796f); q = q * t;
    const f32x2 e = exp2_2(v * v * splat2(-0.72134752044f)); const f32x2 m = v * (q * e); const f32x2 d = v - m;
    return (f32x2){v.x < 0.f ? m.x : d.x, v.y < 0.f ? m.y : d.y};
}
__device__ __forceinline__ void lru_item(LB_LAS unsigned char* lds, int b, int blk, const unsigned short* PROJ, unsigned short* MIXED, float* SSL, const float* conv_w, const float* conv_b, const float* wa, const float* ba_, const float* wx,
                                         const float* bx_, const float* lam) {
    int tid_ = threadIdx.x; asm volatile("" : "+v"(tid_)); const int tid = tid_, c = tid & 63, n = tid & 15, g = (tid >> 4) & 3; const int s = __builtin_amdgcn_readfirstlane(tid >> 6);
    const int cb = blk * 64;
    LB_LAS unsigned short* XS = (LB_LAS unsigned short*)(lds + XS_OFF); LB_LAS unsigned char* XC = lds + XC_OFF; LB_LAS unsigned char* WT = lds + WT_OFF;
    LB_LAS float* RI = (LB_LAS float*)(lds + RI_OFF); LB_LAS float* EX = (LB_LAS float*)(lds + EX_OFF);
    __syncthreads();
    for (int i = tid; i < 2 * 4096; i += 512) { const int mat = i >> 12, d = (i >> 6) & 63, e = i & 63; const float v = (mat ? wx : wa)[(size_t)(blk * 64 + d) * 64 + e];
        *(LB_LAS unsigned short*)(WT + mat * 8192 + e * 128 + ((((d >> 3) ^ ((e >> 1) & 7))) << 4) + (d & 7) * 2) = (unsigned short)f2bf(v); }
    const float w0 = conv_w[0 * 512 + cb + c], w1 = conv_w[1 * 512 + cb + c], w2 = conv_w[2 * 512 + cb + c], w3 = conv_w[3 * 512 + cb + c], cbias = conv_b[cb + c];
    const float ba = ba_[cb + c], bx = bx_[cb + c], sp8 = 8.0f * log1pf(expf(-lam[cb + c]));
    const size_t tbase = (size_t)b * 2048;
    u32x4 xv[3];
#define LB_XLOAD(T0) do { _Pragma("unroll") for (int p_ = 0; p_ < 3; ++p_) { const int idx_ = tid + 512 * p_, row_ = idx_ >> 3, ch_ = idx_ & 7; const long tok_ = (long)(T0) - 3 + row_; \
        xv[p_] = (u32x4){0u, 0u, 0u, 0u}; if (row_ < 131 && tok_ >= 0) xv[p_] = *(const u32x4*)(PROJ + (tbase + tok_) * 2560 + cb + 8 * ch_); } } while (0)
#define LB_XSTORE() do { _Pragma("unroll") for (int p_ = 0; p_ < 3; ++p_) { const int idx_ = tid + 512 * p_, row_ = idx_ >> 3, ch_ = idx_ & 7; if (row_ < 131) *(LB_LAS u32x4*)(XS + row_ * 64 + 8 * ch_) = xv[p_]; } } while (0)
    LB_XLOAD(0); LB_XSTORE();
    float carry = 0.f;
    for (int k = 0; k < 16; ++k) {
        const int T0 = 128 * k;
        LB_BAR();
        unsigned short gt[16];
#pragma unroll
        for (int i = 0; i < 16; ++i) gt[i] = PROJ[(tbase + T0 + 16 * s + i) * 2560 + 512 + cb + c];
        float xc[16];
        { float xs[19];
          unsigned short xr[19];
#pragma unroll
          for (int j = 0; j < 19; ++j) xr[j] = XS[(16 * s + j) * 64 + c];
          LB_LDSWAIT();
#pragma unroll
          for (int j = 0; j < 19; ++j) xs[j] = bf(xr[j]);
#pragma unroll
          for (int i = 0; i < 16; i += 2) { const f32x2 r = splat2(cbias) + splat2(w0) * (f32x2){xs[i], xs[i + 1]} + splat2(w1) * (f32x2){xs[i + 1], xs[i + 2]} + splat2(w2) * (f32x2){xs[i + 2], xs[i + 3]} + splat2(w3) * (f32x2){xs[i + 3], xs[i + 4]};
              xc[i] = r.x; xc[i + 1] = r.y; const unsigned w = pg8::cvt_pk_bf16(r.x, r.y); const int tok = 16 * s + i;
              *(LB_LAS unsigned short*)(XC + tok * 128 + ((((c >> 3) ^ ((tok >> 1) & 7))) << 4) + (c & 7) * 2) = (unsigned short)w;
              *(LB_LAS unsigned short*)(XC + (tok + 1) * 128 + ((((c >> 3) ^ ((tok >> 1) & 7))) << 4) + (c & 7) * 2) = (unsigned short)(w >> 16); } }
        LB_BAR();
        if (k + 1 < 16) LB_XLOAD(T0 + 128);
        { bf16x8 af[2], wf[2][4][2]; f32x4 acc[2][4];
#pragma unroll
          for (int ks = 0; ks < 2; ++ks) { const int row = 16 * s + n; af[ks] = *(const LB_LAS bf16x8*)(XC + row * 128 + (((4 * ks + g) ^ ((row >> 1) & 7)) << 4)); }
#pragma unroll
          for (int mat = 0; mat < 2; ++mat)
#pragma unroll
            for (int nt = 0; nt < 4; ++nt)
#pragma unroll
                for (int ks = 0; ks < 2; ++ks) { const int row = 16 * nt + n; wf[mat][nt][ks] = *(const LB_LAS bf16x8*)(WT + mat * 8192 + row * 128 + (((4 * ks + g) ^ ((row >> 1) & 7)) << 4)); }
#pragma unroll
          for (int mat = 0; mat < 2; ++mat)
#pragma unroll
            for (int nt = 0; nt < 4; ++nt) { acc[mat][nt] = __builtin_amdgcn_mfma_f32_16x16x32_bf16(af[0], wf[mat][nt][0], (f32x4){0.f, 0.f, 0.f, 0.f}, 0, 0, 0);
                acc[mat][nt] = __builtin_amdgcn_mfma_f32_16x16x32_bf16(af[1], wf[mat][nt][1], acc[mat][nt], 0, 0, 0); }
#pragma unroll
          for (int mat = 0; mat < 2; ++mat)
#pragma unroll
            for (int nt = 0; nt < 4; ++nt)
#pragma unroll
                for (int r = 0; r < 4; ++r) RI[mat * 128 * RSTR + (16 * s + 4 * g + r) * RSTR + 16 * nt + n] = acc[mat][nt][r]; }
        LB_BAR();
        float av[16], bv[16]; float A = 1.f, B = 0.f;
        { float pr[16], pi[16];
#pragma unroll
          for (int i = 0; i < 16; ++i) { const int tok = 16 * s + i; pr[i] = RI[tok * RSTR + c]; pi[i] = RI[128 * RSTR + tok * RSTR + c]; }
          LB_LDSWAIT();
          const f32x2 nl2 = splat2(-1.4426950408889634f), one2 = splat2(1.0f), nsp2 = splat2(-1.4426950408889634f * sp8);
#pragma unroll
          for (int i = 0; i < 16; i += 2) {
            const f32x2 gr = rcp_2(one2 + exp2_2(nl2 * ((f32x2){pr[i], pr[i + 1]} + splat2(ba)))), gi = rcp_2(one2 + exp2_2(nl2 * ((f32x2){pi[i], pi[i + 1]} + splat2(bx))));
            const f32x2 a = exp2_2(nsp2 * gr); f32x2 om = one2 - a * a; om = (f32x2){fmaxf(om.x, 0.f), fmaxf(om.y, 0.f)};
            const f32x2 b = sqrt_2(om) * (gi * (f32x2){xc[i], xc[i + 1]});
            av[i] = a.x; av[i + 1] = a.y; bv[i] = b.x; bv[i + 1] = b.y; A *= a.x; B = a.x * B + b.x; A *= a.y; B = a.y * B + b.y; } }
        EX[(s * 64 + c) * 2] = A; EX[(s * 64 + c) * 2 + 1] = B;
        LB_BAR();
        float hin = carry, hall = carry;
        { float ea[8], eb[8];
#pragma unroll
          for (int w = 0; w < 8; ++w) { ea[w] = EX[(w * 64 + c) * 2]; eb[w] = EX[(w * 64 + c) * 2 + 1]; }
          LB_LDSWAIT();
#pragma unroll
          for (int w = 0; w < 8; ++w) { hall = ea[w] * hall + eb[w]; if (w < s) hin = hall; } }
        carry = hall;
        float h = hin;
        float sq[16];
#pragma unroll
        for (int i = 0; i < 16; i += 2) { const float h0 = av[i] * h + bv[i]; h = av[i + 1] * h0 + bv[i + 1];
            const f32x2 y = (f32x2){h0, h} * gelu_as2((f32x2){bf(gt[i]), bf(gt[i + 1])}); const unsigned w = pg8::cvt_pk_bf16(y.x, y.y);
            MIXED[(tbase + T0 + 16 * s + i) * 1024 + cb + c] = (unsigned short)w; MIXED[(tbase + T0 + 16 * s + i + 1) * 1024 + cb + c] = (unsigned short)(w >> 16);
            const f32x2 yf = (f32x2){__uint_as_float(w << 16), __uint_as_float(w & 0xffff0000u)}; const f32x2 q2 = yf * yf; sq[i] = q2.x; sq[i + 1] = q2.y; }
        {
          const bool h3 = (c & 8) != 0, h2 = (c & 4) != 0; float r8[8], r4[4], r2[2], r1;
#pragma unroll
          for (int i = 0; i < 8; ++i) r8[i] = swap32_add(sq[i], sq[i + 8]);
#pragma unroll
          for (int i = 0; i < 4; ++i) r4[i] = swap16_add(r8[i], r8[i + 4]);
#pragma unroll
          for (int i = 0; i < 2; ++i) { const float sa = r4[i] + dpp_f<DPP_ROR8>(r4[i]), sb = r4[i + 2] + dpp_f<DPP_ROR8>(r4[i + 2]); r2[i] = h3 ? sb : sa; }
          { const float sa = r2[0] + dpp_f<DPP_HMIRROR>(r2[0]), sb = r2[1] + dpp_f<DPP_HMIRROR>(r2[1]); r1 = h2 ? sb : sa; }
          r1 += dpp_f<DPP_XOR2>(r1); r1 += dpp_f<DPP_XOR1>(r1);
          if ((c & 3) == 0) SSL[(tbase + T0 + 16 * s + (c >> 2)) * 8 + blk] = r1; }
        if (k + 1 < 16) LB_XSTORE();
    }
    __syncthreads();
#undef LB_XLOAD
#undef LB_XSTORE
}
#undef LB_BAR
#undef LB_LDSWAIT
#undef LB_LAS
}

struct QuadSync { gu32* cnt; unsigned* bar; unsigned gen; unsigned n; bool local; };
__device__ __forceinline__ void quad_sync(QuadSync& q) {
    asm volatile("s_waitcnt vmcnt(0)" ::: "memory");
    __syncthreads();
    ++q.gen;
    if (threadIdx.x == 0) {
        if (!q.local) { __builtin_amdgcn_fence(__ATOMIC_RELEASE, "agent"); asm volatile("s_waitcnt vmcnt(0)" ::: "memory"); }
        __hip_atomic_fetch_add(q.cnt, 1u, RLX_AGENT);
        const unsigned want = q.n * q.gen;
        XB_SPIN(xb_ld((unsigned*)q.cnt) < want, q.bar);
        __builtin_amdgcn_fence(__ATOMIC_ACQUIRE, "agent");
        asm volatile("s_waitcnt vmcnt(0)" ::: "memory");
    }
    __syncthreads();
}
struct QuadOrder { pg8::StaticOrder S;
    __device__ __forceinline__ bool next(int i, pg8::Unit& u) const { pg8::Unit v; if (!S.next(i >> 1, v)) return false; u.pm = v.pm; u.pn = 2 * v.pn + (i & 1); return true; }
    __device__ __forceinline__ void a_ready(const pg8::Unit&) const {}
    __device__ __forceinline__ void done(const pg8::Unit&) const {}
};
constexpr int NPHASE = 12;
#ifndef MK_ONE_LAUNCH
#define MK_ONE_LAUNCH 1
#endif
struct Args { const float* in[26]; float* out; unsigned char* ws; int ph_lo, ph_hi; };
__global__ void __launch_bounds__(NWAVES * 64, 2) mk_fwd(Args args) {
    extern __shared__ __attribute__((aligned(16))) unsigned char lds[];
    Frame F;
    F.lds = (LAS unsigned char*)lds;
    F.MISC = (volatile LAS unsigned*)(F.lds + MISC_OFF);
    F.tid = threadIdx.x; F.lane = F.tid & 63; F.wave = __builtin_amdgcn_readfirstlane(F.tid >> 6);
    F.G = gridDim.x; { const int bx = blockIdx.x; F.vcu = (F.G % 8 == 0) ? (bx % 8) * (F.G / 8) + bx / 8 : bx; }
    F.ws = args.ws; F.out = args.out; F.ctl = (gu32*)(args.ws + WS_CTL);
#pragma unroll
    for (int i = 0; i < 26; ++i) F.in[i] = args.in[i];
    for (int u = F.tid; u < (LDS_BYTES - LDSCTL_OFF) / 4; u += NWAVES * 64) ((LAS unsigned*)(F.lds + LDSCTL_OFF))[u] = 0u;
    __syncthreads();
    const int lo = args.ph_lo, hi = args.ph_hi;
    if (threadIdx.x == 0) __hip_atomic_store(F.ctl + CW_XID + blockIdx.x, xb_xcc_id() + 1u, RLX_AGENT);
    XcdBarrier bar; bar.bar = (unsigned*)(F.ctl + CW_BAR); bar.x = 0; bar.st = nullptr;
    if (hi - lo > 1) bar = xcd_barrier_post((unsigned*)(F.ctl + CW_BAR), F.MISC + 8);
#define IN(k) (lo <= (k) && (k) < hi)
#define SEAM(k) do { if (IN(k) && IN((k) + 1)) xcd_barrier(bar); } while (0)
#define QSEAM(k) do { if (IN(k) && IN((k) + 1)) { if (quad) quad_sync(qs); else xcd_barrier(bar); } } while (0)
    const bool quad = (F.G == 256) && (hi - lo > 1); QuadSync qs; qs.cnt = F.ctl + CW_QUAD + 64 * (blockIdx.x & 63); qs.bar = (unsigned*)(F.ctl + CW_BAR); qs.gen = 0u; qs.n = 4u; qs.local = false;
    QuadSync gs; gs.cnt = F.ctl + CW_G32 + 64 * (blockIdx.x & 7); gs.bar = qs.bar; gs.gen = 0u; gs.n = 32u; gs.local = false;
#define GSEAM(k) do { if (IN(k) && IN((k) + 1)) { if (quad) quad_sync(gs); else xcd_barrier(bar); } } while (0)
    bf16* Win_t = (bf16*)(F.ws + WS_WIN); bf16* Wout_t = (bf16*)(F.ws + WS_WOUT); bf16* Wcq_t = (bf16*)(F.ws + WS_WCQ); bf16* Wckv_t = (bf16*)(F.ws + WS_WCKV);
    bf16* Wco_t = (bf16*)(F.ws + WS_WCO); bf16* Wpq_t = (bf16*)(F.ws + WS_WPQ);
    bf16* H = (bf16*)(F.ws + WS_A); bf16* X1 = (bf16*)(F.ws + WS_A); bf16* PROJ = (bf16*)(F.ws + WS_B); bf16* QC = (bf16*)(F.ws + WS_B); bf16* OC = (bf16*)(F.ws + WS_B + 64 * MiB);
    bf16* MIXED = (bf16*)(F.ws + WS_C); bf16* X2 = (bf16*)(F.ws + WS_C); bf16* MEMN = (bf16*)(F.ws + WS_MEMN); bf16* KCVC = (bf16*)(F.ws + WS_KCVC); bf16* PQ = (bf16*)(F.ws + WS_E);
    float* SS1 = (float*)(F.ws + WS_SS1); float* SS2 = (float*)(F.ws + WS_SS2);

    if (quad && lo < 1) { unsigned same = 1u; const unsigned x0 = xb_ld((unsigned*)(F.ctl + CW_XID + (blockIdx.x & 7)));
        for (int j = 1; j < 32; ++j) same &= (xb_ld((unsigned*)(F.ctl + CW_XID + (blockIdx.x & 7) + 8 * j)) == x0) ? 1u : 0u;
        gs.local = (same != 0u) && (x0 != 0u); }
    if (IN(0)) { p0_prologue(F, quad && IN(1));
        if (quad && IN(1)) { quad_sync(gs);
            if (threadIdx.x == 0) { XB_SPIN(xb_ld((unsigned*)(F.ctl + CW_WCNT)) < (unsigned)F.G, qs.bar); __builtin_amdgcn_fence(__ATOMIC_ACQUIRE, "agent"); asm volatile("s_waitcnt vmcnt(0)" ::: "memory"); }
            __syncthreads(); }
        else SEAM(0); }
#define STAG_SPLIT(k, n) int a0, a1; table_share(F, k, n, a0, a1); const int am = a0 + ((((int)blockIdx.x >> 3) & 3) * (a1 - a0) + 1) / 3
#define STAG_BEFORE(WHICH, k, n) do { STAG_SPLIT(k, n); if (am > a0) convert_rows<WHICH>(F, a0, am < a1 ? am : a1); } while (0)
#define STAG_AFTER(WHICH, k, n) do { STAG_SPLIT(k, n); if (am < a1) convert_rows<WHICH>(F, am, a1); } while (0)
    if (IN(1)) {
        STAG_BEFORE(0, 0, 1);
        { pg8::Gemm g{H, Win_t, T, DIN, D}; pg8::StaticOrder S; S.init(T, DIN, F.G, (int)blockIdx.x); pg8::EpiStore E{PROJ, DIN, 4, 6, attn_body::C2, (float*)(F.ws + WS_KMEAN)};
          pg8::gemm_phase<pg8::EpiStore, pg8::StaticOrder, true, true>(F.lds + RING_OFF, g, S, E); }
        STAG_AFTER(0, 0, 1);
        GSEAM(1);
    }
    if (IN(2)) {
        const attn_body::AttnTensors AT{(const attn_body::bf16*)(PROJ + COL_Q), (const attn_body::bf16*)(PROJ + COL_K), (const attn_body::bf16*)(PROJ + COL_V), (attn_body::bf16*)(MIXED + DLRU), (const float*)(F.ws + WS_KMEAN), (float*)(F.ws + WS_SSA)};
        for (int it = F.vcu; it < 2 * BATCH * AH; it += F.G) {
            if (it & 1) lru_body::lru_item(F.lds + RING_OFF, (it >> 1) / LBLK, (it >> 1) % LBLK, PROJ, MIXED, (float*)(F.ws + WS_SSL), F.in[4], F.in[5], F.in[6], F.in[7], F.in[8], F.in[9], F.in[10]);
            else { int gi = it >> 1;
                if (quad) { const int x = it >> 5, e = (it & 31) >> 1; gi = (e < 8) ? 4 * (2 * x + (e >> 2)) + (e & 3) : 64 + 16 * ((e - 8) & 3) + 2 * x + ((e - 8) >> 2); }
                if (gi < 64) { pg8::Gemm g{MEMN, Wckv_t, TM, D, D}; pg8::OneUnit S{gi >> 2, gi & 3, true}; pg8::EpiStore E{KCVC, D, 0, 0, 1.0f, nullptr};
                    pg8::gemm_phase<pg8::EpiStore, pg8::OneUnit, true, true>(F.lds + RING_OFF, g, S, E); }
                else { pg8::Gemm g{Wckv_t + (size_t)D * D, MEMN, D, TM, D}; pg8::OneUnit S{(gi - 64) >> 4, (gi - 64) & 15, true}; pg8::EpiStore E{KCVC + (size_t)TM * D, TM, 0, 0, 1.0f, nullptr};
                    pg8::gemm_phase<pg8::EpiStore, pg8::OneUnit, true, true>(F.lds + RING_OFF, g, S, E); } }
            attn_body::attn_item((char*)lds + RING_OFF, AT, it); }
        GSEAM(2); }
    if (quad && IN(3) && lo < 3) { unsigned same = 1u; const unsigned x0 = xb_ld((unsigned*)(F.ctl + CW_XID + (blockIdx.x & 63)));
#pragma unroll
        for (int j = 1; j < 4; ++j) same &= (xb_ld((unsigned*)(F.ctl + CW_XID + (blockIdx.x & 63) + 64 * j)) == x0) ? 1u : 0u;
        qs.local = (same != 0u) && (x0 != 0u); }
    if (IN(3)) { pg8::Gemm g{MIXED, Wout_t, T, D, D}; pg8::StaticOrder S; S.init(T, D, F.G, (int)blockIdx.x); pg8::EpiResidGN E{F.in[0], X1, SS1, (const float*)(F.ws + WS_SSL), (const float*)(F.ws + WS_SSA), D, EPS};
        pg8::gemm_phase<pg8::EpiResidGN, pg8::StaticOrder, true, true>(F.lds + RING_OFF, g, S, E); QSEAM(3); }
    if (IN(4)) {
        pg8::Gemm g{X1, Wcq_t, T, D, D}; pg8::StaticOrder S; S.init(T, D, F.G, (int)blockIdx.x); pg8::EpiScale E{SS1, QC, D, EPS};
        pg8::gemm_phase<pg8::EpiScale, pg8::StaticOrder, true, true>(F.lds + RING_OFF, g, S, E);
        __builtin_amdgcn_fence(__ATOMIC_ACQUIRE, "agent");
        { cross_body::bf16x8 qf[8]; int zz = 0; asm volatile("" : "+s"(zz)); bool first = true;
          for (int i = 0; ; ++i) { pg8::Unit u, un; if (!S.next(i, u)) break; const bool more = S.next(i + 1, un);
              const int b = u.pm >> 3, t0 = u.pm * 256;
              cross_body::cross_unit(F.lds + RING_OFF, QC, KCVC, KCVC + (size_t)TM * D, OC, b, u.pn, t0, qf, first, true, b, u.pn, t0 + 128, zz);
              cross_body::cross_unit(F.lds + RING_OFF, QC, KCVC, KCVC + (size_t)TM * D, OC, b, u.pn, t0 + 128, qf, false, more, un.pm >> 3, un.pn, un.pm * 256, zz);
              first = false; }
          asm volatile("s_waitcnt vmcnt(0) lgkmcnt(0)\n\ts_barrier" ::: "memory"); }
        QSEAM(4); }
    if (IN(5)) { pg8::Gemm g{OC, Wco_t, T, D, D}; pg8::StaticOrder S; S.init(T, D, F.G, (int)blockIdx.x); pg8::EpiResid E{nullptr, X1, X2, SS2, D};
        pg8::gemm_phase<pg8::EpiResid, pg8::StaticOrder, true, true>(F.lds + RING_OFF, g, S, E); QSEAM(5); }
    if (IN(6)) { pg8::Gemm g{X2, Wpq_t, T, 2048, D}; pg8::EpiScale E{SS2, PQ, 2048, EPS};
        if (quad) { QuadOrder S; S.S.init(T, D, F.G, (int)blockIdx.x); pg8::gemm_phase<pg8::EpiScale, QuadOrder, true, true>(F.lds + RING_OFF, g, S, E); }
        else { pg8::StaticOrder S; S.init(T, 2048, F.G, (int)blockIdx.x); pg8::gemm_phase<pg8::EpiScale, pg8::StaticOrder, true, true>(F.lds + RING_OFF, g, S, E); }
        SEAM(6); }
    if (IN(7)) { PeerStream st; st.k = 0; st.lane = F.lane; st.U = F.in[23]; st.V = F.in[24]; st.gf = F.in[20]; st.UQ = (signed char*)(F.ws + WS_UQ); st.SU = (float*)(F.ws + WS_SU); st.VQ = F.ws + WS_VQ;
        st.X2 = X2; st.SS2 = SS2; st.XQ = (signed char*)(F.ws + WS_XQ); st.HS = (float*)(F.ws + WS_HS); st.buf = F.lds + STREAM_OFF + F.wave * STREAM_WAVE_BYTES; st.sbuf = F.lds + STREAM_OFF + NWAVES * STREAM_WAVE_BYTES + F.wave * 256;
        if (quad) {
            pg8::StaticOrder S; S.init(T, D, F.G, (int)blockIdx.x); pg8::Unit u0, u1; S.next(0, u0); S.next(1, u1);
            st.local = true; st.count = 12; st.xb0 = 64 * u0.pm + 16 * u0.pn + 2 * F.wave; st.xb1 = 64 * u1.pm + 16 * u1.pn + 2 * F.wave; st.vbase = 64 * (int)blockIdx.x + F.wave; st.gbase = 0; st.gstep = 0;
            const route_body::PanelTiles tts{u0.pm, u1.pm};
            route_body::route_phase(F.lds + RING_OFF, PQ, (const bf16*)(F.ws + WS_SUBK), (unsigned short*)(F.ws + WS_IDS), (float*)(F.ws + WS_GATES), 2 * u0.pn, tts, st, false);
            route_body::route_phase(F.lds + RING_OFF, PQ, (const bf16*)(F.ws + WS_SUBK), (unsigned short*)(F.ws + WS_IDS), (float*)(F.ws + WS_GATES), 2 * u0.pn + 1, tts, st, true);
        } else { const int h = F.vcu & 7, rank = F.vcu >> 3, nrank = (F.G - h + 7) >> 3;
            st.local = false; st.gbase = F.vcu * 8 + F.wave; st.gstep = F.G * 8; st.count = (16384 + 8192 - st.gbase + st.gstep - 1) / st.gstep; st.xb0 = st.xb1 = st.vbase = 0;
            const route_body::StrideTiles tts{rank, nrank, (T / 128 - rank + nrank - 1) / nrank};
            route_body::route_phase(F.lds + RING_OFF, PQ, (const bf16*)(F.ws + WS_SUBK), (unsigned short*)(F.ws + WS_IDS), (float*)(F.ws + WS_GATES), h, tts, st, true); }
        SEAM(7); }
    if (IN(8)) { peer_u(F, hi - lo > 1); SEAM(8); }
    if (IN(9)) { peer_combine(F); SEAM(9); }
    if (IN(10)) { peer_v(F, hi - lo > 1); SEAM(10); }
    if (IN(11)) { final_norm(F); }
#undef IN
#undef SEAM
#undef QSEAM
#undef GSEAM
}

extern "C" void kernel_launch(void* const* d_in, const int* in_sizes, int n_in, void* d_out, int out_size, void* d_ws, size_t ws_size, hipStream_t stream) {
    static int grid = 0;
    if (grid == 0) {
        if (n_in != 26 || in_sizes[0] != T * D || out_size != T * D || ws_size < WS_END) { fprintf(stderr, "kernel_launch: unexpected shapes (n_in %d, in0 %d, out %d, ws %zu); nothing launched\n", n_in, n_in > 0 ? in_sizes[0] : -1, out_size, ws_size); grid = -1; return; }
        int dev = 0, cus = 0, per_cu = 0;
        if (hipGetDevice(&dev) != hipSuccess || hipDeviceGetAttribute(&cus, hipDeviceAttributeMultiprocessorCount, dev) != hipSuccess) { grid = -1; return; }
        if (hipFuncSetAttribute((const void*)mk_fwd, hipFuncAttributeMaxDynamicSharedMemorySize, LDS_BYTES) != hipSuccess) { fprintf(stderr, "kernel_launch: hipFuncSetAttribute failed\n"); grid = -1; return; }
        if (hipOccupancyMaxActiveBlocksPerMultiprocessor(&per_cu, (const void*)mk_fwd, NWAVES * 64, LDS_BYTES) != hipSuccess || per_cu < 1) fprintf(stderr, "kernel_launch: occupancy query reports %d\n", per_cu);
        (void)hipGetLastError();
        grid = cus;
    }
    if (grid < 0) return;
    (void)hipMemsetAsync((char*)d_ws + WS_CTL, 0, CTL_ZERO_BYTES, stream);
    Args a{};
    for (int i = 0; i < 26; ++i) a.in[i] = (const float*)d_in[i];
    a.out = (float*)d_out; a.ws = (unsigned char*)d_ws;
#if MK_ONE_LAUNCH
    a.ph_lo = 0; a.ph_hi = NPHASE;
    hipLaunchKernelGGL(mk_fwd, dim3(grid), dim3(NWAVES * 64), LDS_BYTES, stream, a);
#else
    for (int p = 0; p < NPHASE; ++p) { a.ph_lo = p; a.ph_hi = p + 1; hipLaunchKernelGGL(mk_fwd, dim3(grid), dim3(NWAVES * 64), LDS_BYTES, stream, a); }
#endif
}
```

```cpp
#include <hip/hip_runtime.h>
#include <cstdio>
#include <cstdint>
namespace pg8 {
#define PG8_LAS __attribute__((address_space(3)))
typedef unsigned short bf16_t;
typedef short bf16x8 __attribute__((ext_vector_type(8)));
typedef float f32x4 __attribute__((ext_vector_type(4)));
typedef unsigned u32x4 __attribute__((ext_vector_type(4)));
constexpr int BM = 256, BK = 64, HALF = 128, HTB = HALF * BK * 2  , STAGE_BYTES = 8 * HTB, NXCD = 8, WGM = 8;

__host__ __device__ __forceinline__ int lds_byte(int r, int c) { const int st = (r >> 4) * 2 + (c >> 5), rr = r & 15, cc = c & 31, ob = rr * 64 + cc * 2; return st * 1024 + (ob ^ (((ob >> 9) & 1) << 5)); }
__host__ __device__ __forceinline__ void stage_rc(int b, int& R, int& C) { const int st = b / 1024, sb = b % 1024, swz = sb ^ (((sb >> 9) & 1) << 5); R = (st >> 1) * 16 + swz / 64; C = (st & 1) * 32 + (swz % 64) / 2; }
__host__ __device__ __forceinline__ int perm32(int rho) { const int n = rho >> 4, i = rho & 15; return 8 * (i >> 2) + 4 * n + (i & 3); }

struct Unit { int pm, pn; };
struct Gemm { const bf16_t* A; const bf16_t* Bt; int M, N, K; };

struct StaticOrder {
    int nM, nN, nwg, G, c;
    __host__ __device__ __forceinline__ void init(int M, int N, int G_, int c_) { nM = M / BM; nN = N / BM; nwg = nM * nN; G = G_; c = c_; }
    __host__ __device__ __forceinline__ bool next(int i, Unit& u) const {
        const long L = (long)i * G + c; if (L >= nwg) return false;
        int wgid = (int)L; { const int q = nwg / NXCD, r = nwg % NXCD, xcd = wgid % NXCD, off = wgid / NXCD; wgid = (xcd < r ? xcd * (q + 1) : r * (q + 1) + (xcd - r) * q) + off; }
        const int nig = WGM * nN, gid = wgid / nig, fm = gid * WGM, gsz = (nM - fm) < WGM ? (nM - fm) : WGM;
        u.pm = fm + ((wgid % nig) % gsz); u.pn = (wgid % nig) / gsz; return true;
    }
    __device__ __forceinline__ void a_ready(const Unit&) const {}
    __device__ __forceinline__ void done(const Unit&) const {}
};
struct OneUnit { int pm, pn; bool have;
    __device__ __forceinline__ bool next(int i, Unit& u) const { if (i != 0 || !have) return false; u.pm = pm; u.pn = pn; return true; }
    __device__ __forceinline__ void a_ready(const Unit&) const {}
    __device__ __forceinline__ void done(const Unit&) const {}
};
__device__ __forceinline__ unsigned cvt_pk_bf16(float lo, float hi) { unsigned r; asm volatile("v_cvt_pk_bf16_f32 %0, %1, %2" : "=v"(r) : "v"(lo), "v"(hi)); return r; }
typedef float f32x2 __attribute__((ext_vector_type(2)));
template <int CTRL> __device__ __forceinline__ float dppf(float x) { return __int_as_float(__builtin_amdgcn_update_dpp(0, __float_as_int(x), CTRL, 0xf, 0xf, true)); }
struct EpiStore {
    static constexpr bool PERM = true, AFTER_DRAIN = false, MIDK = false;
    bf16_t* O; int ldc; int slo, shi; float scale; float* KMP;
    __device__ __forceinline__ void operator()(const f32x4 (&acc)[2][2][4][2], const Unit& u, int wr, int wc, int fr, int fq) const {
        const int row0 = u.pm * BM + wr * 64 + fr, col0 = u.pn * BM + wc * 32 + 8 * fq; const float sc = (u.pn >= slo && u.pn < shi) ? scale : 1.0f;
#pragma unroll
        for (int ai = 0; ai < 2; ++ai)
#pragma unroll
            for (int m = 0; m < 4; ++m) { bf16_t* rowp = O + (size_t)(row0 + ai * HALF + m * 16) * ldc + col0;
#pragma unroll
                for (int bj = 0; bj < 2; ++bj) { const f32x4 v0 = acc[ai][bj][m][0] * sc, v1 = acc[ai][bj][m][1] * sc;
                    u32x4 w; w.x = cvt_pk_bf16(v0[0], v0[1]); w.y = cvt_pk_bf16(v0[2], v0[3]); w.z = cvt_pk_bf16(v1[0], v1[1]); w.w = cvt_pk_bf16(v1[2], v1[3]);
                    *(u32x4*)(rowp + bj * HALF) = w; } }
        if (KMP != nullptr && (u.pn == 6 || u.pn == 7)) {
            float cs[16];
#pragma unroll
            for (int bj = 0; bj < 2; ++bj)
#pragma unroll
                for (int n = 0; n < 2; ++n)
#pragma unroll
                    for (int e = 0; e < 4; ++e) { float a = 0.f;
#pragma unroll
                        for (int ai = 0; ai < 2; ++ai)
#pragma unroll
                            for (int m = 0; m < 4; ++m) a += acc[ai][bj][m][n][e];
                        cs[bj * 8 + n * 4 + e] = a; }
            const bool b3 = (fr & 8) != 0, b2 = (fr & 4) != 0, b1 = (fr & 2) != 0, b0 = (fr & 1) != 0; float r8[8], r4[4], r2[2], r1;
#pragma unroll
            for (int i = 0; i < 8; ++i) { const float sa = cs[i] + dppf<0x128>(cs[i]), sb = cs[i + 8] + dppf<0x128>(cs[i + 8]); r8[i] = b3 ? sb : sa; }
#pragma unroll
            for (int i = 0; i < 4; ++i) { const float sa = r8[i] + dppf<0x141>(r8[i]), sb = r8[i + 4] + dppf<0x141>(r8[i + 4]); r4[i] = b2 ? sb : sa; }
#pragma unroll
            for (int i = 0; i < 2; ++i) { const float sa = r4[i] + dppf<0x4E>(r4[i]), sb = r4[i + 2] + dppf<0x4E>(r4[i + 2]); r2[i] = b1 ? sb : sa; }
            { const float sa = r2[0] + dppf<0xB1>(r2[0]), sb = r2[1] + dppf<0xB1>(r2[1]); r1 = b0 ? sb : sa; }
            const int cg = (u.pn - 6) * 256 + 128 * (fr >> 3) + 32 * wc + 8 * fq + (fr & 7);
            KMP[((((size_t)wr * 16 + (u.pm >> 3)) * 8 + (cg >> 6)) * 8 + (u.pm & 7)) * 64 + (cg & 63)] = r1;
        }
    }
};
__device__ __forceinline__ float bfl(unsigned w) { return __uint_as_float(w << 16); }
__device__ __forceinline__ float bfh(unsigned w) { return __uint_as_float(w & 0xffff0000u); }
struct EpiResid {
    static constexpr bool PERM = true, AFTER_DRAIN = false, MIDK = false;
    const float* resf; const bf16_t* resb; bf16_t* O; float* SS; int ldc;
    __device__ __forceinline__ void operator()(const f32x4 (&acc)[2][2][4][2], const Unit& u, int wr, int wc, int fr, int fq) const {
        const int row0 = u.pm * BM + wr * 64 + fr, col0 = u.pn * BM + wc * 32 + 8 * fq;
#pragma unroll
        for (int ai = 0; ai < 2; ++ai)
#pragma unroll
            for (int m = 0; m < 4; ++m) { const int row = row0 + ai * HALF + m * 16; const size_t off = (size_t)row * ldc + col0; float ss = 0.f;
#pragma unroll
                for (int bj = 0; bj < 2; ++bj) { f32x4 v0 = acc[ai][bj][m][0], v1 = acc[ai][bj][m][1];
                    if (resf) { const f32x4 r0 = *(const f32x4*)(resf + off + bj * HALF), r1 = *(const f32x4*)(resf + off + bj * HALF + 4); v0 = v0 + r0; v1 = v1 + r1; }
                    else { const u32x4 r = *(const u32x4*)(resb + off + bj * HALF);
                        v0[0] += bfl(r.x); v0[1] += bfh(r.x); v0[2] += bfl(r.y); v0[3] += bfh(r.y); v1[0] += bfl(r.z); v1[1] += bfh(r.z); v1[2] += bfl(r.w); v1[3] += bfh(r.w); }
                    ss += (v0[0] * v0[0] + v0[1] * v0[1]) + (v0[2] * v0[2] + v0[3] * v0[3]) + (v1[0] * v1[0] + v1[1] * v1[1]) + (v1[2] * v1[2] + v1[3] * v1[3]);
                    u32x4 w; w.x = cvt_pk_bf16(v0[0], v0[1]); w.y = cvt_pk_bf16(v0[2], v0[3]); w.z = cvt_pk_bf16(v1[0], v1[1]); w.w = cvt_pk_bf16(v1[2], v1[3]);
                    *(u32x4*)(O + off + bj * HALF) = w; }
                ss += __shfl_xor(ss, 16); ss += __shfl_xor(ss, 32);
                if (fq == 0) SS[(size_t)row * 16 + u.pn * 4 + wc] = ss; }
    }
};
struct EpiScale {
    static constexpr bool PERM = true, AFTER_DRAIN = false, MIDK = false;
    const float* SS; bf16_t* O; int ldc; float eps;
    __device__ __forceinline__ void operator()(const f32x4 (&acc)[2][2][4][2], const Unit& u, int wr, int wc, int fr, int fq) const {
        const int row0 = u.pm * BM + wr * 64 + fr, col0 = u.pn * BM + wc * 32 + 8 * fq;
#pragma unroll
        for (int ai = 0; ai < 2; ++ai)
#pragma unroll
            for (int m = 0; m < 4; ++m) { const int row = row0 + ai * HALF + m * 16; bf16_t* rowp = O + (size_t)row * ldc + col0;
                const f32x4* sp = (const f32x4*)(SS + (size_t)row * 16); const f32x4 s0 = sp[0], s1 = sp[1], s2 = sp[2], s3 = sp[3];
                const float tot = ((s0[0] + s0[1]) + (s0[2] + s0[3])) + ((s1[0] + s1[1]) + (s1[2] + s1[3])) + ((s2[0] + s2[1]) + (s2[2] + s2[3])) + ((s3[0] + s3[1]) + (s3[2] + s3[3]));
                const float rs = 1.0f / sqrtf(tot * (1.0f / 1024.0f) + eps);
#pragma unroll
                for (int bj = 0; bj < 2; ++bj) { const f32x4 v0 = acc[ai][bj][m][0] * rs, v1 = acc[ai][bj][m][1] * rs;
                    u32x4 w; w.x = cvt_pk_bf16(v0[0], v0[1]); w.y = cvt_pk_bf16(v0[2], v0[3]); w.z = cvt_pk_bf16(v1[0], v1[1]); w.w = cvt_pk_bf16(v1[2], v1[3]);
                    *(u32x4*)(rowp + bj * HALF) = w; } }
    }
};

struct EpiResidGN {
    static constexpr bool PERM = true, AFTER_DRAIN = false, MIDK = true;
    const float* resf; bf16_t* O; float* SS; const float* SSL; const float* SSA; int ldc; float eps;
    __device__ __forceinline__ float rsum8(const float* p) const { const f32x4 a = *(const f32x4*)p, b = *(const f32x4*)(p + 4); return ((a[0] + a[1]) + (a[2] + a[3])) + ((b[0] + b[1]) + (b[2] + b[3])); }
    __device__ __forceinline__ void mid(f32x4 (&acc)[2][2][4][2], const Unit& u, int wr, int wc, int fr, int fq) const {
        int row0 = u.pm * BM + wr * 64 + fr; asm volatile("" : "+v"(row0));
#pragma unroll
        for (int ai = 0; ai < 2; ++ai)
#pragma unroll
            for (int m = 0; m < 4; ++m) { const int row = row0 + ai * HALF + m * 16;
                const float rl = 1.0f / sqrtf(rsum8(SSL + (size_t)row * 8) * (1.0f / 512.0f) + eps), rh = 1.0f / sqrtf(rsum8(SSA + (size_t)row * 8) * (1.0f / 512.0f) + eps); const float ratio = rl / rh;
#pragma unroll
                for (int bj = 0; bj < 2; ++bj) { acc[ai][bj][m][0] = acc[ai][bj][m][0] * ratio; acc[ai][bj][m][1] = acc[ai][bj][m][1] * ratio; }
                asm volatile("" ::: "memory"); }
    }
    __device__ __forceinline__ void operator()(const f32x4 (&acc)[2][2][4][2], const Unit& u, int wr, int wc, int fr, int fq) const {
        int row0 = u.pm * BM + wr * 64 + fr; asm volatile("" : "+v"(row0)); const int col0 = u.pn * BM + wc * 32 + 8 * fq;
#pragma unroll
        for (int ai = 0; ai < 2; ++ai)
#pragma unroll
            for (int m = 0; m < 4; ++m) { const int row = row0 + ai * HALF + m * 16; const size_t off = (size_t)row * ldc + col0; float ss = 0.f;
                const float rh = 1.0f / sqrtf(rsum8(SSA + (size_t)row * 8) * (1.0f / 512.0f) + eps);
#pragma unroll
                for (int bj = 0; bj < 2; ++bj) { const f32x4 r0 = *(const f32x4*)(resf + off + bj * HALF), r1 = *(const f32x4*)(resf + off + bj * HALF + 4);
                    const f32x4 v0 = acc[ai][bj][m][0] * rh + r0, v1 = acc[ai][bj][m][1] * rh + r1;
                    ss += (v0[0] * v0[0] + v0[1] * v0[1]) + (v0[2] * v0[2] + v0[3] * v0[3]) + (v1[0] * v1[0] + v1[1] * v1[1]) + (v1[2] * v1[2] + v1[3] * v1[3]);
                    u32x4 w; w.x = cvt_pk_bf16(v0[0], v0[1]); w.y = cvt_pk_bf16(v0[2], v0[3]); w.z = cvt_pk_bf16(v1[0], v1[1]); w.w = cvt_pk_bf16(v1[2], v1[3]);
                    *(u32x4*)(O + off + bj * HALF) = w; }
                ss += __shfl_xor(ss, 16); ss += __shfl_xor(ss, 32);
                if (fq == 0) SS[(size_t)row * 16 + u.pn * 4 + wc] = ss; }
    }
};

template <class Epi, class Sched, bool ALIGN_EPI = false, bool SP2 = false>
__device__ __forceinline__ void gemm_phase(PG8_LAS unsigned char* lds, const Gemm g, const Sched& S, const Epi& E) {
    const int tid = threadIdx.x, wid = __builtin_amdgcn_readfirstlane(tid >> 6), lane = tid & 63, wr = wid >> 2, wc = wid & 3, fr = lane & 15, fq = lane >> 4;
    const int K = g.K, nt = K / BK;
    unsigned voffA[2], voffB[2];
#pragma unroll
    for (int i = 0; i < 2; ++i) { int R, C; stage_rc(tid * 16 + i * 8192, R, C); const int Rb = Epi::PERM ? ((R & ~31) + perm32(R & 31)) : R;
        voffA[i] = (unsigned)(R * K + C) * 2u; voffB[i] = (unsigned)(Rb * K + C) * 2u; }
    const size_t kstep = (size_t)(BK * 2);
    const size_t hstep = (size_t)HALF * K * 2;
    const size_t tstep = 2 * hstep;
    const unsigned ldsw = (unsigned)wid * 1024u;
    const int aoff = lds_byte(wr * 64 + fr, fq * 8), boff = lds_byte(wc * 32 + fr, fq * 8);
#define PG8_SA(b, h) (((b) * 2 + (h)) * HTB)
#define PG8_SB(b, h) ((4 + (b) * 2 + (h)) * HTB)
#define PG8_STAGE(bufoff, gbase, voff) do { _Pragma("unroll") for (int _i = 0; _i < 2; ++_i) \
        __builtin_amdgcn_global_load_lds((const unsigned*)((const char*)(gbase) + (voff)[_i]), (PG8_LAS unsigned*)(lds + (bufoff) + ldsw + _i * 8192), 16, 0, 0); } while (0)
#define PG8_LDA(dst, b, h) do { _Pragma("unroll") for (int m = 0; m < 4; ++m) _Pragma("unroll") for (int k = 0; k < 2; ++k) dst[m][k] = *(const PG8_LAS bf16x8*)(lds + PG8_SA(b, h) + aoff + m * 2048 + k * 1024); } while (0)
#define PG8_LDB(dst, b, h) do { _Pragma("unroll") for (int n = 0; n < 2; ++n) _Pragma("unroll") for (int k = 0; k < 2; ++k) dst[n][k] = *(const PG8_LAS bf16x8*)(lds + PG8_SB(b, h) + boff + n * 2048 + k * 1024); } while (0)
#define PG8_MMA(ai, bj, At, Bt) do { __builtin_amdgcn_s_setprio(1); _Pragma("unroll") for (int m = 0; m < 4; ++m) _Pragma("unroll") for (int n = 0; n < 2; ++n) _Pragma("unroll") for (int k = 0; k < 2; ++k) \
        acc[ai][bj][m][n] = __builtin_amdgcn_mfma_f32_16x16x32_bf16(Bt[n][k], At[m][k], acc[ai][bj][m][n], 0, 0, 0); __builtin_amdgcn_s_setprio(0); } while (0)
#define PG8_WAIT_V(n) asm volatile("s_waitcnt vmcnt(" #n ")" ::: "memory")
#define PG8_WAIT_L(n) asm volatile("s_waitcnt lgkmcnt(" #n ")" ::: "memory")
#define PG8_BAR __builtin_amdgcn_s_barrier()
#define PG8_SCHED __builtin_amdgcn_sched_barrier(0)
    Unit cur, nxt; int ui = 0;
    if (!S.next(0, cur)) return;
    f32x4 acc[2][2][4][2];
#pragma unroll
    for (int a = 0; a < 2; ++a)
#pragma unroll
        for (int b = 0; b < 2; ++b)
#pragma unroll
            for (int m = 0; m < 4; ++m)
#pragma unroll
                for (int n = 0; n < 2; ++n) acc[a][b][m][n] = (f32x4){0.f, 0.f, 0.f, 0.f};
    bf16x8 At[4][2], B0[2][2], B1[2][2];
    const char* cA = (const char*)g.A + (size_t)cur.pm * tstep; const char* cB = (const char*)g.Bt + (size_t)cur.pn * tstep;
    S.a_ready(cur);
    if constexpr (SP2) {
        PG8_STAGE(PG8_SB(0, 0), cB, voffB); PG8_STAGE(PG8_SB(0, 1), cB + hstep, voffB); PG8_STAGE(PG8_SA(0, 0), cA, voffA); PG8_STAGE(PG8_SA(0, 1), cA + hstep, voffA);
        if (wr == 1) PG8_BAR;
        PG8_WAIT_V(2); PG8_BAR;
        PG8_STAGE(PG8_SB(1, 0), cB + kstep, voffB); PG8_STAGE(PG8_SA(1, 0), cA + kstep, voffA); PG8_STAGE(PG8_SB(1, 1), cB + hstep + kstep, voffB);
        PG8_WAIT_V(6); PG8_BAR;
    } else {
        PG8_STAGE(PG8_SB(0, 0), cB, voffB); PG8_STAGE(PG8_SA(0, 0), cA, voffA); PG8_STAGE(PG8_SB(0, 1), cB + hstep, voffB); PG8_STAGE(PG8_SA(0, 1), cA + hstep, voffA);
        if (wr == 1) PG8_BAR;
        PG8_WAIT_V(4); PG8_BAR;
        PG8_STAGE(PG8_SB(1, 0), cB + kstep, voffB); PG8_STAGE(PG8_SA(1, 0), cA + kstep, voffA); PG8_STAGE(PG8_SB(1, 1), cB + hstep + kstep, voffB);
        PG8_WAIT_V(6); PG8_BAR;
    }
    for (;;) {
        const bool has_next = S.next(ui + 1, nxt);
        const char* nA = has_next ? (const char*)g.A + (size_t)nxt.pm * tstep : cA; const char* nB = has_next ? (const char*)g.Bt + (size_t)nxt.pn * tstep : cB;
        for (int t = 0; t < nt; t += 2) {
            const bool last = (t == nt - 2);
            const char* a1 = cA + (size_t)(t + 1) * kstep;
            const char* a2 = last ? nA : cA + (size_t)(t + 2) * kstep; const char* b2 = last ? nB : cB + (size_t)(t + 2) * kstep;
            const char* a3 = a2 + kstep; const char* b3 = b2 + kstep;
            if constexpr (Epi::MIDK) { if (t == (nt >> 1)) E.mid(acc, cur, wr, wc, fr, fq); }
            if (last && has_next) S.a_ready(nxt);
            if constexpr (SP2) {
            PG8_LDB(B0, 0, 0); PG8_LDB(B1, 0, 1); PG8_SCHED; PG8_LDA(At, 0, 0); PG8_STAGE(PG8_SA(1, 1), a1 + hstep, voffA);
            PG8_WAIT_V(8); PG8_WAIT_L(0); PG8_BAR; PG8_MMA(0, 0, At, B0); PG8_MMA(0, 1, At, B1); PG8_BAR; PG8_SCHED;
            PG8_LDA(At, 0, 1); PG8_STAGE(PG8_SB(0, 0), b2, voffB); PG8_STAGE(PG8_SB(0, 1), b2 + hstep, voffB); PG8_STAGE(PG8_SA(0, 0), a2, voffA);
            PG8_WAIT_V(8); PG8_WAIT_L(0); PG8_BAR; PG8_MMA(1, 0, At, B0); PG8_MMA(1, 1, At, B1); PG8_BAR; PG8_SCHED;
            PG8_LDB(B0, 1, 0); PG8_LDB(B1, 1, 1); PG8_SCHED; PG8_LDA(At, 1, 0); PG8_STAGE(PG8_SA(0, 1), a2 + hstep, voffA);
            PG8_WAIT_V(8); PG8_WAIT_L(0); PG8_BAR; PG8_MMA(0, 0, At, B0); PG8_MMA(0, 1, At, B1); PG8_BAR; PG8_SCHED;
            PG8_LDA(At, 1, 1); PG8_STAGE(PG8_SB(1, 0), b3, voffB); PG8_STAGE(PG8_SB(1, 1), b3 + hstep, voffB); PG8_STAGE(PG8_SA(1, 0), a3, voffA);
            PG8_WAIT_V(8); PG8_WAIT_L(0); PG8_BAR; PG8_MMA(1, 0, At, B0); PG8_MMA(1, 1, At, B1); PG8_BAR; PG8_SCHED;
            } else {
            PG8_LDB(B0, 0, 0); PG8_SCHED; PG8_LDA(At, 0, 0); PG8_STAGE(PG8_SA(1, 1), a1 + hstep, voffA);
            PG8_WAIT_L(8); PG8_BAR; PG8_WAIT_L(0); PG8_MMA(0, 0, At, B0); PG8_BAR; PG8_SCHED;
            PG8_LDB(B1, 0, 1); PG8_STAGE(PG8_SB(0, 0), b2, voffB);
            PG8_BAR; PG8_WAIT_L(0); PG8_MMA(0, 1, At, B1); PG8_BAR;
            PG8_LDA(At, 0, 1); PG8_STAGE(PG8_SA(0, 0), a2, voffA);
            PG8_BAR; PG8_WAIT_L(0); PG8_MMA(1, 0, At, B0); PG8_BAR; PG8_SCHED;
            PG8_STAGE(PG8_SB(0, 1), b2 + hstep, voffB);
            PG8_WAIT_V(6); PG8_BAR; PG8_MMA(1, 1, At, B1); PG8_BAR;
            PG8_LDB(B0, 1, 0); PG8_SCHED; PG8_LDA(At, 1, 0); PG8_STAGE(PG8_SA(0, 1), a2 + hstep, voffA);
            PG8_WAIT_L(8); PG8_BAR; PG8_WAIT_L(0); PG8_MMA(0, 0, At, B0); PG8_BAR; PG8_SCHED;
            PG8_LDB(B1, 1, 1); PG8_STAGE(PG8_SB(1, 0), b3, voffB);
            PG8_BAR; PG8_WAIT_L(0); PG8_MMA(0, 1, At, B1); PG8_BAR;
            PG8_LDA(At, 1, 1); PG8_STAGE(PG8_SA(1, 0), a3, voffA);
            PG8_BAR; PG8_WAIT_L(0); PG8_MMA(1, 0, At, B0); PG8_BAR; PG8_SCHED;
            PG8_STAGE(PG8_SB(1, 1), b3 + hstep, voffB);
            PG8_WAIT_V(6); PG8_BAR; PG8_MMA(1, 1, At, B1); PG8_BAR;
            }
        }
        if constexpr (ALIGN_EPI) { if (wr == 0) PG8_BAR; }
        if constexpr (!Epi::AFTER_DRAIN) { E(acc, cur, wr, wc, fr, fq); S.done(cur); }
        if (!has_next) break;
#pragma unroll
        for (int a = 0; a < 2; ++a)
#pragma unroll
            for (int b = 0; b < 2; ++b)
#pragma unroll
                for (int m = 0; m < 4; ++m)
#pragma unroll
                    for (int n = 0; n < 2; ++n) acc[a][b][m][n] = (f32x4){0.f, 0.f, 0.f, 0.f};
        cur = nxt; cA = nA; cB = nB; ++ui;
        if constexpr (ALIGN_EPI) { if (wr == 1) PG8_BAR; }
    }
    PG8_WAIT_V(0);
    if constexpr (!ALIGN_EPI) { if (wr == 0) PG8_BAR; }
    PG8_BAR;
    if constexpr (Epi::AFTER_DRAIN) { E.fused(acc, cur, wr, wc, fr, fq, lds, wid, lane); S.done(cur); }
#undef PG8_SA
#undef PG8_SB
#undef PG8_STAGE
#undef PG8_LDA
#undef PG8_LDB
#undef PG8_MMA
#undef PG8_WAIT_V
#undef PG8_WAIT_L
#undef PG8_BAR
#undef PG8_SCHED
}
}
#define GAS __attribute__((address_space(1)))
#define LAS __attribute__((address_space(3)))
typedef unsigned short bf16;
typedef unsigned v4u __attribute__((ext_vector_type(4)));
typedef float f32x4 __attribute__((ext_vector_type(4)));
typedef short bf16x8 __attribute__((ext_vector_type(8)));
typedef GAS unsigned gu32;
typedef GAS unsigned long long gu64;
#define RLX_AGENT __ATOMIC_RELAXED, __HIP_MEMORY_SCOPE_AGENT
#define LDS_WAIT() asm volatile("s_waitcnt lgkmcnt(0)" ::: "memory")
#define VM_WAIT() asm volatile("s_waitcnt vmcnt(0)" ::: "memory")
__device__ __forceinline__ unsigned long long rt() { return __builtin_amdgcn_s_memrealtime(); }
__device__ __forceinline__ unsigned f2bf(float f) { unsigned u = __builtin_bit_cast(unsigned, f); return (u + 0x7fffu + ((u >> 16) & 1u)) >> 16; }
__device__ __forceinline__ unsigned pk2(float lo, float hi) { return f2bf(lo) | (f2bf(hi) << 16); }

#define XB_TMO      128
#define XB_XCNT(j)  (256  + 64 * (j))
#define XB_XSUB(j)  (1280 + 64 * (j))
#define XB_XGEN(j)  (2304 + 64 * (j))
#define XB_TOP      3328
#define XB_TOPGEN   3392
#define XCD_BAR_WORDS 3456
#define XB_SPIN_CAP (1u << 18)

__device__ __forceinline__ unsigned xb_ld(unsigned* p)              { return __hip_atomic_load(p, __ATOMIC_RELAXED, __HIP_MEMORY_SCOPE_AGENT); }
__device__ __forceinline__ unsigned xb_add(unsigned* p, unsigned v) { return __hip_atomic_fetch_add(p, v, __ATOMIC_RELAXED, __HIP_MEMORY_SCOPE_AGENT); }
__device__ __forceinline__ unsigned xb_xcc_id() { return (unsigned)__builtin_amdgcn_s_getreg((3 << 11) | 20) & 0xFu; }
#define XB_SPIN(cond, bar) do { unsigned _sp = 0; while (cond) { __builtin_amdgcn_s_sleep(1); \
    if ((++_sp & 255u) == 0u) { if (xb_ld(&(bar)[XB_TMO])) break; if (_sp > XB_SPIN_CAP) { atomicAdd(&(bar)[XB_TMO], 1u); break; } } } } while (0)

struct XcdBarrier {
    unsigned* bar; unsigned x;
    volatile LAS unsigned* st;
};

__device__ __forceinline__ XcdBarrier xcd_barrier_post(unsigned* bar, volatile LAS unsigned* st) {
    XcdBarrier b; b.bar = bar; b.x = xb_xcc_id(); b.st = st;
    if (threadIdx.x == 0) { const unsigned r_ = xb_add(&bar[XB_XCNT(b.x)], 1u); st[2] = r_; st[3] = b.x; }
    return b;
}
__device__ __forceinline__ void xcd_barrier_complete(unsigned* bar, unsigned x, unsigned& nloc, unsigned& nx) {
    const unsigned G = gridDim.x * gridDim.y * gridDim.z;
    unsigned sum, cnt, mine, sp = 0u;
    for (;;) {
        sum = 0u; cnt = 0u; mine = 0u;
#pragma unroll
        for (unsigned j = 0; j < 16; ++j) { const unsigned c = xb_ld(&bar[XB_XCNT(j)]); sum += c; cnt += (c > 0u) ? 1u : 0u; mine = (j == x) ? c : mine; }
        if (sum == G) break;
        __builtin_amdgcn_s_sleep(1);
        if ((++sp & 255u) == 0u) { if (xb_ld(&bar[XB_TMO])) break; if (sp > XB_SPIN_CAP) { atomicAdd(&bar[XB_TMO], 1u); break; } }
    }
    nloc = mine > 0u ? mine : 1u; nx = cnt > 0u ? cnt : 1u;
}

__device__ __forceinline__ void xcd_barrier(const XcdBarrier& b) {
    asm volatile("s_waitcnt vmcnt(0)" ::: "memory");
    __syncthreads();
    if (threadIdx.x == 0) {
        unsigned* bar = b.bar;
        __builtin_amdgcn_s_waitcnt(0);
        unsigned nloc = b.st[0], nx = b.st[1];
        if (nloc == 0u) { xcd_barrier_complete(bar, b.x, nloc, nx); b.st[0] = nloc; b.st[1] = nx; }
        const unsigned old = xb_add(&bar[XB_XSUB(b.x)], 1u);
        const unsigned gen = old / nloc;
        if (old + 1u == (gen + 1u) * nloc) {
            __builtin_amdgcn_fence(__ATOMIC_RELEASE, "agent");
            asm volatile("s_waitcnt vmcnt(0)" ::: "memory");
            const unsigned og = xb_add(&bar[XB_TOP], 1u);
            const unsigned tg = og / nx;
            if (og + 1u == (tg + 1u) * nx) xb_add(&bar[XB_TOPGEN], 1u);
            else XB_SPIN(xb_ld(&bar[XB_TOPGEN]) == tg, bar);
            __builtin_amdgcn_fence(__ATOMIC_ACQUIRE, "agent");
            xb_add(&bar[XB_XGEN(b.x)], 1u);
            asm volatile("s_waitcnt vmcnt(0)" ::: "memory");
        } else {
            XB_SPIN(xb_ld(&bar[XB_XGEN(b.x)]) == gen, bar);
            __builtin_amdgcn_fence(__ATOMIC_ACQUIRE, "agent");
            asm volatile("s_waitcnt vmcnt(0)" ::: "memory");
        }
    }
    __syncthreads();
}

constexpr int NWAVES = 8;
constexpr int BATCH = 16, SEQ = 2048, T = BATCH * SEQ, D = 1024, DIN = 2560, NMEM = 256, TM = BATCH * NMEM;
constexpr int DLRU = 512, LBLK = 8, LBD = 64;
constexpr int AH = 8, AD = 64, MOBA = 256, NB = SEQ / MOBA;
constexpr int CH = 4, CD = 256;
constexpr int PKEYS = 128, PHEADS = 8, PTOP = 16, PHALF = 128, PEXP = PHEADS * PTOP;
constexpr float EPS = 1e-6f;
constexpr int COL_LX = 0, COL_LG = 512, COL_Q = 1024, COL_K = 1536, COL_V = 2048;

constexpr size_t MiB = 1u << 20;
constexpr size_t WS_CTL = 0, CTL_ZERO_BYTES = 64 * 1024;
constexpr size_t WS_WIN = 2 * MiB, WS_WOUT = 7 * MiB, WS_WCQ = 9 * MiB, WS_WCKV = 11 * MiB, WS_WCO = 15 * MiB, WS_WPQ = 17 * MiB, WS_SUBK = 21 * MiB;
constexpr size_t WS_KMEAN = 23 * MiB;
constexpr size_t WS_MEMN = 24 * MiB;
constexpr size_t WS_KCVC = 32 * MiB;
constexpr size_t WS_SS1 = 48 * MiB, WS_SS2 = 50 * MiB;
constexpr size_t WS_IDS = 52 * MiB;
constexpr size_t WS_GATES = 60 * MiB;
constexpr size_t WS_A = 80 * MiB;
constexpr size_t WS_B = 144 * MiB;
constexpr size_t WS_C = 304 * MiB;
constexpr size_t WS_E = 368 * MiB;
constexpr size_t WS_SU = 76 * MiB;
constexpr size_t WS_SS3 = 77 * MiB;
constexpr size_t WS_HS = 78 * MiB;
constexpr size_t WS_SSL = 79 * MiB, WS_SSA = 22 * MiB;
constexpr size_t WS_XQ = 144 * MiB;
constexpr size_t WS_VQ = 272 * MiB;
constexpr size_t WS_ACTW = 288 * MiB;
constexpr size_t WS_UQ = 496 * MiB;
constexpr size_t WS_END = 512 * MiB;
constexpr int XQ_LD = 2048;
constexpr int CW_TMO = 0, CW_BAR = 4096, CW_QUAD = 8192  , CW_XID = 12288  , CW_G32 = 12800  , CW_WCNT = 13312  ;

constexpr int RING_OFF = 0, RING_BYTES = 131072;
constexpr int STREAM_OFF = 81920, STREAM_WAVE_BYTES = 8192;
constexpr int LDSCTL_OFF = 155648, MISC_OFF = LDSCTL_OFF + 320;
constexpr int LDS_BYTES = 163840;

__device__ __forceinline__ float bf2f(bf16 b) { return __uint_as_float(((unsigned)b) << 16); }
__device__ __forceinline__ float bflo(unsigned w) { return __uint_as_float(w << 16); }
__device__ __forceinline__ float bfhi(unsigned w) { return __uint_as_float(w & 0xffff0000u); }
__device__ __forceinline__ float wave_sum(float v) {
#pragma unroll
    for (int o = 1; o < 64; o <<= 1) v += __shfl_xor(v, o);
    return v;
}
__device__ __forceinline__ float wave_max(float v) {
#pragma unroll
    for (int o = 1; o < 64; o <<= 1) v = fmaxf(v, __shfl_xor(v, o));
    return v;
}
__device__ __forceinline__ unsigned wave_umax(unsigned v) {
#pragma unroll
    for (int o = 1; o < 64; o <<= 1) { const unsigned w = (unsigned)__shfl_xor((int)v, o); v = v > w ? v : w; }
    return v;
}
__device__ __forceinline__ float gelu_erf(float v) { return 0.5f * v * (1.0f + erff(v * 0.70710678118654752f)); }
__device__ __forceinline__ float sigmoidf_(float v) { return 1.0f / (1.0f + __expf(-v)); }
__device__ __forceinline__ unsigned ordf(float f) { const unsigned u = __float_as_uint(f); return (u & 0x80000000u) ? ~u : (u | 0x80000000u); }

struct Frame {
    LAS unsigned char* lds;
    volatile LAS unsigned* MISC;
    gu32* ctl;
    int tid, lane, wave, vcu, G;
    const float* in[26]; float* out; unsigned char* ws;
};

__device__ __forceinline__ void p0_transpose_item(const float* W, int K, int N, bf16* WT, int row_off, LAS float* scr, int item, int lane, const float* g0, const float* g1) {
    const int nblk = N / 32, kb = item / nblk, nb = item % nblk, k0 = 64 * kb, n0 = 32 * nb;
#pragma unroll 8
    for (int i = 0; i < 32; ++i) { const int kk = 2 * i + (lane >> 5); const int k = k0 + kk; float gv = 1.f; if (g0) gv = (k < 512) ? g0[k] : g1[k - 512];
        scr[kk * 33 + (lane & 31)] = W[(size_t)k * N + n0 + (lane & 31)] * gv; }
    LDS_WAIT(); asm volatile("" ::: "memory");
    const int c = lane & 7;
#pragma unroll
    for (int j = 0; j < 4; ++j) { const int n = (lane >> 3) + 8 * j; const LAS float* s = scr + (8 * c) * 33 + n;
        v4u o; o.x = pk2(s[0 * 33], s[1 * 33]); o.y = pk2(s[2 * 33], s[3 * 33]); o.z = pk2(s[4 * 33], s[5 * 33]); o.w = pk2(s[6 * 33], s[7 * 33]);
        *(GAS v4u*)(WT + (size_t)(row_off + n0 + n) * K + k0 + 8 * c) = o; }
    LDS_WAIT(); asm volatile("" ::: "memory");
}
template <int R> __device__ __forceinline__ void rms_rows_to_bf16(int lane, const float* xrow, const float* g, bf16* orow) {
    f32x4 v[R][4]; float s[R];
#pragma unroll
    for (int r = 0; r < R; ++r) { const GAS f32x4* xr = (const GAS f32x4*)(xrow + (size_t)r * D) + lane;
#pragma unroll
        for (int j = 0; j < 4; ++j) v[r][j] = __builtin_nontemporal_load(xr + 64 * j); }
    const GAS f32x4* gr = (const GAS f32x4*)g + lane; f32x4 gg[4];
#pragma unroll
    for (int j = 0; j < 4; ++j) gg[j] = gr[64 * j];
#pragma unroll
    for (int r = 0; r < R; ++r) { float a = 0.f;
#pragma unroll
        for (int j = 0; j < 4; ++j) a += (v[r][j].x * v[r][j].x + v[r][j].y * v[r][j].y) + (v[r][j].z * v[r][j].z + v[r][j].w * v[r][j].w);
        s[r] = a; }
#pragma unroll
    for (int o = 1; o < 64; o <<= 1) {
#pragma unroll
        for (int r = 0; r < R; ++r) s[r] += __shfl_xor(s[r], o); }
#pragma unroll
    for (int r = 0; r < R; ++r) { const float rs = 1.f / sqrtf(s[r] * (1.f / D) + EPS); GAS unsigned long long* o8 = (GAS unsigned long long*)(orow + (size_t)r * D) + lane;
#pragma unroll
        for (int j = 0; j < 4; ++j) o8[64 * j] = (unsigned long long)pk2(v[r][j].x * rs * gg[j].x, v[r][j].y * rs * gg[j].y) | ((unsigned long long)pk2(v[r][j].z * rs * gg[j].z, v[r][j].w * rs * gg[j].w) << 32); }
}
__device__ __forceinline__ void p0_prologue(Frame& F, bool split) {
    LAS float* scr = (LAS float*)(F.lds + RING_OFF + F.wave * 16384);
    const int gw = F.vcu * NWAVES + F.wave, NGW = F.G * NWAVES;
    bf16* Win_t = (bf16*)(F.ws + WS_WIN); bf16* Wout_t = (bf16*)(F.ws + WS_WOUT); bf16* Wcq_t = (bf16*)(F.ws + WS_WCQ); bf16* Wckv_t = (bf16*)(F.ws + WS_WCKV);
    bf16* Wco_t = (bf16*)(F.ws + WS_WCO); bf16* Wpq_t = (bf16*)(F.ws + WS_WPQ);
    constexpr int I_IN = (D / 64) * (DIN / 32), I_SQ = (D / 64) * (D / 32), I_PQ = (D / 64) * (2048 / 32);
    constexpr int NITEMS = I_IN + 5 * I_SQ + I_PQ;
    for (int it = gw; it < NITEMS; it += NGW) {
        int r = it;
        if (r < I_IN) { p0_transpose_item(F.in[3], D, DIN, Win_t, 0, scr, r, F.lane, nullptr, nullptr); continue; } r -= I_IN;
        if (r < I_SQ) { p0_transpose_item(F.in[13], D, D, Wout_t, 0, scr, r, F.lane, F.in[11], F.in[12]); continue; } r -= I_SQ;
        if (r < I_SQ) { p0_transpose_item(F.in[16], D, D, Wcq_t, 0, scr, r, F.lane, F.in[14], F.in[14] + 512); continue; } r -= I_SQ;
        if (r < I_SQ) { p0_transpose_item(F.in[17], D, D, Wckv_t, 0, scr, r, F.lane, nullptr, nullptr); continue; } r -= I_SQ;
        if (r < I_SQ) { p0_transpose_item(F.in[18], D, D, Wckv_t, D, scr, r, F.lane, nullptr, nullptr); continue; } r -= I_SQ;
        if (r < I_SQ) { p0_transpose_item(F.in[19], D, D, Wco_t, 0, scr, r, F.lane, nullptr, nullptr); continue; } r -= I_SQ;
        p0_transpose_item(F.in[21], D, 2048, Wpq_t, 0, scr, r, F.lane, F.in[20], F.in[20] + 512);
    }
    bf16* H = (bf16*)(F.ws + WS_A); bf16* MEMN = (bf16*)(F.ws + WS_MEMN);
    for (int m = 2 * gw; m < TM; m += 2 * NGW) rms_rows_to_bf16<2>(F.lane, F.in[1] + (size_t)m * D, F.in[15], MEMN + (size_t)m * D);
    { bf16* SUBK = (bf16*)(F.ws + WS_SUBK); const float* sk = F.in[22]; const int gt = F.vcu * (NWAVES * 64) + F.tid, NGT = F.G * NWAVES * 64;
      for (int i = gt; i < PHEADS * 2 * PKEYS * PHALF / 4; i += NGT) { const f32x4 v = ((const GAS f32x4*)sk)[i]; ((GAS unsigned long long*)SUBK)[i] = (unsigned long long)pk2(v.x, v.y) | ((unsigned long long)pk2(v.z, v.w) << 32); } }
    if (split) {
        asm volatile("s_waitcnt vmcnt(0)" ::: "memory"); __syncthreads();
        if (F.tid == 0) { __builtin_amdgcn_fence(__ATOMIC_RELEASE, "agent"); asm volatile("s_waitcnt vmcnt(0)" ::: "memory"); __hip_atomic_fetch_add(F.ctl + CW_WCNT, 1u, RLX_AGENT); }
        const int lw = ((int)blockIdx.x >> 3) * NWAVES + F.wave, nlw = (F.G >> 3) * NWAVES, r0 = ((int)blockIdx.x & 7) * (T / 8);
        for (int m = 4 * lw; m < T / 8; m += 4 * nlw) rms_rows_to_bf16<4>(F.lane, F.in[0] + (size_t)(r0 + m) * D, F.in[2], H + (size_t)(r0 + m) * D);
    } else
        for (int m = 4 * gw; m < T; m += 4 * NGW) rms_rows_to_bf16<4>(F.lane, F.in[0] + (size_t)m * D, F.in[2], H + (size_t)m * D);
}

typedef float f32x2_ __attribute__((ext_vector_type(2)));
struct PeerStream {
    int k, count; int lane;
    bool local; int gbase, gstep, xb0, xb1, vbase;
    __device__ __forceinline__ int item_of(int kk) const { return local ? (kk >= 8 ? 16384 + (((kk - 8) >> 1) ? xb1 : xb0) + (kk & 1) : vbase + 8 * kk) : gbase + kk * gstep; }
    const float* U; const float* V; const float* gf; signed char* UQ; float* SU; unsigned char* VQ;
    const bf16* X2; const float* SS2; signed char* XQ; float* HS;
    LAS unsigned char* buf; LAS unsigned char* sbuf;
    __device__ __forceinline__ void issue(int kk) { const int item = item_of(kk);
        if (item < 16384) {
#pragma unroll
            for (int j = 0; j < 4; ++j) __builtin_amdgcn_global_load_lds((const unsigned*)(V + (size_t)item * D + j * 256 + 4 * lane), (LAS unsigned*)(buf + 4096 + j * 1024), 16, 0, 0);
        } else { const int t = 4 * (item - 16384);
#pragma unroll
            for (int j = 0; j < 8; ++j) __builtin_amdgcn_global_load_lds((const unsigned*)(X2 + (size_t)(t + (j >> 1)) * D + (j & 1) * 512 + 8 * lane), (LAS unsigned*)(buf + j * 1024), 16, 0, 0);
            __builtin_amdgcn_global_load_lds((const unsigned*)(SS2 + (size_t)(t + (lane >> 4)) * 16 + (lane & 15)), (LAS unsigned*)sbuf, 4, 0, 0);
        }
    }
    template <bool WAIT = true> __device__ __forceinline__ void finish(int kk) { const int item = item_of(kk);
        if constexpr (WAIT) asm volatile("s_waitcnt vmcnt(0)" ::: "memory");
        if (item < 16384) { const int e = item;
            v4u o2;
#pragma unroll
            for (int i = 0; i < 4; ++i) { const f32x4 w = *(const LAS f32x4*)(buf + 4096 + 64 * lane + 16 * i) * 16.0f;
                int p = __builtin_amdgcn_cvt_pk_fp8_f32(w[0], w[1], 0, false); p = __builtin_amdgcn_cvt_pk_fp8_f32(w[2], w[3], p, true); o2[i] = (unsigned)p; }
            *(v4u*)(VQ + ((size_t)(lane >> 3) * (PKEYS * PKEYS) + e) * 128 + 16 * (lane & 7)) = o2;
        } else { const int t = 4 * (item - 16384);
#pragma unroll
            for (int q = 0; q < 4; ++q) { const v4u wa = *(const LAS v4u*)(buf + 2048 * q + 32 * lane), wb = *(const LAS v4u*)(buf + 2048 * q + 32 * lane + 16); const unsigned w[8] = {wa.x, wa.y, wa.z, wa.w, wb.x, wb.y, wb.z, wb.w};
                float am = 0.f;
#pragma unroll
                for (int i = 0; i < 8; ++i) am = fmaxf(am, fmaxf(fabsf(bflo(w[i])), fabsf(bfhi(w[i]))));
                am = wave_max(am); const float inv = am > 0.f ? 127.0f / am : 0.f;
                v4u o;
#pragma unroll
                for (int i = 0; i < 4; ++i) { const int q0 = (int)rintf(bflo(w[2 * i]) * inv), q1 = (int)rintf(bfhi(w[2 * i]) * inv), q2 = (int)rintf(bflo(w[2 * i + 1]) * inv), q3 = (int)rintf(bfhi(w[2 * i + 1]) * inv);
                    o[i] = (unsigned)(q0 & 0xff) | ((unsigned)(q1 & 0xff) << 8) | ((unsigned)(q2 & 0xff) << 16) | ((unsigned)(q3 & 0xff) << 24); }
                *(v4u*)(XQ + (size_t)(t + q) * XQ_LD + 16 * lane) = o;
                float a = *(const LAS float*)(sbuf + 64 * q + 4 * (lane & 15)); a += __shfl_xor(a, 1); a += __shfl_xor(a, 2); a += __shfl_xor(a, 4); a += __shfl_xor(a, 8);
                if (lane == 0) HS[t + q] = (1.f / sqrtf(a * (1.f / D) + EPS)) * am * (1.0f / 127.0f); }
        }
        asm volatile("s_waitcnt lgkmcnt(0)" ::: "memory");
    }
};
template <int WHICH> __device__ __forceinline__ void convert_rows(Frame& F, int i0, int i1) {
    const float* SRC = WHICH ? F.in[24] : F.in[23]; signed char* UQ = (signed char*)(F.ws + WS_UQ); float* SU = (float*)(F.ws + WS_SU); unsigned char* VQ = F.ws + WS_VQ;
    int lane = F.lane; asm volatile("" : "+v"(lane));
    f32x4 gg[4];
#pragma unroll
    for (int i = 0; i < 4; ++i) gg[i] = WHICH ? (f32x4){16.f, 16.f, 16.f, 16.f} : *(const f32x4*)(F.in[20] + 16 * lane + 4 * i);
    asm volatile("s_waitcnt vmcnt(0)" ::: "memory");
    LAS unsigned char* const b0 = F.lds + RING_OFF + F.wave * 16384;
#define CT_ISSUE(item, buf) do { _Pragma("unroll") for (int j = 0; j < 4; ++j) \
        __builtin_amdgcn_global_load_lds((const unsigned*)(SRC + (size_t)(item) * D + j * 256 + 4 * lane), (LAS unsigned*)((buf) + j * 1024), 16, 0, 0); } while (0)
    int it = i0 + F.wave, par = 0;
#pragma unroll
    for (int k = 0; k < 3; ++k) if (it + 8 * k < i1) CT_ISSUE(it + 8 * k, b0 + k * 4096);
    for (; it < i1; it += 8, par = (par + 1) & 3) {
        LAS unsigned char* const buf = b0 + par * 4096;
        if (it + 24 < i1) { CT_ISSUE(it + 24, b0 + ((par + 3) & 3) * 4096); asm volatile("s_waitcnt vmcnt(12)" ::: "memory"); }
        else if (it + 16 < i1) asm volatile("s_waitcnt vmcnt(8)" ::: "memory");
        else if (it + 8 < i1) asm volatile("s_waitcnt vmcnt(4)" ::: "memory");
        else asm volatile("s_waitcnt vmcnt(0)" ::: "memory");
        const int e = it; f32x4 v[4];
#pragma unroll
        for (int i = 0; i < 4; ++i) v[i] = *(const LAS f32x4*)(buf + 64 * lane + 16 * i) * gg[i];
        v4u o;
        if constexpr (WHICH == 0) { float am = 0.f;
#pragma unroll
            for (int i = 0; i < 4; ++i) am = fmaxf(am, fmaxf(fmaxf(fabsf(v[i][0]), fabsf(v[i][1])), fmaxf(fabsf(v[i][2]), fabsf(v[i][3]))));
            am = wave_max(am); const float inv = am > 0.f ? 127.0f / am : 0.f;
#pragma unroll
            for (int i = 0; i < 4; ++i) { const int q0 = (int)rintf(v[i][0] * inv), q1 = (int)rintf(v[i][1] * inv), q2 = (int)rintf(v[i][2] * inv), q3 = (int)rintf(v[i][3] * inv);
                o[i] = (unsigned)(q0 & 0xff) | ((unsigned)(q1 & 0xff) << 8) | ((unsigned)(q2 & 0xff) << 16) | ((unsigned)(q3 & 0xff) << 24); }
            *(v4u*)(UQ + ((size_t)(lane >> 3) * (PKEYS * PKEYS) + e) * 128 + 16 * (lane & 7)) = o;
            if (lane == 0) SU[e] = am * (1.0f / 127.0f);
        } else {
#pragma unroll
            for (int i = 0; i < 4; ++i) { int p = __builtin_amdgcn_cvt_pk_fp8_f32(v[i][0], v[i][1], 0, false); p = __builtin_amdgcn_cvt_pk_fp8_f32(v[i][2], v[i][3], p, true); o[i] = (unsigned)p; }
            *(v4u*)(VQ + ((size_t)(lane >> 3) * (PKEYS * PKEYS) + e) * 128 + 16 * (lane & 7)) = o;
        }
        asm volatile("s_waitcnt lgkmcnt(0)" ::: "memory");
    }
#undef CT_ISSUE
    asm volatile("s_waitcnt vmcnt(0) lgkmcnt(0)\n\ts_barrier" ::: "memory");
}
__device__ __forceinline__ void table_share(const Frame& F, int k, int n, int& i0, int& i1) {
    const int per = (PKEYS * PKEYS + F.G - 1) / F.G, lo = (int)blockIdx.x * per, hi = (lo + per < PKEYS * PKEYS) ? lo + per : PKEYS * PKEYS;
    i0 = lo + (k * per) / n; i1 = lo + ((k + 1) * per) / n; if (i0 > hi) i0 = hi; if (i1 > hi) i1 = hi;
}
__device__ __forceinline__ void xcd_split(Frame& F, bool census, int& part, int& rank, int& nrank) {
    part = (int)(blockIdx.x & 7); rank = (int)(blockIdx.x >> 3); nrank = (F.G - part + 7) >> 3;
    if (census && (F.G & 7) == 0) { const unsigned x = F.MISC[11], r = F.MISC[10]; unsigned pre = 0u; gu32* bar = F.ctl + CW_BAR;
#pragma unroll
        for (unsigned j = 0; j < 16; ++j) { const unsigned c = __hip_atomic_load(bar + XB_XCNT(j), RLX_AGENT); pre += (j < x) ? c : 0u; }
        const unsigned gi = pre + r, per = (unsigned)F.G >> 3; part = (int)(gi / per); rank = (int)(gi % per); nrank = (int)per; }
}
template <int CTRL> __device__ __forceinline__ int dpp_i(int x) { return __builtin_amdgcn_update_dpp(0, x, CTRL, 0xf, 0xf, true); }
template <int CTRL> __device__ __forceinline__ float dpp_f(float x) { return __int_as_float(__builtin_amdgcn_update_dpp(0, __float_as_int(x), CTRL, 0xf, 0xf, true)); }
constexpr int DPP_XOR1 = 0xB1  , DPP_XOR2 = 0x4E  , DPP_HMIRROR = 0x141  , DPP_ROR8 = 0x128  ;
__device__ __forceinline__ float swap32_add(float a, float b) { const auto r = __builtin_amdgcn_permlane32_swap(__float_as_uint(a), __float_as_uint(b), false, false); return __uint_as_float(r[0]) + __uint_as_float(r[1]); }
__device__ __forceinline__ float swap16_add(float a, float b) { const auto r = __builtin_amdgcn_permlane16_swap(__float_as_uint(a), __float_as_uint(b), false, false); return __uint_as_float(r[0]) + __uint_as_float(r[1]); }
struct PuMeta { v4u ida, idb; v4u xq; };
__device__ __forceinline__ void pu_load(PuMeta& m, int t, int g, int col16, const unsigned short* IDS, const signed char* XQ) {
    const v4u* ip = (const v4u*)(IDS + (size_t)t * PEXP + g * 16); m.ida = ip[0]; m.idb = ip[1]; m.xq = *(const v4u*)(XQ + (size_t)t * XQ_LD + col16);
}
__device__ __forceinline__ unsigned pu_id(const PuMeta& m, int i) { const unsigned w = (i < 8) ? m.ida[(i & 7) >> 1] : m.idb[(i & 7) >> 1]; return (i & 1) ? (w >> 16) : (w & 0xffffu); }
__device__ __forceinline__ void peer_u(Frame& F, bool census) {
    const unsigned short* IDS = (const unsigned short*)(F.ws + WS_IDS); const signed char* XQ = (const signed char*)(F.ws + WS_XQ); const signed char* UQ = (const signed char*)(F.ws + WS_UQ); int* PD = (int*)(F.ws + WS_E);
    int part, rank, nrank; xcd_split(F, census, part, rank, nrank); const int lane = F.lane, g = lane >> 3, l7 = lane & 7;
    const signed char* slab = UQ + (size_t)part * (PKEYS * PKEYS) * 128 + 16 * l7; const int col16 = 128 * part + 16 * l7;
    const bool b4 = (lane & 4) != 0, b2 = (lane & 2) != 0, b1 = (lane & 1) != 0;
    const int t0 = rank * NWAVES + F.wave, tstep = nrank * NWAVES;
    PuMeta m[2]; v4u q[2][16]; v4u xc[2];
#pragma unroll
    for (int k = 0; k < 2; ++k) { const int t = t0 + k * tstep; pu_load(m[k], t < T ? t : t0, g, col16, IDS, XQ); }
#define PU_ISSUE(buf, mk) do { _Pragma("unroll") for (int i_ = 0; i_ < 16; ++i_) q[buf][i_] = *(const v4u*)(slab + (size_t)pu_id((mk), i_) * 128); xc[buf] = (mk).xq; } while (0)
    PU_ISSUE(0, m[0]);
    { const int tp = t0 + 2 * tstep; if (tp < T) pu_load(m[0], tp, g, col16, IDS, XQ); }
    for (int tb = t0; tb < T; tb += 2 * tstep) {
#pragma unroll
        for (int k = 0; k < 2; ++k) {
            const int t = tb + k * tstep;
            if (t < T) {
                const int tn = t + tstep;
                if (tn < T) PU_ISSUE(k ^ 1, m[k ^ 1]);
                { const int tp = t + 3 * tstep; if (tp < T) pu_load(m[k ^ 1], tp, g, col16, IDS, XQ); }
                int d[16];
#pragma unroll
                for (int i = 0; i < 16; ++i) { const v4u uu = q[k][i]; const v4u xx = xc[k];
                    int a = __builtin_amdgcn_sdot4((int)uu.x, (int)xx.x, 0, false); a = __builtin_amdgcn_sdot4((int)uu.y, (int)xx.y, a, false); a = __builtin_amdgcn_sdot4((int)uu.z, (int)xx.z, a, false); d[i] = __builtin_amdgcn_sdot4((int)uu.w, (int)xx.w, a, false); }
                int r8[8], r4[4], r2[2];
#pragma unroll
                for (int i = 0; i < 8; ++i) { const int sa = d[i] + dpp_i<DPP_HMIRROR>(d[i]), sb = d[i + 8] + dpp_i<DPP_HMIRROR>(d[i + 8]); r8[i] = b4 ? sb : sa; }
#pragma unroll
                for (int i = 0; i < 4; ++i) { const int sa = r8[i] + dpp_i<DPP_XOR2>(r8[i]), sb = r8[i + 4] + dpp_i<DPP_XOR2>(r8[i + 4]); r4[i] = b2 ? sb : sa; }
#pragma unroll
                for (int i = 0; i < 2; ++i) { const int sa = r4[i] + dpp_i<DPP_XOR1>(r4[i]), sb = r4[i + 2] + dpp_i<DPP_XOR1>(r4[i + 2]); r2[i] = b1 ? sb : sa; }
                { const int q0_ = (r2[0] + 32) >> 6, q1_ = (r2[1] + 32) >> 6;
                  PD[((size_t)t * 8 + part) * 64 + lane] = (int)(((unsigned)q0_ & 0xffffu) | ((unsigned)q1_ << 16)); }
            }
        }
    }
#undef PU_ISSUE
}
__device__ __forceinline__ void peer_combine(Frame& F) {
    const int* PD = (const int*)(F.ws + WS_E); const unsigned short* IDS = (const unsigned short*)(F.ws + WS_IDS); const float* GATES = (const float*)(F.ws + WS_GATES); const float* SU = (const float*)(F.ws + WS_SU);
    const float* HS = (const float*)(F.ws + WS_HS); unsigned* PK = (unsigned*)(F.ws + WS_ACTW);
    const int gw = F.vcu * NWAVES + F.wave, NGW = F.G * NWAVES, lane = F.lane, g = lane >> 3, l7 = lane & 7;
    const int ii0 = 2 * (l7 & 1) + 4 * ((l7 >> 1) & 1) + 8 * ((l7 >> 2) & 1), p0 = 8 * ii0 + g, p1 = 8 * (ii0 + 1) + g, q0 = g * 16 + ii0, q1 = q0 + 1;
    for (int t = 2 * gw; t < T; t += 2 * NGW) {
        uint2 v[2][8]; float hs[2], g0[2], g1[2]; int id0[2], id1[2];
#pragma unroll
        for (int r = 0; r < 2; ++r) {
#pragma unroll
            for (int x = 0; x < 8; ++x) { const int w_ = PD[((size_t)(t + r) * 8 + x) * 64 + lane]; v[r][x] = make_uint2((unsigned)((w_ << 16) >> 16), (unsigned)(w_ >> 16)); }
            hs[r] = HS[t + r]; id0[r] = IDS[(size_t)(t + r) * PEXP + q0]; id1[r] = IDS[(size_t)(t + r) * PEXP + q1]; g0[r] = GATES[(size_t)(t + r) * PEXP + p0]; g1[r] = GATES[(size_t)(t + r) * PEXP + p1]; }
        float su0[2], su1[2];
#pragma unroll
        for (int r = 0; r < 2; ++r) { su0[r] = SU[id0[r]]; su1[r] = SU[id1[r]]; }
#pragma unroll
        for (int r = 0; r < 2; ++r) { int s0 = 0, s1 = 0;
#pragma unroll
            for (int x = 0; x < 8; ++x) { s0 += (int)v[r][x].x; s1 += (int)v[r][x].y; }
            const float w0 = g0[r] * gelu_erf(hs[r] * su0[r] * (64.0f * (float)s0)) * 0.0625f, w1 = g1[r] * gelu_erf(hs[r] * su1[r] * (64.0f * (float)s1)) * 0.0625f;
            *(uint2*)(PK + (size_t)(t + r) * PEXP + q0) = make_uint2((f2bf(w0) << 16) | (unsigned)id0[r], (f2bf(w1) << 16) | (unsigned)id1[r]); }
    }
}
struct PvMeta { v4u pk[4]; unsigned xw; };
__device__ __forceinline__ void pv_load(PvMeta& m, int t, int g, int col, const unsigned* PK, const bf16* X2) {
    const v4u* pp = (const v4u*)(PK + (size_t)t * PEXP + g * 16);
#pragma unroll
    for (int i = 0; i < 4; ++i) m.pk[i] = pp[i];
    m.xw = *(const unsigned*)(X2 + (size_t)t * D + col);
}
__device__ __forceinline__ void peer_v(Frame& F, bool census) {
    const bf16* X2 = (const bf16*)(F.ws + WS_C); const unsigned* PK = (const unsigned*)(F.ws + WS_ACTW);
    const unsigned char* VQ = F.ws + WS_VQ; bf16* X3 = (bf16*)(F.ws + WS_A);
    int part, rank, nrank; xcd_split(F, census, part, rank, nrank); const int lane = F.lane, g = lane >> 3, l7 = lane & 7;
    const unsigned char* slab = VQ + (size_t)part * (PKEYS * PKEYS) * 128 + 16 * l7;
    const bool hi = lane >= 32, b16 = (lane & 16) != 0, b8 = (lane & 8) != 0;
    const int col = 128 * part + 16 * l7 + 2 * g;
    const int t0 = rank * NWAVES + F.wave, tstep = nrank * NWAVES;
    PvMeta m[2]; v4u qa[8], qb[8]; float wa[8], wb[8];
#pragma unroll
    for (int k = 0; k < 2; ++k) { const int t = t0 + k * tstep; pv_load(m[k], t < T ? t : t0, g, col, PK, X2); }
#define PV_ISSUE(qx, wx, mk, h_) do { _Pragma("unroll") for (int i_ = 0; i_ < 8; ++i_) { const unsigned p_ = (mk).pk[2 * (h_) + (i_ >> 2)][i_ & 3]; wx[i_] = __uint_as_float(p_ & 0xffff0000u); qx[i_] = *(const v4u*)(slab + (size_t)(p_ & 0xffffu) * 128); } } while (0)
#define PV_HALF(qx, wx) do { _Pragma("unroll") for (int i_ = 0; i_ < 8; ++i_) { const float w_ = wx[i_]; \
        _Pragma("unroll") for (int kk = 0; kk < 4; ++kk) { const f32x2_ lo = __builtin_amdgcn_cvt_pk_f32_fp8((int)qx[i_][kk], false), hi2 = __builtin_amdgcn_cvt_pk_f32_fp8((int)qx[i_][kk], true); \
            acc2[2 * kk] += lo * w_; acc2[2 * kk + 1] += hi2 * w_; } } } while (0)
    PV_ISSUE(qa, wa, m[0], 0);
    for (int tb = t0; tb < T; tb += 2 * tstep) {
#pragma unroll
        for (int k = 0; k < 2; ++k) {
            const int t = tb + k * tstep;
            if (t < T) {
                PV_ISSUE(qb, wb, m[k], 1); const unsigned xw = m[k].xw;
                f32x2_ acc2[8];
#pragma unroll
                for (int i = 0; i < 8; ++i) acc2[i] = (f32x2_){0.f, 0.f};
                PV_HALF(qa, wa);
                const int tn = t + tstep;
                if (tn < T) { PV_ISSUE(qa, wa, m[k ^ 1], 0); }
                { const int tp = t + 2 * tstep; if (tp < T) pv_load(m[k], tp, g, col, PK, X2); }
                PV_HALF(qb, wb);
                float acc[16];
#pragma unroll
                for (int i = 0; i < 8; ++i) { acc[2 * i] = acc2[i].x; acc[2 * i + 1] = acc2[i].y; }
                float r8[8], r4[4], r2[2];
#pragma unroll
                for (int i = 0; i < 8; ++i) r8[i] = swap32_add(acc[i], acc[i + 8]);
#pragma unroll
                for (int i = 0; i < 4; ++i) r4[i] = swap16_add(r8[i], r8[i + 4]);
#pragma unroll
                for (int i = 0; i < 2; ++i) { const float sa = r4[i] + dpp_f<DPP_ROR8>(r4[i]), sb = r4[i + 2] + dpp_f<DPP_ROR8>(r4[i + 2]); r2[i] = b8 ? sb : sa; }
                const float y0 = bflo(xw) + r2[0], y1 = bfhi(xw) + r2[1];
                *(unsigned*)(X3 + (size_t)t * D + col) = pk2(y0, y1);
            }
        }
    }
#undef PV_ISSUE
#undef PV_HALF
}
__device__ __forceinline__ void final_norm(Frame& F) {
    const bf16* X3 = (const bf16*)(F.ws + WS_A); const float* SS3 = (const float*)(F.ws + WS_SS3); const float* gfin = F.in[25];
    int tid_ = threadIdx.x; asm volatile("" : "+v"(tid_)); const int lane = tid_ & 63;
    const int gw = F.vcu * NWAVES + F.wave, NGW = F.G * NWAVES;
    f32x4 gg[4];
#pragma unroll
    for (int i = 0; i < 4; ++i) gg[i] = *(const f32x4*)(gfin + 256 * i + 4 * lane);
    for (int t = 4 * gw; t < T; t += 4 * NGW) {
        uint2 v[4][4]; float tot[4];
#pragma unroll
        for (int r = 0; r < 4; ++r)
#pragma unroll
            for (int i = 0; i < 4; ++i) v[r][i] = *(const uint2*)(X3 + (size_t)(t + r) * D + 256 * i + 4 * lane);
#pragma unroll
        for (int r = 0; r < 4; ++r) { float a = 0.f;
#pragma unroll
            for (int i = 0; i < 4; ++i) { const float x0 = bflo(v[r][i].x), x1 = bfhi(v[r][i].x), x2 = bflo(v[r][i].y), x3 = bfhi(v[r][i].y); a += (x0 * x0 + x1 * x1) + (x2 * x2 + x3 * x3); }
            tot[r] = a; }
#pragma unroll
        for (int o = 1; o < 64; o <<= 1)
#pragma unroll
            for (int r = 0; r < 4; ++r) tot[r] += __shfl_xor(tot[r], o);
#pragma unroll
        for (int r = 0; r < 4; ++r) { const float rs = 1.f / sqrtf(tot[r] * (1.f / D) + EPS);
#pragma unroll
            for (int i = 0; i < 4; ++i) { f32x4 o; o[0] = bflo(v[r][i].x) * rs * gg[i][0]; o[1] = bfhi(v[r][i].x) * rs * gg[i][1]; o[2] = bflo(v[r][i].y) * rs * gg[i][2]; o[3] = bfhi(v[r][i].y) * rs * gg[i][3];
                __builtin_nontemporal_store(o, (f32x4*)(F.out + (size_t)(t + r) * D + 256 * i + 4 * lane)); } }
    }
}

#include <hip/hip_bf16.h>
#include <cmath>
namespace attn_body {
using bf16=__hip_bfloat16;
using bf16x8=__attribute__((ext_vector_type(8)))short;
using s16x4=__attribute__((ext_vector_type(4)))short;
using f32x16=__attribute__((ext_vector_type(16)))float;
using u32x4=__attribute__((ext_vector_type(4)))unsigned;
constexpr int BATCH=16,NHEAD=8,SEQ=2048,D=64,DM=2560,DMO=1024;
constexpr int NW=8,QBLK=32,QB=QBLK*NW,KVBLK=64,NQB=SEQ/QB;
constexpr int ATTN_PITCH=DM, ATTN_UNIT_ROWS=QB;
__device__ __forceinline__ int crow(int r,int hi){return (r&3)+8*(r>>2)+4*hi;}
#define SBAR() __builtin_amdgcn_sched_barrier(0)
__device__ __forceinline__ void cmask(f32x16&p0,f32x16&p1,int jb,int qrel,int hi){
  const float NEG=-INFINITY; int kb=64*jb+4*hi;
  #pragma unroll
  for(int r=0;r<16;++r){int kv=kb+(r&3)+8*(r>>2); if(kv>qrel)p0[r]=NEG; if(kv+32>qrel)p1[r]=NEG;}
}

constexpr int NSLOT=3, SLOTB=8192;
constexpr int LDS_K=0, LDS_V=NSLOT*SLOTB, LDS_WS=2*NSLOT*SLOTB, LDS_OST=LDS_WS+NW*128*4, LDS_SEL=LDS_OST+NW*4096, LDS_BYTES=LDS_SEL+16*QB*4;
constexpr float C2=0.125f*1.4426950408889634f;
__device__ __forceinline__ void glds16(const void*gsrc,unsigned lds_dst){unsigned keep;
  asm volatile("s_mov_b32 %0, m0\n\ts_mov_b32 m0, %2\n\ts_nop 0\n\tglobal_load_lds_dwordx4 %1, off\n\ts_mov_b32 m0, %0":"=&s"(keep):"v"(gsrc),"s"(lds_dst):"memory");}
__device__ __forceinline__ float max3f(float a,float b,float c){float r;asm("v_max3_f32 %0, %1, %2, %3":"=v"(r):"v"(a),"v"(b),"v"(c));return r;}
__device__ __forceinline__ float max2f(float a,float b){float r;asm("v_max_f32_e32 %0, %1, %2":"=v"(r):"v"(a),"v"(b));return r;}
__device__ __forceinline__ float fadd_s(float a,float b){float r;asm("v_add_f32_e32 %0, %1, %2":"=v"(r):"v"(a),"v"(b));return r;}
__device__ __forceinline__ float fsub_s(float a,float b){float r;asm("v_sub_f32_e32 %0, %1, %2":"=v"(r):"v"(a),"v"(b));return r;}
typedef float f32x2_t __attribute__((ext_vector_type(2))); typedef __bf16 bf16x2_t __attribute__((ext_vector_type(2)));
__device__ __forceinline__ unsigned cvtpk_s(float lo,float hi){f32x2_t v={lo,hi};bf16x2_t b=__builtin_convertvector(v,bf16x2_t);return __builtin_bit_cast(unsigned,b);}
#define WAIT_BAR(N) asm volatile("s_waitcnt vmcnt(" #N ") lgkmcnt(0)\n\ts_barrier":::"memory")

__device__ __forceinline__ void qkt(f32x16&p0,f32x16&p1,const char*Kslot,const bf16x8*qr,const f32x16&negm,int r32,int hi){
  const char*kb=Kslot+hi*1024+r32*16;
  #pragma unroll
  for(int d0=0;d0<4;++d0){
    const bf16x8 b0=*reinterpret_cast<const bf16x8*>(kb+d0*2048);
    const bf16x8 b1=*reinterpret_cast<const bf16x8*>(kb+d0*2048+512);
    if(d0==0){p0=__builtin_amdgcn_mfma_f32_32x32x16_bf16(b0,qr[0],negm,0,0,0);p1=__builtin_amdgcn_mfma_f32_32x32x16_bf16(b1,qr[0],negm,0,0,0);}
    else{p0=__builtin_amdgcn_mfma_f32_32x32x16_bf16(b0,qr[d0],p0,0,0,0);p1=__builtin_amdgcn_mfma_f32_32x32x16_bf16(b1,qr[d0],p1,0,0,0);}}
}
typedef __attribute__((address_space(3))) const char* lds_cptr;
typedef short v4i16_t __attribute__((ext_vector_type(4)));
__device__ __forceinline__ void kload8(bf16x8*kf,lds_cptr kp){
  kf[0]=*(const __attribute__((address_space(3))) bf16x8*)(kp);      kf[1]=*(const __attribute__((address_space(3))) bf16x8*)(kp+512);
  kf[2]=*(const __attribute__((address_space(3))) bf16x8*)(kp+2048); kf[3]=*(const __attribute__((address_space(3))) bf16x8*)(kp+2560);
  kf[4]=*(const __attribute__((address_space(3))) bf16x8*)(kp+4096); kf[5]=*(const __attribute__((address_space(3))) bf16x8*)(kp+4608);
  kf[6]=*(const __attribute__((address_space(3))) bf16x8*)(kp+6144); kf[7]=*(const __attribute__((address_space(3))) bf16x8*)(kp+6656);
}
__device__ __forceinline__ void kload2(bf16x8*kf,lds_cptr kp,int j){ kf[2*j]=*(const __attribute__((address_space(3))) bf16x8*)(kp+j*2048); kf[2*j+1]=*(const __attribute__((address_space(3))) bf16x8*)(kp+j*2048+512); }
__device__ __forceinline__ s16x4 vtr(lds_cptr p){ return __builtin_bit_cast(s16x4,__builtin_amdgcn_ds_read_tr16_b64_v4i16((__attribute__((address_space(3))) v4i16_t*)p)); }
__device__ __forceinline__ float rowmax(const f32x16&p0,const f32x16&p1){
  float a=max3f(p0[0],p0[1],p1[0]),b=max3f(p0[2],p0[3],p1[1]);a=max3f(a,p1[2],p1[3]);
  #pragma unroll
  for(int r=4;r<16;r+=4){a=max3f(a,p0[r],p0[r+1]);b=max3f(b,p0[r+2],p0[r+3]);a=max3f(a,p1[r],p1[r+1]);b=max3f(b,p1[r+2],p1[r+3]);}
  const float m=max2f(a,b);
  auto rr=__builtin_amdgcn_permlane32_swap(__float_as_uint(m),__float_as_uint(m),false,false);
  return max2f(__uint_as_float(rr[0]),__uint_as_float(rr[1]));
}
__device__ __forceinline__ void pv(f32x16*o,int vb,bf16x8 pa0,bf16x8 pa1,bf16x8 pa2,bf16x8 pa3){
  #pragma unroll
  for(int d0=0;d0<2;++d0){s16x4 lo[4],hi[4];
    #pragma unroll
    for(int ks=0;ks<4;++ks){
      asm volatile("ds_read_b64_tr_b16 %0,%1 offset:%c2":"=&v"(lo[ks]):"v"(vb),"i"(d0*4096+ks*1024):"memory");
      asm volatile("ds_read_b64_tr_b16 %0,%1 offset:%c2":"=&v"(hi[ks]):"v"(vb),"i"(d0*4096+ks*1024+512):"memory");}
    asm volatile("s_waitcnt lgkmcnt(0)":::"memory");SBAR();
    #define PK(k) (bf16x8){lo[k][0],lo[k][1],lo[k][2],lo[k][3],hi[k][0],hi[k][1],hi[k][2],hi[k][3]}
    o[d0]=__builtin_amdgcn_mfma_f32_32x32x16_bf16(pa0,PK(0),o[d0],0,0,0);
    o[d0]=__builtin_amdgcn_mfma_f32_32x32x16_bf16(pa1,PK(1),o[d0],0,0,0);
    o[d0]=__builtin_amdgcn_mfma_f32_32x32x16_bf16(pa2,PK(2),o[d0],0,0,0);
    o[d0]=__builtin_amdgcn_mfma_f32_32x32x16_bf16(pa3,PK(3),o[d0],0,0,0);
    #undef PK
  }
}

#ifndef ATTN_STORE16
#define ATTN_STORE16(p,v) (*(u32x4*)(p)=(v))
#endif
template<int THRL> __device__ __forceinline__ void attn_unit(int b,int h,int qb,const bf16*Q,const bf16*__restrict__ K,const bf16*__restrict__ V,bf16*O,float*SSA,int ui,char*shm){
  int tid_=threadIdx.x; asm volatile("":"+v"(tid_)); const int tid=tid_,lane=tid&63,r32=lane&31,hi=lane>>5; const int wid=__builtin_amdgcn_readfirstlane(tid>>6);
  const long rowbase=(long)b*SEQ; const int q0=qb*QB;
  const bf16*Qw=Q+(rowbase+q0+wid*QBLK)*DM+h*D;
  const bf16*Kh=K+rowbase*DM+h*D,*Vh=V+rowbase*DM+h*D;
  const unsigned lds0=(unsigned)(uintptr_t)shm;
  float*wsf=(float*)(shm+LDS_WS)+wid*128; const unsigned*selp=(const unsigned*)(shm+LDS_SEL)+ui*QB+wid*QBLK+r32;

  const bf16*ksrc=Kh+(long)lane*DM+wid*8;
  const bf16*vsrc=Vh+(long)(16*(wid&3)+(lane>>2))*DM+(wid>>2)*32+(lane&3)*8;
  const unsigned kdst=lds0+LDS_K+wid*1024, vdst=lds0+LDS_V+wid*1024;
  const int tb4=4*qb;
  #define PHYS(t) (((t)<4)?(tb4+(t)):((t)-4))
  #define DMA_K(t,slot) glds16(ksrc+(long)PHYS(t)*KVBLK*DM,(unsigned)__builtin_amdgcn_readfirstlane(kdst+(slot)))
  #define DMA_V(t,slot) glds16(vsrc+(long)PHYS(t)*KVBLK*DM,(unsigned)__builtin_amdgcn_readfirstlane(vdst+(slot)))
  const int vb0=(int)(lds0+LDS_V)+((lane>>4)&1)*32+(lane&3)*8+(4*hi+((lane&15)>>2))*64;
  const char*Kbase=shm+LDS_K; bf16x8 kf[8];
  const lds_cptr shm3=(lds_cptr)shm; const lds_cptr kp0=shm3+LDS_K+hi*1024+r32*16; const lds_cptr vp0=shm3+LDS_V+((lane>>4)&1)*32+(lane&3)*8+(4*hi+((lane&15)>>2))*64;
  const int NT=(q0+QB)/KVBLK;
  DMA_K(0,0);DMA_V(0,0);DMA_K(1,SLOTB);
  bf16x8 qr[4];
  #pragma unroll
  for(int d0=0;d0<4;++d0)qr[d0]=*reinterpret_cast<const bf16x8*>(&Qw[(long)r32*DM+d0*16+hi*8]);

  float mhat=0.f,l_reg=0.f;f32x16 o[2];o[0]=f32x16{};o[1]=f32x16{};const f32x16 negm0=f32x16{};
  const int qrel=wid*QBLK+r32;
  #define CMASK(P0,P1,t) do{ if((t)<4){cmask(P0,P1,(t),qrel,hi);} }while(0)
  bool resc=false;
  #define START(P0,P1) do{ const float rm=rowmax(P0,P1); resc=false; \
    { const float dl=rm; mhat=fadd_s(mhat,dl); \
      _Pragma("unroll") for(int r=0;r<16;++r){P0[r]=fsub_s(P0[r],dl);P1[r]=fsub_s(P1[r],dl);} \
    } \
    _Pragma("unroll") for(int r=0;r<16;++r)P0[r]=__builtin_amdgcn_exp2f(P0[r]); }while(0)
  #define RESC() do{ if(resc){ asm volatile("s_waitcnt lgkmcnt(0)":::"memory"); \
      _Pragma("unroll") for(int d_=0;d_<2;++d_) _Pragma("unroll") for(int r=0;r<16;++r)o[d_][r]*=wsf[crow(r,hi)]; } }while(0)
  f32x16 pA0,pA1,pB0,pB1;
  int sl_prev=0,sl_cur=0,sl_next=SLOTB;
  #define ROT() do{sl_prev=sl_cur;sl_cur=sl_next;sl_next=(sl_next==(NSLOT-1)*SLOTB)?0:sl_next+SLOTB;}while(0)
  DMA_K(2,2*SLOTB);
  WAIT_BAR(3);
  qkt(pA0,pA1,Kbase,qr,negm0,r32,hi);asm volatile("s_nop 15\n\ts_nop 7":"+v"(pA0),"+v"(pA1));CMASK(pA0,pA1,0);
  START(pA0,pA1);
  _Pragma("unroll") for(int r=0;r<16;++r)pA1[r]=__builtin_amdgcn_exp2f(pA1[r]);
  WAIT_BAR(0);
  DMA_K(3,0);DMA_V(1,SLOTB);
  ROT();
  kload8(kf,kp0+sl_cur);
  WAIT_BAR(2);
  s16x4 vlo[8],vhi[8]; u32x4 pw0,pw1,pw2,pw3;
  #define PKW(P,B) cvtpk_s(P[B],P[B+1])
  #define PAF(k) __builtin_bit_cast(bf16x8,pw##k)
  #define VFR(i) (bf16x8){vlo[i][0],vlo[i][1],vlo[i][2],vlo[i][3],vhi[i][0],vhi[i][1],vhi[i][2],vhi[i][3]}
  #define PIN(x) asm volatile("":"+v"(x))
  #define MX3(a,b,c) __builtin_fmaxf(__builtin_fmaxf((a),(b)),(c))
  #define GAPA(MF,A0,A1,A2,A3,W0,W1,PW) do{ MF; sacc+=A0; sacc+=A1; sacc+=A2; sacc+=A3; PIN(sacc); W0; W1; PIN(PW); SBAR(); }while(0)
  #define EX(v) __builtin_amdgcn_exp2f(v)
  #define GAPB(MF,X,B) do{ MF; X[B]=EX(X[B]); X[B+1]=EX(X[B+1]); X[B+2]=EX(X[B+2]); X[B+3]=EX(X[B+3]); PIN(X); SBAR(); }while(0)
  #define VRD(i) do{ vlo[i]=vtr(vp_+(((i)>>2)*4096+((i)&3)*1024)); vhi[i]=vtr(vp_+(((i)>>2)*4096+((i)&3)*1024+512)); }while(0)
  #define KRD(G,j) do{ if(G){ kload2(kf,kp0+sl_next,j); SBAR(); } }while(0)
  #define STEP(C0,C1,P0,P1,t,GK,GV,GL) do{ SBAR(); \
    const lds_cptr vp_=vp0+sl_prev; \
    float sacc; { const unsigned sw_=*selp; const float nm_=((sw_>>(((t)<4)?31:((((t)-4)>>2)&7)))&1u)?-mhat:-1.0e30f; f32x16 negm; _Pragma("unroll") for(int r=0;r<16;++r)negm[r]=nm_; asm volatile("":"+v"(negm)); \
    VRD(0); SBAR(); sacc=(P0[0]+P0[1]); \
    GAPA(C0=__builtin_amdgcn_mfma_f32_32x32x16_bf16(kf[0],qr[0],negm,0,0,0), P0[2],P0[3],P0[4],P0[5],     pw0[0]=PKW(P0,0), pw0[1]=PKW(P0,2), pw0); \
    VRD(4); SBAR(); GAPA(C1=__builtin_amdgcn_mfma_f32_32x32x16_bf16(kf[1],qr[0],negm,0,0,0), P0[6],P0[7],P0[8],P0[9],     pw0[2]=PKW(P0,4), pw0[3]=PKW(P0,6), pw0); \
    } \
    VRD(1); SBAR(); GAPA(C0=__builtin_amdgcn_mfma_f32_32x32x16_bf16(kf[2],qr[1],C0,0,0,0),   P0[10],P0[11],P0[12],P0[13], pw1[0]=PKW(P0,8), pw1[1]=PKW(P0,10), pw1); \
    VRD(5); SBAR(); GAPA(C1=__builtin_amdgcn_mfma_f32_32x32x16_bf16(kf[3],qr[1],C1,0,0,0),   P0[14],P0[15],P1[0],P1[1],   pw1[2]=PKW(P0,12),pw1[3]=PKW(P0,14), pw1); \
    VRD(2); SBAR(); GAPA(C0=__builtin_amdgcn_mfma_f32_32x32x16_bf16(kf[4],qr[2],C0,0,0,0),   P1[2],P1[3],P1[4],P1[5],     pw2[0]=PKW(P1,0), pw2[1]=PKW(P1,2), pw2); \
    VRD(6); SBAR(); GAPA(C1=__builtin_amdgcn_mfma_f32_32x32x16_bf16(kf[5],qr[2],C1,0,0,0),   P1[6],P1[7],P1[8],P1[9],     pw2[2]=PKW(P1,4), pw2[3]=PKW(P1,6), pw2); \
    VRD(3); SBAR(); GAPA(C0=__builtin_amdgcn_mfma_f32_32x32x16_bf16(kf[6],qr[3],C0,0,0,0),   P1[10],P1[11],P1[12],P1[13], pw3[0]=PKW(P1,8), pw3[1]=PKW(P1,10), pw3); \
    VRD(7); SBAR(); GAPA(C1=__builtin_amdgcn_mfma_f32_32x32x16_bf16(kf[7],qr[3],C1,0,0,0),   P1[14],P1[15],0.f,0.f,       pw3[2]=PKW(P1,12),pw3[3]=PKW(P1,14), pw3); \
    l_reg+=sacc; \
    if(GK){DMA_K((t)+3,sl_cur);} if(GV){DMA_V((t)+1,sl_next);} \
    CMASK(C0,C1,t); \
    { float a=MX3(C0[0],C0[1],C1[0]),b=MX3(C0[2],C0[3],C1[1]); a=MX3(a,C1[2],C1[3]); \
      _Pragma("unroll") for(int r=4;r<16;r+=4){a=MX3(a,C0[r],C0[r+1]);b=MX3(b,C0[r+2],C0[r+3]);a=MX3(a,C1[r],C1[r+1]);b=MX3(b,C1[r+2],C1[r+3]);} \
      float rm=__builtin_fmaxf(a,b); { auto rr=__builtin_amdgcn_permlane32_swap(__float_as_uint(rm),__float_as_uint(rm),false,false); rm=__builtin_fmaxf(__uint_as_float(rr[0]),__uint_as_float(rr[1])); } \
      resc=false; \
      if(__builtin_expect(__any(rm>(float)THRL),0)){ const float dl=__builtin_fmaxf(rm,0.f); mhat+=dl; \
        _Pragma("unroll") for(int r=0;r<16;++r){C0[r]-=dl;C1[r]-=dl;} \
        const float f=__builtin_amdgcn_exp2f(-dl); l_reg*=f; if(hi==0)wsf[r32]=f; resc=true; } } \
    SBAR(); \
    GAPB(o[0]=__builtin_amdgcn_mfma_f32_32x32x16_bf16(PAF(0),VFR(0),o[0],0,0,0), C0,0); \
    GAPB(o[1]=__builtin_amdgcn_mfma_f32_32x32x16_bf16(PAF(0),VFR(4),o[1],0,0,0), C0,4); \
    KRD(GL,0); GAPB(o[0]=__builtin_amdgcn_mfma_f32_32x32x16_bf16(PAF(1),VFR(1),o[0],0,0,0), C0,8); \
    KRD(GL,1); GAPB(o[1]=__builtin_amdgcn_mfma_f32_32x32x16_bf16(PAF(1),VFR(5),o[1],0,0,0), C0,12); \
    KRD(GL,2); GAPB(o[0]=__builtin_amdgcn_mfma_f32_32x32x16_bf16(PAF(2),VFR(2),o[0],0,0,0), C1,0); \
    KRD(GL,3); GAPB(o[1]=__builtin_amdgcn_mfma_f32_32x32x16_bf16(PAF(2),VFR(6),o[1],0,0,0), C1,4); \
    GAPB(o[0]=__builtin_amdgcn_mfma_f32_32x32x16_bf16(PAF(3),VFR(3),o[0],0,0,0), C1,8); \
    GAPB(o[1]=__builtin_amdgcn_mfma_f32_32x32x16_bf16(PAF(3),VFR(7),o[1],0,0,0), C1,12); \
    }while(0)
  int t=1;
  for(;t+5<NT;t+=2){
    STEP(pB0,pB1,pA0,pA1,t,true,true,true);     WAIT_BAR(2); RESC(); ROT();
    STEP(pA0,pA1,pB0,pB1,t+1,true,true,true);   WAIT_BAR(2); RESC(); ROT();
  }
  #define ENDW(tt) do{ if((tt)+3<NT){WAIT_BAR(2);} else if((tt)+2<NT){WAIT_BAR(1);} else {WAIT_BAR(0);} }while(0)
  for(;t+1<NT;t+=2){
    STEP(pB0,pB1,pA0,pA1,t,(t+3<NT),(t+1<NT),(t+1<NT));       ENDW(t);   RESC(); ROT();
    STEP(pA0,pA1,pB0,pB1,t+1,(t+4<NT),(t+2<NT),(t+2<NT));     ENDW(t+1); RESC(); ROT();
  }
  STEP(pB0,pB1,pA0,pA1,NT-1,false,false,false); RESC();
  { float sacc=pB0[0]+pB0[1]; _Pragma("unroll") for(int r=2;r<16;++r)sacc+=pB0[r]; _Pragma("unroll") for(int r=0;r<16;++r)sacc+=pB1[r]; l_reg+=sacc;
    pw0=(u32x4){PKW(pB0,0),PKW(pB0,2),PKW(pB0,4),PKW(pB0,6)};pw1=(u32x4){PKW(pB0,8),PKW(pB0,10),PKW(pB0,12),PKW(pB0,14)};pw2=(u32x4){PKW(pB1,0),PKW(pB1,2),PKW(pB1,4),PKW(pB1,6)};pw3=(u32x4){PKW(pB1,8),PKW(pB1,10),PKW(pB1,12),PKW(pB1,14)};
    SBAR(); pv(o,vb0+sl_cur,PAF(0),PAF(1),PAF(2),PAF(3)); }
  #undef PKW
  #undef PAF
  #undef VFR
  #undef PIN
  #undef MX3
  #undef GAPA
  #undef GAPB
  #undef EX
  #undef VRD
  #undef KRD
  #undef STEP
  #undef ENDW
  {auto rr=__builtin_amdgcn_permlane32_swap(__float_as_uint(l_reg),__float_as_uint(l_reg),false,false);l_reg=__uint_as_float(rr[0])+__uint_as_float(rr[1]);}
  if(hi==0)wsf[32+r32]=l_reg;asm volatile("s_waitcnt lgkmcnt(0)":::"memory");
  float rli[16];
  #pragma unroll
  for(int r=0;r<16;++r)rli[r]=__builtin_amdgcn_rcpf(wsf[32+crow(r,hi)]);
  bf16*Ow=O+(rowbase+q0+wid*QBLK)*DMO+h*D;
  { bf16*stg=(bf16*)(shm+LDS_OST)+wid*2048;
    #pragma unroll
    for(int r=0;r<16;++r){const int orow=crow(r,hi);
      #pragma unroll
      for(int d0=0;d0<2;++d0)stg[orow*64+d0*32+r32]=__float2bfloat16(o[d0][r]*rli[r]);}
    asm volatile("s_waitcnt lgkmcnt(0)":::"memory");
    #pragma unroll
    for(int i=0;i<4;++i){const int row=i*8+(lane>>3),ch=lane&7; const u32x4 v=*(const u32x4*)(stg+row*64+ch*8); ATTN_STORE16(Ow+(long)row*DMO+ch*8,v);
      float sq=0.f;
      #pragma unroll
      for(int e=0;e<4;++e){const float lo_=__uint_as_float(v[e]<<16),hi_=__uint_as_float(v[e]&0xffff0000u); sq+=lo_*lo_+hi_*hi_;}
      sq+=__shfl_xor(sq,1); sq+=__shfl_xor(sq,2); sq+=__shfl_xor(sq,4);
      if(ch==0)SSA[(rowbase+q0+wid*QBLK+row)*8+h]=sq; } }
  asm volatile("s_waitcnt lgkmcnt(0)\n\ts_barrier":::"memory");
  #undef DMA_K
  #undef DMA_V
  #undef PHYS
  #undef CMASK
  #undef START
  #undef RESC
  #undef ROT
}
constexpr int ATTN_LDS_BYTES=LDS_BYTES;
struct AttnTensors { const bf16* Q; const bf16* K; const bf16* V; bf16* O; const float* KM; float* SSA; };
struct AttnUnit { int bh; int qb; };
struct StaticOrder {
  int vcu,G;
  __device__ __forceinline__ explicit StaticOrder(int grid,int block):vcu((grid%8==0)?((block%8)*(grid/8)+block/8):block),G(grid){}
  __device__ __forceinline__ bool next(int i,AttnUnit&u)const{ const int it=(i>>2)*G+vcu; if(it>=2*BATCH*NHEAD)return false; const int j=i&3,s=it&1; u.bh=it>>1; u.qb=s?((j==0)?6:(j==1)?5:(j==2)?2:1):((j==0)?7:(j==1)?4:(j==2)?3:0); return true; }
  __device__ __forceinline__ void a_ready(const AttnUnit&)const{}
  __device__ __forceinline__ void done(const AttnUnit&)const{}
};
__device__ __forceinline__ void attn_select(int b,int h,int qb,const bf16*Q,const float*__restrict__ KM,int ui,char*shm){
  int tid_=threadIdx.x; asm volatile("":"+v"(tid_)); const int tid=tid_,lane=tid&63,r32=lane&31,hi=lane>>5; const int wid=__builtin_amdgcn_readfirstlane(tid>>6);
  unsigned*selw=(unsigned*)(shm+LDS_SEL)+ui*QB+wid*QBLK+r32; float*kml=(float*)(shm+LDS_K);
  unsigned word=0xffffffffu;
  if(qb>3){
    if(tid<qb*64){ const long ki=((long)(b*NHEAD+h)*8)*64+tid; kml[tid]=(KM[ki]+KM[(long)BATCH*NHEAD*8*64+ki])*(1.0f/256.0f); }
    const bf16*qrow=Q+((long)b*SEQ+qb*QB+wid*QBLK+r32)*DM+h*D+hi*8; uint4 qv[4];
    #pragma unroll
    for(int d0=0;d0<4;++d0)qv[d0]=*reinterpret_cast<const uint4*>(qrow+d0*16);
    asm volatile("s_waitcnt vmcnt(0) lgkmcnt(0)\n\ts_barrier":::"memory");
    float g1=-3.0e38f,g2=-3.0e38f,g3=-3.0e38f; int i1=0,i2=0,i3=0;
    #pragma unroll 1
    for(int n=0;n<qb;++n){ const float*km=kml+n*64+hi*8; float a=0.f;
      #pragma unroll
      for(int d0=0;d0<4;++d0){ const float4 k0=*(const float4*)(km+d0*16),k1=*(const float4*)(km+d0*16+4); const uint4 q4=qv[d0];
        a+=__uint_as_float(q4.x<<16)*k0.x+__uint_as_float(q4.x&0xffff0000u)*k0.y+__uint_as_float(q4.y<<16)*k0.z+__uint_as_float(q4.y&0xffff0000u)*k0.w
          +__uint_as_float(q4.z<<16)*k1.x+__uint_as_float(q4.z&0xffff0000u)*k1.y+__uint_as_float(q4.w<<16)*k1.z+__uint_as_float(q4.w&0xffff0000u)*k1.w; }
      a+=__shfl_xor(a,32);
      if(a>g1){g3=g2;i3=i2;g2=g1;i2=i1;g1=a;i1=n;} else if(a>g2){g3=g2;i3=i2;g2=a;i2=n;} else if(a>g3){g3=a;i3=n;} }
    word=0x80000000u|(1u<<i1)|(1u<<i2)|(1u<<i3); }
  if(hi==0)*selw=word;
  asm volatile("s_waitcnt lgkmcnt(0)\n\ts_barrier":::"memory");
}
__device__ __forceinline__ int attn_qb(int role,int j){ return role?((j==0)?5:(j==1)?3:(j==2)?2:0):((j==0)?7:(j==1)?6:(j==2)?4:1); }
template<int THRL=8> __device__ __forceinline__ void attn_item(char*lds,const AttnTensors&T,int it){
  const int bh=it>>1,role=it&1,b=bh/NHEAD,h=bh%NHEAD; const int nu=4;
  for(int j=0;j<nu;++j)attn_select(b,h,attn_qb(role,j),T.Q,T.KM,j,lds);
  for(int j=0;j<nu;++j)attn_unit<THRL>(b,h,attn_qb(role,j),T.Q,T.K,T.V,T.O,T.SSA,j,lds);
}
template<class Sched,int THRL=8> __device__ __forceinline__ void attn_phase(char*lds,const AttnTensors&T,const Sched&S){
  AttnUnit u;
  for(int i=0;i<16&&S.next(i,u);++i)attn_select(u.bh/NHEAD,u.bh%NHEAD,u.qb,T.Q,T.KM,i,lds);
  for(int i=0;i<16&&S.next(i,u);++i){ S.a_ready(u); attn_unit<THRL>(u.bh/NHEAD,u.bh%NHEAD,u.qb,T.Q,T.K,T.V,T.O,T.SSA,i,lds); S.done(u); }
}
#undef SBAR
#undef WAIT_BAR
}

namespace cross_body {
typedef short bf16x8 __attribute__((ext_vector_type(8)));
typedef float f32x4 __attribute__((ext_vector_type(4)));
typedef unsigned u32x2 __attribute__((ext_vector_type(2)));
typedef unsigned u32x4 __attribute__((ext_vector_type(4)));
#define CB_LAS __attribute__((address_space(3)))
constexpr int TILE_OFF = 0, PW_OFF = 65536, LDS_BYTES = 65536 + 8 * 8192;
#define CB_BAR() asm volatile("s_waitcnt lgkmcnt(0)\n\ts_barrier" ::: "memory")
#define CB_VMWAIT() asm volatile("s_waitcnt vmcnt(0)" ::: "memory")
__device__ __forceinline__ void cross_stage(CB_LAS unsigned char* buf, const unsigned short* KC, const unsigned short* VT, int b, int hd, int i, int wid, const unsigned (&voK)[4], const unsigned (&voV)[4]) {
    if (i < 4) { const unsigned short* base = KC + (size_t)(b * 256 + 64 * i) * 1024 + hd * 256;
#pragma unroll
        for (int q = 0; q < 4; ++q) __builtin_amdgcn_global_load_lds((const unsigned*)(base + voK[q]), (CB_LAS unsigned*)(buf + (wid * 4 + q) * 1024), 16, 0, 0);
    } else { const unsigned short* base = VT + (size_t)(hd * 256) * 4096 + b * 256 + 64 * (i - 4);
#pragma unroll
        for (int q = 0; q < 4; ++q) __builtin_amdgcn_global_load_lds((const unsigned*)(base + voV[q]), (CB_LAS unsigned*)(buf + (wid * 4 + q) * 1024), 16, 0, 0);
    }
}
__device__ __forceinline__ void cross_unit(CB_LAS unsigned char* lds, const unsigned short* QC, const unsigned short* KC, const unsigned short* VT, unsigned short* OC, int b, int hd, int t0, bf16x8 (&qf)[8], bool first, bool has_next, int nb_, int nhd, int nt0, int zz = 0) {
    const int tid = threadIdx.x + zz, lane = tid & 63, n = lane & 15, g = lane >> 4; const int wid = __builtin_amdgcn_readfirstlane(tid >> 6);
    CB_LAS unsigned char* pw = lds + PW_OFF + wid * 8192;
    unsigned voK[4], voV[4];
#pragma unroll
    for (int q = 0; q < 4; ++q) { const int off = (wid * 4 + q) * 1024 + lane * 16; { const int row = off >> 9, c = (off >> 4) & 31, sc = c ^ (row & 15); voK[q] = (unsigned)(row * 1024 + 8 * sc); }
        { const int row = off >> 7, c = (off >> 4) & 7, sc = c ^ ((row >> 1) & 7); voV[q] = (unsigned)(row * 4096 + 8 * sc); } }
    if (first) {
        CB_BAR();
        cross_stage(lds + TILE_OFF, KC, VT, b, hd, 0, wid, voK, voV);
        const unsigned short* qrow = QC + (size_t)(t0 + wid * 16 + n) * 1024 + hd * 256 + 8 * g;
#pragma unroll
        for (int ks = 0; ks < 8; ++ks) qf[ks] = *(const bf16x8*)(qrow + 32 * ks);
    }
    f32x4 s[16];
#pragma unroll
    for (int i = 0; i < 16; ++i) s[i] = (f32x4){0.f, 0.f, 0.f, 0.f};
#pragma unroll
    for (int kt = 0; kt < 4; ++kt) {
        CB_LAS unsigned char* tile = lds + TILE_OFF + (kt & 1) * 32768;
        CB_VMWAIT(); CB_BAR();
        cross_stage(lds + TILE_OFF + ((kt + 1) & 1) * 32768, KC, VT, b, hd, kt + 1, wid, voK, voV);
#pragma unroll
        for (int nb = 0; nb < 4; ++nb) { const int row = 16 * nb + n;
#pragma unroll
            for (int ks = 0; ks < 8; ++ks) { const bf16x8 kf = *(const CB_LAS bf16x8*)(tile + row * 512 + (((4 * ks + g) ^ (row & 15)) << 4));
                s[kt * 4 + nb] = __builtin_amdgcn_mfma_f32_16x16x32_bf16(kf, qf[ks], s[kt * 4 + nb], 0, 0, 0); }
            if (nb & 1) __builtin_amdgcn_sched_barrier(0); }
    }
    float mx = -3.0e38f;
#pragma unroll
    for (int i = 0; i < 16; ++i) mx = fmaxf(mx, fmaxf(fmaxf(s[i][0], s[i][1]), fmaxf(s[i][2], s[i][3])));
    mx = fmaxf(mx, __shfl_xor(mx, 16)); mx = fmaxf(mx, __shfl_xor(mx, 32));
    const float c2 = 0.0625f * 1.4426950408889634f; float l = 0.f;
#pragma unroll
    for (int i = 0; i < 16; ++i) {
        f32x4 p; p[0] = __builtin_amdgcn_exp2f((s[i][0] - mx) * c2); p[1] = __builtin_amdgcn_exp2f((s[i][1] - mx) * c2); p[2] = __builtin_amdgcn_exp2f((s[i][2] - mx) * c2); p[3] = __builtin_amdgcn_exp2f((s[i][3] - mx) * c2);
        l += (p[0] + p[1]) + (p[2] + p[3]);
        u32x2 w; w.x = pg8::cvt_pk_bf16(p[0], p[1]); w.y = pg8::cvt_pk_bf16(p[2], p[3]);
        *(CB_LAS u32x2*)(pw + n * 512 + (((2 * i + (g >> 1)) ^ n) << 4) + ((g & 1) << 3)) = w;
    }
    l += __shfl_xor(l, 16); l += __shfl_xor(l, 32);
    const float linv = 1.0f / l;
    f32x4 o[16];
#pragma unroll
    for (int i = 0; i < 16; ++i) o[i] = (f32x4){0.f, 0.f, 0.f, 0.f};
#pragma unroll
    for (int kt = 0; kt < 4; ++kt) {
        CB_LAS unsigned char* tile = lds + TILE_OFF + (kt & 1) * 32768;
        CB_VMWAIT(); CB_BAR();
        if (kt < 3) cross_stage(lds + TILE_OFF + ((kt + 1) & 1) * 32768, KC, VT, b, hd, 5 + kt, wid, voK, voV);
        else if (has_next) {
            cross_stage(lds + TILE_OFF, KC, VT, nb_, nhd, 0, wid, voK, voV);
            const unsigned short* qrow = QC + (size_t)(nt0 + wid * 16 + n) * 1024 + nhd * 256 + 8 * g;
#pragma unroll
            for (int ks = 0; ks < 8; ++ks) qf[ks] = *(const bf16x8*)(qrow + 32 * ks); }
        bf16x8 pf[2];
#pragma unroll
        for (int ks = 0; ks < 2; ++ks) pf[ks] = *(const CB_LAS bf16x8*)(pw + n * 512 + (((8 * kt + 4 * ks + g) ^ n) << 4));
#pragma unroll
        for (int db = 0; db < 16; ++db) { const int row = 16 * db + n;
#pragma unroll
            for (int ks = 0; ks < 2; ++ks) { const bf16x8 vf = *(const CB_LAS bf16x8*)(tile + row * 128 + (((4 * ks + g) ^ ((row >> 1) & 7)) << 4));
                o[db] = __builtin_amdgcn_mfma_f32_16x16x32_bf16(vf, pf[ks], o[db], 0, 0, 0); }
            if ((db & 7) == 7) __builtin_amdgcn_sched_barrier(0); }
    }
    asm volatile("s_waitcnt lgkmcnt(0)" ::: "memory");
#pragma unroll
    for (int db = 0; db < 16; ++db) { u32x2 w; w.x = pg8::cvt_pk_bf16(o[db][0] * linv, o[db][1] * linv); w.y = pg8::cvt_pk_bf16(o[db][2] * linv, o[db][3] * linv);
        *(CB_LAS u32x2*)(pw + n * 512 + (((2 * db + (g >> 1)) ^ n) << 4) + ((g & 1) << 3)) = w; }
    asm volatile("s_waitcnt lgkmcnt(0)" ::: "memory");
#pragma unroll
    for (int i = 0; i < 8; ++i) { const int row = 2 * i + (lane >> 5), c = lane & 31; const u32x4 v = *(const CB_LAS u32x4*)(pw + row * 512 + ((c ^ row) << 4));
        *(u32x4*)(OC + (size_t)(t0 + wid * 16 + row) * 1024 + hd * 256 + 8 * c) = v; }
    asm volatile("s_waitcnt lgkmcnt(0)" ::: "memory");
}
__device__ __forceinline__ void cross_phase(CB_LAS unsigned char* lds, const unsigned short* QC, const unsigned short* KC, const unsigned short* VT, unsigned short* OC, int vcu, int G) {
    bf16x8 qf[8]; bool first = true;
    for (int u = vcu; u < 16 * 4 * 16; u += G) { const int tt = u & 15, hd = (u >> 4) & 3, b = u >> 6; const int un = u + G; const bool hn = un < 16 * 4 * 16;
        cross_unit(lds, QC, KC, VT, OC, b, hd, b * 2048 + tt * 128, qf, first, hn, un >> 6, (un >> 4) & 3, (un >> 6) * 2048 + (un & 15) * 128); first = false; }
    CB_VMWAIT(); CB_BAR();
}
#undef CB_BAR
#undef CB_VMWAIT
#undef CB_LAS
}

namespace route_body {
typedef short bf16x8 __attribute__((ext_vector_type(8)));
typedef float f32x4 __attribute__((ext_vector_type(4)));
typedef unsigned u32x2 __attribute__((ext_vector_type(2)));
typedef unsigned u32x4 __attribute__((ext_vector_type(4)));
#define RB_LAS __attribute__((address_space(3)))
constexpr int SUB_OFF = 0, LIST_OFF = 65536, LDS_BYTES = 65536 + 8 * 2048;
__device__ __forceinline__ unsigned ordf(float f) { return __float_as_uint(f); }
__device__ __forceinline__ float unordf(unsigned k) { return __uint_as_float(k); }
__device__ __forceinline__ unsigned umax_(unsigned a, unsigned b) { unsigned r; asm("v_max_f32 %0, %1, %2" : "=v"(r) : "v"(a), "v"(b)); return r; }
__device__ __forceinline__ unsigned umin_(unsigned a, unsigned b) { unsigned r; asm("v_min_f32 %0, %1, %2" : "=v"(r) : "v"(a), "v"(b)); return r; }
#define RB_CE(x, i, l) do { const unsigned hi_ = umax_(x[i], x[l]), lo_ = umin_(x[i], x[l]); x[i] = hi_; x[l] = lo_; } while (0)
#define RB_CEA(x, i, l) do { const unsigned hi_ = umax_(x[i], x[l]), lo_ = umin_(x[i], x[l]); x[i] = lo_; x[l] = hi_; } while (0)
__device__ __forceinline__ void sort16(unsigned (&x)[16]) {
#pragma unroll
    for (int p = 1; p < 16; p <<= 1)
#pragma unroll
        for (int k = p; k >= 1; k >>= 1)
#pragma unroll
            for (int j = k % p; j <= 15 - k; j += 2 * k)
#pragma unroll
                for (int i = 0; i <= ((k - 1) < (15 - j - k) ? (k - 1) : (15 - j - k)); ++i)
                    if ((i + j) / (2 * p) == (i + j + k) / (2 * p)) RB_CE(x, i + j, i + j + k);
}
__device__ __forceinline__ void bmerge16(unsigned (&x)[16]) {
#pragma unroll
    for (int j = 8; j > 0; j >>= 1)
#pragma unroll
        for (int i = 0; i < 16; ++i) { const int l = i ^ j; if (l > i) RB_CE(x, i, l); }
}
__device__ __forceinline__ void mergetop(unsigned (&a)[16], const unsigned (&b)[16]) {
#pragma unroll
    for (int i = 0; i < 16; ++i) a[i] = umax_(a[i], b[15 - i]);
    bmerge16(a);
}
__device__ __forceinline__ void xmergetop(unsigned (&a)[16], int mask) {
    unsigned b[16];
#pragma unroll
    for (int i = 0; i < 16; ++i) b[i] = (unsigned)__shfl_xor((int)a[i], mask);
    mergetop(a, b);
}
__device__ __forceinline__ unsigned cand(float fa, float fb, int i, int j) { return (ordf(fa + fb) & ~0xFFu) | (unsigned)(255 - (i * 16 + j)); }

struct StrideTiles { int first, step, n; __device__ __forceinline__ int count() const { return n; } __device__ __forceinline__ int at(int k) const { return first + k * step; } };
struct PanelTiles { int pm0, pm1; __device__ __forceinline__ int count() const { return 4; } __device__ __forceinline__ int at(int k) const { return 2 * ((k >> 1) ? pm1 : pm0) + (k & 1); } };
template <class ST, class TT> __device__ __forceinline__ void route_phase(RB_LAS unsigned char* lds, const unsigned short* PQ, const unsigned short* SUBK, unsigned short* IDS, float* GATES, int h, const TT& tts, ST& st, bool drain) {
    const int tid = threadIdx.x, lane = tid & 63, n = lane & 15, g = lane >> 4; const int wid = __builtin_amdgcn_readfirstlane(tid >> 6);
    RB_LAS unsigned char* sub = lds + SUB_OFF; RB_LAS unsigned* lst = (RB_LAS unsigned*)(lds + LIST_OFF + wid * 2048) + n * 32;
    __syncthreads();
#pragma unroll
    for (int i = 0; i < 8; ++i) { const int off = (wid * 8 + i) * 1024 + lane * 16, R = off >> 8, c = (off >> 4) & 15, sc = c ^ (R & 15);
        __builtin_amdgcn_global_load_lds((const unsigned*)(SUBK + ((size_t)h * 256 + R) * 128 + 8 * sc), (RB_LAS unsigned*)(sub + (wid * 8 + i) * 1024), 16, 0, 0); }
    asm volatile("s_waitcnt vmcnt(0)" ::: "memory");
    __syncthreads();
    for (int ti = 0; ti < tts.count(); ++ti) { const int tt = tts.at(ti);
        const int t = tt * 128 + wid * 16 + n;
        bf16x8 qf[8];
        { const unsigned short* qrow = PQ + (size_t)t * 2048 + h * 256 + 8 * g;
#pragma unroll
          for (int ks = 0; ks < 8; ++ks) qf[ks] = *(const bf16x8*)(qrow + 32 * ks); }
        unsigned key[2][2][16];
#pragma unroll
        for (int p = 0; p < 2; ++p)
#pragma unroll
            for (int kblk = 0; kblk < 8; ++kblk) { const int R = p * 128 + 16 * kblk + n; f32x4 s = (f32x4){0.f, 0.f, 0.f, 0.f};
#pragma unroll
                for (int ks = 0; ks < 4; ++ks) { const bf16x8 kf = *(const RB_LAS bf16x8*)(sub + R * 256 + (((4 * ks + g) ^ (R & 15)) << 4));
                    s = __builtin_amdgcn_mfma_f32_16x16x32_bf16(kf, qf[p * 4 + ks], s, 0, 0, 0); }
#pragma unroll
                for (int r = 0; r < 4; ++r) key[p][kblk >> 2][(kblk & 3) * 4 + r] = (ordf(s[r]) & ~0x7Fu) | (unsigned)(127 - (16 * kblk + 4 * g + r)); }
        const bool shave = st.k < st.count; if (shave) st.issue(st.k);
        unsigned top[2][16];
#pragma unroll
        for (int p = 0; p < 2; ++p) {
            sort16(key[p][0]); sort16(key[p][1]); mergetop(key[p][0], key[p][1]); xmergetop(key[p][0], 16); xmergetop(key[p][0], 32);
#pragma unroll
            for (int i = 0; i < 16; ++i) top[p][i] = key[p][0][i];
        }
#pragma unroll
        for (int r = 0; r < 4; ++r) { const unsigned va = g == 0 ? top[0][r] : g == 1 ? top[0][4 + r] : g == 2 ? top[0][8 + r] : top[0][12 + r];
            const unsigned vb = g == 0 ? top[1][r] : g == 1 ? top[1][4 + r] : g == 2 ? top[1][8 + r] : top[1][12 + r]; lst[4 * g + r] = va; lst[16 + 4 * g + r] = vb; }
        float fa[16], fb[16];
#pragma unroll
        for (int i = 0; i < 16; ++i) { fa[i] = unordf(top[0][i] & ~0x7Fu); fb[i] = unordf(top[1][i] & ~0x7Fu); }
        unsigned c[16];
#pragma unroll
        for (int i = 0; i < 16; ++i) c[i] = 0xFF800000u;
        if (g == 0) {
#pragma unroll
            for (int j = 0; j < 16; ++j) c[j] = cand(fa[0], fb[j], 0, j);
        } else if (g == 1) {
#pragma unroll
            for (int j = 0; j < 8; ++j) c[j] = cand(fa[1], fb[j], 1, j);
#pragma unroll
            for (int j = 0; j < 3; ++j) c[8 + j] = cand(fa[4], fb[j], 4, j);
            c[11] = cand(fa[8], fb[0], 8, 0); c[12] = cand(fa[9], fb[0], 9, 0); c[13] = cand(fa[10], fb[0], 10, 0);
        } else if (g == 2) {
#pragma unroll
            for (int j = 0; j < 5; ++j) c[j] = cand(fa[2], fb[j], 2, j);
#pragma unroll
            for (int j = 0; j < 4; ++j) c[5 + j] = cand(fa[3], fb[j], 3, j);
#pragma unroll
            for (int i = 11; i < 16; ++i) c[9 + (i - 11)] = cand(fa[i], fb[0], i, 0);
        } else {
#pragma unroll
            for (int i = 5; i < 8; ++i) { c[2 * (i - 5)] = cand(fa[i], fb[0], i, 0); c[2 * (i - 5) + 1] = cand(fa[i], fb[1], i, 1); }
        }
        sort16(c); xmergetop(c, 16); xmergetop(c, 32);
        const float mxs = unordf(c[0] & ~0xFFu);
        asm volatile("s_waitcnt lgkmcnt(0)" ::: "memory");
        unsigned ids[4]; float pe[4]; float ls = 0.f;
#pragma unroll
        for (int r = 0; r < 4; ++r) { const unsigned key = g == 0 ? c[r] : g == 1 ? c[4 + r] : g == 2 ? c[8 + r] : c[12 + r]; const int pos = 255 - (int)(key & 0xFFu);
            const unsigned ka_ = lst[pos >> 4], kb_ = lst[16 + (pos & 15)];
            ids[r] = (127u - (ka_ & 0x7Fu)) * 128u + (127u - (kb_ & 0x7Fu));
            const float sv = unordf(ka_ & ~0x7Fu) + unordf(kb_ & ~0x7Fu); pe[r] = __builtin_amdgcn_exp2f((sv - mxs) * 1.4426950408889634f); ls += pe[r]; }
        ls += __shfl_xor(ls, 16); ls += __shfl_xor(ls, 32);
        const float linv = 1.0f / ls;
#pragma unroll
        for (int r = 0; r < 4; ++r) { const int k = 4 * g + r; IDS[(size_t)t * 128 + (k & 7) * 16 + 2 * h + (k >> 3)] = (unsigned short)ids[r]; }
        *(f32x4*)(GATES + (size_t)t * 128 + h * 16 + 4 * g) = (f32x4){pe[0] * linv, pe[1] * linv, pe[2] * linv, pe[3] * linv};
        asm volatile("s_waitcnt lgkmcnt(0)" ::: "memory");
        if (shave) { st.finish(st.k); ++st.k; }
    }
    __syncthreads();
    if (drain && st.k < st.count) {
        RB_LAS unsigned char* const bA = st.buf; RB_LAS unsigned char* const sA = st.sbuf; RB_LAS unsigned char* const bB = lds + SUB_OFF + wid * 8192; RB_LAS unsigned char* const sB = lds + LIST_OFF + wid * 256;
        st.issue(st.k);
        for (int par = 0; st.k < st.count; ++st.k, par ^= 1) {
            if (st.k + 1 < st.count) { st.buf = par ? bA : bB; st.sbuf = par ? sA : sB; st.issue(st.k + 1); if (st.item_of(st.k + 1) < 16384) asm volatile("s_waitcnt vmcnt(4)" ::: "memory"); else asm volatile("s_waitcnt vmcnt(9)" ::: "memory"); } else asm volatile("s_waitcnt vmcnt(0)" ::: "memory");
            st.buf = par ? bB : bA; st.sbuf = par ? sB : sA; st.template finish<false>(st.k); }
        st.buf = bA; st.sbuf = sA; }
    __syncthreads();
}
#undef RB_CE
#undef RB_CEA
#undef RB_LAS
}

namespace lru_body {
typedef short bf16x8 __attribute__((ext_vector_type(8)));
typedef float f32x4 __attribute__((ext_vector_type(4)));
typedef unsigned u32x4 __attribute__((ext_vector_type(4)));
#define LB_LAS __attribute__((address_space(3)))
#define LB_BAR() asm volatile("s_waitcnt lgkmcnt(0)\n\ts_barrier" ::: "memory")
#define LB_LDSWAIT() do { asm volatile("s_waitcnt lgkmcnt(0)" ::: "memory"); __builtin_amdgcn_sched_barrier(0); } while (0)
constexpr int XS_OFF = 0  , XC_OFF = 17408  , WT_OFF = 33792  , RI_OFF = 50176  , EX_OFF = 119808  , LDS_BYTES = 123904;
constexpr int RSTR = 68;
__device__ __forceinline__ float bf(unsigned short b) { return __uint_as_float(((unsigned)b) << 16); }
__device__ __forceinline__ float sigm(float v) { return __builtin_amdgcn_rcpf(1.0f + __builtin_amdgcn_exp2f(-1.4426950408889634f * v)); }
__device__ __forceinline__ float gelu_as(float v) {
    const float av = fabsf(v), t = __builtin_amdgcn_rcpf(1.0f + 0.2316418882f * av);
    float q = t * 0.5307027145f + (-0.7265760135f); q = q * t + 0.7107068705f; q = q * t + (-0.142248368f); q = q * t + 0.127414796f; q = q * t;
    const float e = __builtin_amdgcn_exp2f(v * v * (-0.72134752044f)); const float m = v * (q * e); return v < 0.f ? m : v - m;
}
typedef float f32x2 __attribute__((ext_vector_type(2)));
__device__ __forceinline__ f32x2 exp2_2(f32x2 v) { return (f32x2){__builtin_amdgcn_exp2f(v.x), __builtin_amdgcn_exp2f(v.y)}; }
__device__ __forceinline__ f32x2 rcp_2(f32x2 v) { return (f32x2){__builtin_amdgcn_rcpf(v.x), __builtin_amdgcn_rcpf(v.y)}; }
__device__ __forceinline__ f32x2 sqrt_2(f32x2 v) { return (f32x2){__builtin_amdgcn_sqrtf(v.x), __builtin_amdgcn_sqrtf(v.y)}; }
__device__ __forceinline__ f32x2 splat2(float v) { return (f32x2){v, v}; }
__device__ __forceinline__ f32x2 gelu_as2(f32x2 v) {
    const f32x2 av = (f32x2){fabsf(v.x), fabsf(v.y)}, t = rcp_2(splat2(1.0f) + splat2(0.2316418882f) * av);
    f32x2 q = t * splat2(0.5307027145f) + splat2(-0.7265760135f); q = q * t + splat2(0.7107068705f); q = q * t + splat2(-0.142248368f); q = q * t + splat2(0.127414796f); q = q * t;
    const f32x2 e = exp2_2(v * v * splat2(-0.72134752044f)); const f32x2 m = v * (q * e); const f32x2 d = v - m;
    return (f32x2){v.x < 0.f ? m.x : d.x, v.y < 0.f ? m.y : d.y};
}
__device__ __forceinline__ void lru_item(LB_LAS unsigned char* lds, int b, int blk, const unsigned short* PROJ, unsigned short* MIXED, float* SSL, const float* conv_w, const float* conv_b, const float* wa, const float* ba_, const float* wx,
                                         const float* bx_, const float* lam) {
    int tid_ = threadIdx.x; asm volatile("" : "+v"(tid_)); const int tid = tid_, c = tid & 63, n = tid & 15, g = (tid >> 4) & 3; const int s = __builtin_amdgcn_readfirstlane(tid >> 6);
    const int cb = blk * 64;
    LB_LAS unsigned short* XS = (LB_LAS unsigned short*)(lds + XS_OFF); LB_LAS unsigned char* XC = lds + XC_OFF; LB_LAS unsigned char* WT = lds + WT_OFF;
    LB_LAS float* RI = (LB_LAS float*)(lds + RI_OFF); LB_LAS float* EX = (LB_LAS float*)(lds + EX_OFF);
    __syncthreads();
    for (int i = tid; i < 2 * 4096; i += 512) { const int mat = i >> 12, d = (i >> 6) & 63, e = i & 63; const float v = (mat ? wx : wa)[(size_t)(blk * 64 + d) * 64 + e];
        *(LB_LAS unsigned short*)(WT + mat * 8192 + e * 128 + ((((d >> 3) ^ ((e >> 1) & 7))) << 4) + (d & 7) * 2) = (unsigned short)f2bf(v); }
    const float w0 = conv_w[0 * 512 + cb + c], w1 = conv_w[1 * 512 + cb + c], w2 = conv_w[2 * 512 + cb + c], w3 = conv_w[3 * 512 + cb + c], cbias = conv_b[cb + c];
    const float ba = ba_[cb + c], bx = bx_[cb + c], sp8 = 8.0f * log1pf(expf(-lam[cb + c]));
    const size_t tbase = (size_t)b * 2048;
    u32x4 xv[3];
#define LB_XLOAD(T0) do { _Pragma("unroll") for (int p_ = 0; p_ < 3; ++p_) { const int idx_ = tid + 512 * p_, row_ = idx_ >> 3, ch_ = idx_ & 7; const long tok_ = (long)(T0) - 3 + row_; \
        xv[p_] = (u32x4){0u, 0u, 0u, 0u}; if (row_ < 131 && tok_ >= 0) xv[p_] = *(const u32x4*)(PROJ + (tbase + tok_) * 2560 + cb + 8 * ch_); } } while (0)
#define LB_XSTORE() do { _Pragma("unroll") for (int p_ = 0; p_ < 3; ++p_) { const int idx_ = tid + 512 * p_, row_ = idx_ >> 3, ch_ = idx_ & 7; if (row_ < 131) *(LB_LAS u32x4*)(XS + row_ * 64 + 8 * ch_) = xv[p_]; } } while (0)
    LB_XLOAD(0); LB_XSTORE();
    float carry = 0.f;
    for (int k = 0; k < 16; ++k) {
        const int T0 = 128 * k;
        LB_BAR();
        unsigned short gt[16];
#pragma unroll
        for (int i = 0; i < 16; ++i) gt[i] = PROJ[(tbase + T0 + 16 * s + i) * 2560 + 512 + cb + c];
        float xc[16];
        { float xs[19];
          unsigned short xr[19];
#pragma unroll
          for (int j = 0; j < 19; ++j) xr[j] = XS[(16 * s + j) * 64 + c];
          LB_LDSWAIT();
#pragma unroll
          for (int j = 0; j < 19; ++j) xs[j] = bf(xr[j]);
#pragma unroll
          for (int i = 0; i < 16; i += 2) { const f32x2 r = splat2(cbias) + splat2(w0) * (f32x2){xs[i], xs[i + 1]} + splat2(w1) * (f32x2){xs[i + 1], xs[i + 2]} + splat2(w2) * (f32x2){xs[i + 2], xs[i + 3]} + splat2(w3) * (f32x2){xs[i + 3], xs[i + 4]};
              xc[i] = r.x; xc[i + 1] = r.y; const unsigned w = pg8::cvt_pk_bf16(r.x, r.y); const int tok = 16 * s + i;
              *(LB_LAS unsigned short*)(XC + tok * 128 + ((((c >> 3) ^ ((tok >> 1) & 7))) << 4) + (c & 7) * 2) = (unsigned short)w;
              *(LB_LAS unsigned short*)(XC + (tok + 1) * 128 + ((((c >> 3) ^ ((tok >> 1) & 7))) << 4) + (c & 7) * 2) = (unsigned short)(w >> 16); } }
        LB_BAR();
        if (k + 1 < 16) LB_XLOAD(T0 + 128);
        { bf16x8 af[2], wf[2][4][2]; f32x4 acc[2][4];
#pragma unroll
          for (int ks = 0; ks < 2; ++ks) { const int row = 16 * s + n; af[ks] = *(const LB_LAS bf16x8*)(XC + row * 128 + (((4 * ks + g) ^ ((row >> 1) & 7)) << 4)); }
#pragma unroll
          for (int mat = 0; mat < 2; ++mat)
#pragma unroll
            for (int nt = 0; nt < 4; ++nt)
#pragma unroll
                for (int ks = 0; ks < 2; ++ks) { const int row = 16 * nt + n; wf[mat][nt][ks] = *(const LB_LAS bf16x8*)(WT + mat * 8192 + row * 128 + (((4 * ks + g) ^ ((row >> 1) & 7)) << 4)); }
#pragma unroll
          for (int mat = 0; mat < 2; ++mat)
#pragma unroll
            for (int nt = 0; nt < 4; ++nt) { acc[mat][nt] = __builtin_amdgcn_mfma_f32_16x16x32_bf16(af[0], wf[mat][nt][0], (f32x4){0.f, 0.f, 0.f, 0.f}, 0, 0, 0);
                acc[mat][nt] = __builtin_amdgcn_mfma_f32_16x16x32_bf16(af[1], wf[mat][nt][1], acc[mat][nt], 0, 0, 0); }
#pragma unroll
          for (int mat = 0; mat < 2; ++mat)
#pragma unroll
            for (int nt = 0; nt < 4; ++nt)
#pragma unroll
                for (int r = 0; r < 4; ++r) RI[mat * 128 * RSTR + (16 * s + 4 * g + r) * RSTR + 16 * nt + n] = acc[mat][nt][r]; }
        LB_BAR();
        float av[16], bv[16]; float A = 1.f, B = 0.f;
        { float pr[16], pi[16];
#pragma unroll
          for (int i = 0; i < 16; ++i) { const int tok = 16 * s + i; pr[i] = RI[tok * RSTR + c]; pi[i] = RI[128 * RSTR + tok * RSTR + c]; }
          LB_LDSWAIT();
          const f32x2 nl2 = splat2(-1.4426950408889634f), one2 = splat2(1.0f), nsp2 = splat2(-1.4426950408889634f * sp8);
#pragma unroll
          for (int i = 0; i < 16; i += 2) {
            const f32x2 gr = rcp_2(one2 + exp2_2(nl2 * ((f32x2){pr[i], pr[i + 1]} + splat2(ba)))), gi = rcp_2(one2 + exp2_2(nl2 * ((f32x2){pi[i], pi[i + 1]} + splat2(bx))));
            const f32x2 a = exp2_2(nsp2 * gr); f32x2 om = one2 - a * a; om = (f32x2){fmaxf(om.x, 0.f), fmaxf(om.y, 0.f)};
            const f32x2 b = sqrt_2(om) * (gi * (f32x2){xc[i], xc[i + 1]});
            av[i] = a.x; av[i + 1] = a.y; bv[i] = b.x; bv[i + 1] = b.y; A *= a.x; B = a.x * B + b.x; A *= a.y; B = a.y * B + b.y; } }
        EX[(s * 64 + c) * 2] = A; EX[(s * 64 + c) * 2 + 1] = B;
        LB_BAR();
        float hin = carry, hall = carry;
        { float ea[8], eb[8];
#pragma unroll
          for (int w = 0; w < 8; ++w) { ea[w] = EX[(w * 64 + c) * 2]; eb[w] = EX[(w * 64 + c) * 2 + 1]; }
          LB_LDSWAIT();
#pragma unroll
          for (int w = 0; w < 8; ++w) { hall = ea[w] * hall + eb[w]; if (w < s) hin = hall; } }
        carry = hall;
        float h = hin;
        float sq[16];
#pragma unroll
        for (int i = 0; i < 16; i += 2) { const float h0 = av[i] * h + bv[i]; h = av[i + 1] * h0 + bv[i + 1];
            const f32x2 y = (f32x2){h0, h} * gelu_as2((f32x2){bf(gt[i]), bf(gt[i + 1])}); const unsigned w = pg8::cvt_pk_bf16(y.x, y.y);
            MIXED[(tbase + T0 + 16 * s + i) * 1024 + cb + c] = (unsigned short)w; MIXED[(tbase + T0 + 16 * s + i + 1) * 1024 + cb + c] = (unsigned short)(w >> 16);
            const f32x2 yf = (f32x2){__uint_as_float(w << 16), __uint_as_float(w & 0xffff0000u)}; const f32x2 q2 = yf * yf; sq[i] = q2.x; sq[i + 1] = q2.y; }
        {
          const bool h3 = (c & 8) != 0, h2 = (c & 4) != 0; float r8[8], r4[4], r2[2], r1;
#pragma unroll
          for (int i = 0; i < 8; ++i) r8[i] = swap32_add(sq[i], sq[i + 8]);
#pragma unroll
          for (int i = 0; i < 4; ++i) r4[i] = swap16_add(r8[i], r8[i + 4]);
#pragma unroll
          for (int i = 0; i < 2; ++i) { const float sa = r4[i] + dpp_f<DPP_ROR8>(r4[i]), sb = r4[i + 2] + dpp_f<DPP_ROR8>(r4[i + 2]); r2[i] = h3 ? sb : sa; }
          { const float sa = r2[0] + dpp_f<DPP_HMIRROR>(r2[0]), sb = r2[1] + dpp_f<DPP_HMIRROR>(r2[1]); r1 = h2 ? sb : sa; }
          r1 += dpp_f<DPP_XOR2>(r1); r1 += dpp_f<DPP_XOR1>(r1);
          if ((c & 3) == 0) SSL[(tbase + T0 + 16 * s + (c >> 2)) * 8 + blk] = r1; }
        if (k + 1 < 16) LB_XSTORE();
    }
    __syncthreads();
#undef LB_XLOAD
#undef LB_XSTORE
}
#undef LB_BAR
#undef LB_LDSWAIT
#undef LB_LAS
}

struct QuadSync { gu32* cnt; unsigned* bar; unsigned gen; unsigned n; bool local; };
__device__ __forceinline__ void quad_sync(QuadSync& q) {
    asm volatile("s_waitcnt vmcnt(0)" ::: "memory");
    __syncthreads();
    ++q.gen;
    if (threadIdx.x == 0) {
        if (!q.local) { __builtin_amdgcn_fence(__ATOMIC_RELEASE, "agent"); asm volatile("s_waitcnt vmcnt(0)" ::: "memory"); }
        __hip_atomic_fetch_add(q.cnt, 1u, RLX_AGENT);
        const unsigned want = q.n * q.gen;
        XB_SPIN(xb_ld((unsigned*)q.cnt) < want, q.bar);
        __builtin_amdgcn_fence(__ATOMIC_ACQUIRE, "agent");
        asm volatile("s_waitcnt vmcnt(0)" ::: "memory");
    }
    __syncthreads();
}
struct QuadOrder { pg8::StaticOrder S;
    __device__ __forceinline__ bool next(int i, pg8::Unit& u) const { pg8::Unit v; if (!S.next(i >> 1, v)) return false; u.pm = v.pm; u.pn = 2 * v.pn + (i & 1); return true; }
    __device__ __forceinline__ void a_ready(const pg8::Unit&) const {}
    __device__ __forceinline__ void done(const pg8::Unit&) const {}
};
constexpr int NPHASE = 12;
#ifndef MK_ONE_LAUNCH
#define MK_ONE_LAUNCH 1
#endif
struct Args { const float* in[26]; float* out; unsigned char* ws; int ph_lo, ph_hi; };
__global__ void __launch_bounds__(NWAVES * 64, 2) mk_fwd(Args args) {
    extern __shared__ __attribute__((aligned(16))) unsigned char lds[];
    Frame F;
    F.lds = (LAS unsigned char*)lds;
    F.MISC = (volatile LAS unsigned*)(F.lds + MISC_OFF);
    F.tid = threadIdx.x; F.lane = F.tid & 63; F.wave = __builtin_amdgcn_readfirstlane(F.tid >> 6);
    F.G = gridDim.x; { const int bx = blockIdx.x; F.vcu = (F.G % 8 == 0) ? (bx % 8) * (F.G / 8) + bx / 8 : bx; }
    F.ws = args.ws; F.out = args.out; F.ctl = (gu32*)(args.ws + WS_CTL);
#pragma unroll
    for (int i = 0; i < 26; ++i) F.in[i] = args.in[i];
    for (int u = F.tid; u < (LDS_BYTES - LDSCTL_OFF) / 4; u += NWAVES * 64) ((LAS unsigned*)(F.lds + LDSCTL_OFF))[u] = 0u;
    __syncthreads();
    const int lo = args.ph_lo, hi = args.ph_hi;
    if (threadIdx.x == 0) __hip_atomic_store(F.ctl + CW_XID + blockIdx.x, xb_xcc_id() + 1u, RLX_AGENT);
    XcdBarrier bar; bar.bar = (unsigned*)(F.ctl + CW_BAR); bar.x = 0; bar.st = nullptr;
    if (hi - lo > 1) bar = xcd_barrier_post((unsigned*)(F.ctl + CW_BAR), F.MISC + 8);
#define IN(k) (lo <= (k) && (k) < hi)
#define SEAM(k) do { if (IN(k) && IN((k) + 1)) xcd_barrier(bar); } while (0)
#define QSEAM(k) do { if (IN(k) && IN((k) + 1)) { if (quad) quad_sync(qs); else xcd_barrier(bar); } } while (0)
    const bool quad = (F.G == 256) && (hi - lo > 1); QuadSync qs; qs.cnt = F.ctl + CW_QUAD + 64 * (blockIdx.x & 63); qs.bar = (unsigned*)(F.ctl + CW_BAR); qs.gen = 0u; qs.n = 4u; qs.local = false;
    QuadSync gs; gs.cnt = F.ctl + CW_G32 + 64 * (blockIdx.x & 7); gs.bar = qs.bar; gs.gen = 0u; gs.n = 32u; gs.local = false;
#define GSEAM(k) do { if (IN(k) && IN((k) + 1)) { if (quad) quad_sync(gs); else xcd_barrier(bar); } } while (0)
    bf16* Win_t = (bf16*)(F.ws + WS_WIN); bf16* Wout_t = (bf16*)(F.ws + WS_WOUT); bf16* Wcq_t = (bf16*)(F.ws + WS_WCQ); bf16* Wckv_t = (bf16*)(F.ws + WS_WCKV);
    bf16* Wco_t = (bf16*)(F.ws + WS_WCO); bf16* Wpq_t = (bf16*)(F.ws + WS_WPQ);
    bf16* H = (bf16*)(F.ws + WS_A); bf16* X1 = (bf16*)(F.ws + WS_A); bf16* PROJ = (bf16*)(F.ws + WS_B); bf16* QC = (bf16*)(F.ws + WS_B); bf16* OC = (bf16*)(F.ws + WS_B + 64 * MiB);
    bf16* MIXED = (bf16*)(F.ws + WS_C); bf16* X2 = (bf16*)(F.ws + WS_C); bf16* MEMN = (bf16*)(F.ws + WS_MEMN); bf16* KCVC = (bf16*)(F.ws + WS_KCVC); bf16* PQ = (bf16*)(F.ws + WS_E);
    float* SS1 = (float*)(F.ws + WS_SS1); float* SS2 = (float*)(F.ws + WS_SS2);

    if (quad && lo < 1) { unsigned same = 1u; const unsigned x0 = xb_ld((unsigned*)(F.ctl + CW_XID + (blockIdx.x & 7)));
        for (int j = 1; j < 32; ++j) same &= (xb_ld((unsigned*)(F.ctl + CW_XID + (blockIdx.x & 7) + 8 * j)) == x0) ? 1u : 0u;
        gs.local = (same != 0u) && (x0 != 0u); }
    if (IN(0)) { p0_prologue(F, quad && IN(1));
        if (quad && IN(1)) { quad_sync(gs);
            if (threadIdx.x == 0) { XB_SPIN(xb_ld((unsigned*)(F.ctl + CW_WCNT)) < (unsigned)F.G, qs.bar); __builtin_amdgcn_fence(__ATOMIC_ACQUIRE, "agent"); asm volatile("s_waitcnt vmcnt(0)" ::: "memory"); }
            __syncthreads(); }
        else SEAM(0); }
#define STAG_SPLIT(k, n) int a0, a1; table_share(F, k, n, a0, a1); const int am = a0 + ((((int)blockIdx.x >> 3) & 3) * (a1 - a0) + 1) / 3
#define STAG_BEFORE(WHICH, k, n) do { STAG_SPLIT(k, n); if (am > a0) convert_rows<WHICH>(F, a0, am < a1 ? am : a1); } while (0)
#define STAG_AFTER(WHICH, k, n) do { STAG_SPLIT(k, n); if (am < a1) convert_rows<WHICH>(F, am, a1); } while (0)
    if (IN(1)) {
        STAG_BEFORE(0, 0, 1);
        { pg8::Gemm g{H, Win_t, T, DIN, D}; pg8::StaticOrder S; S.init(T, DIN, F.G, (int)blockIdx.x); pg8::EpiStore E{PROJ, DIN, 4, 6, attn_body::C2, (float*)(F.ws + WS_KMEAN)};
          pg8::gemm_phase<pg8::EpiStore, pg8::StaticOrder, true, true>(F.lds + RING_OFF, g, S, E); }
        STAG_AFTER(0, 0, 1);
        GSEAM(1);
    }
    if (IN(2)) {
        const attn_body::AttnTensors AT{(const attn_body::bf16*)(PROJ + COL_Q), (const attn_body::bf16*)(PROJ + COL_K), (const attn_body::bf16*)(PROJ + COL_V), (attn_body::bf16*)(MIXED + DLRU), (const float*)(F.ws + WS_KMEAN), (float*)(F.ws + WS_SSA)};
        for (int it = F.vcu; it < 2 * BATCH * AH; it += F.G) {
            if (it & 1) lru_body::lru_item(F.lds + RING_OFF, (it >> 1) / LBLK, (it >> 1) % LBLK, PROJ, MIXED, (float*)(F.ws + WS_SSL), F.in[4], F.in[5], F.in[6], F.in[7], F.in[8], F.in[9], F.in[10]);
            else { int gi = it >> 1;
                if (quad) { const int x = it >> 5, e = (it & 31) >> 1; gi = (e < 8) ? 4 * (2 * x + (e >> 2)) + (e & 3) : 64 + 16 * ((e - 8) & 3) + 2 * x + ((e - 8) >> 2); }
                if (gi < 64) { pg8::Gemm g{MEMN, Wckv_t, TM, D, D}; pg8::OneUnit S{gi >> 2, gi & 3, true}; pg8::EpiStore E{KCVC, D, 0, 0, 1.0f, nullptr};
                    pg8::gemm_phase<pg8::EpiStore, pg8::OneUnit, true, true>(F.lds + RING_OFF, g, S, E); }
                else { pg8::Gemm g{Wckv_t + (size_t)D * D, MEMN, D, TM, D}; pg8::OneUnit S{(gi - 64) >> 4, (gi - 64) & 15, true}; pg8::EpiStore E{KCVC + (size_t)TM * D, TM, 0, 0, 1.0f, nullptr};
                    pg8::gemm_phase<pg8::EpiStore, pg8::OneUnit, true, true>(F.lds + RING_OFF, g, S, E); } }
            attn_body::attn_item((char*)lds + RING_OFF, AT, it); }
        GSEAM(2); }
    if (quad && IN(3) && lo < 3) { unsigned same = 1u; const unsigned x0 = xb_ld((unsigned*)(F.ctl + CW_XID + (blockIdx.x & 63)));
#pragma unroll
        for (int j = 1; j < 4; ++j) same &= (xb_ld((unsigned*)(F.ctl + CW_XID + (blockIdx.x & 63) + 64 * j)) == x0) ? 1u : 0u;
        qs.local = (same != 0u) && (x0 != 0u); }
    if (IN(3)) { pg8::Gemm g{MIXED, Wout_t, T, D, D}; pg8::StaticOrder S; S.init(T, D, F.G, (int)blockIdx.x); pg8::EpiResidGN E{F.in[0], X1, SS1, (const float*)(F.ws + WS_SSL), (const float*)(F.ws + WS_SSA), D, EPS};
        pg8::gemm_phase<pg8::EpiResidGN, pg8::StaticOrder, true, true>(F.lds + RING_OFF, g, S, E); QSEAM(3); }
    if (IN(4)) {
        pg8::Gemm g{X1, Wcq_t, T, D, D}; pg8::StaticOrder S; S.init(T, D, F.G, (int)blockIdx.x); pg8::EpiScale E{SS1, QC, D, EPS};
        pg8::gemm_phase<pg8::EpiScale, pg8::StaticOrder, true, true>(F.lds + RING_OFF, g, S, E);
        __builtin_amdgcn_fence(__ATOMIC_ACQUIRE, "agent");
        { cross_body::bf16x8 qf[8]; int zz = 0; asm volatile("" : "+s"(zz)); bool first = true;
          for (int i = 0; ; ++i) { pg8::Unit u, un; if (!S.next(i, u)) break; const bool more = S.next(i + 1, un);
              const int b = u.pm >> 3, t0 = u.pm * 256;
              cross_body::cross_unit(F.lds + RING_OFF, QC, KCVC, KCVC + (size_t)TM * D, OC, b, u.pn, t0, qf, first, true, b, u.pn, t0 + 128, zz);
              cross_body::cross_unit(F.lds + RING_OFF, QC, KCVC, KCVC + (size_t)TM * D, OC, b, u.pn, t0 + 128, qf, false, more, un.pm >> 3, un.pn, un.pm * 256, zz);
              first = false; }
          asm volatile("s_waitcnt vmcnt(0) lgkmcnt(0)\n\ts_barrier" ::: "memory"); }
        QSEAM(4); }
    if (IN(5)) { pg8::Gemm g{OC, Wco_t, T, D, D}; pg8::StaticOrder S; S.init(T, D, F.G, (int)blockIdx.x); pg8::EpiResid E{nullptr, X1, X2, SS2, D};
        pg8::gemm_phase<pg8::EpiResid, pg8::StaticOrder, true, true>(F.lds + RING_OFF, g, S, E); QSEAM(5); }
    if (IN(6)) { pg8::Gemm g{X2, Wpq_t, T, 2048, D}; pg8::EpiScale E{SS2, PQ, 2048, EPS};
        if (quad) { QuadOrder S; S.S.init(T, D, F.G, (int)blockIdx.x); pg8::gemm_phase<pg8::EpiScale, QuadOrder, true, true>(F.lds + RING_OFF, g, S, E); }
        else { pg8::StaticOrder S; S.init(T, 2048, F.G, (int)blockIdx.x); pg8::gemm_phase<pg8::EpiScale, pg8::StaticOrder, true, true>(F.lds + RING_OFF, g, S, E); }
        SEAM(6); }
    if (IN(7)) { PeerStream st; st.k = 0; st.lane = F.lane; st.U = F.in[23]; st.V = F.in[24]; st.gf = F.in[20]; st.UQ = (signed char*)(F.ws + WS_UQ); st.SU = (float*)(F.ws + WS_SU); st.VQ = F.ws + WS_VQ;
        st.X2 = X2; st.SS2 = SS2; st.XQ = (signed char*)(F.ws + WS_XQ); st.HS = (float*)(F.ws + WS_HS); st.buf = F.lds + STREAM_OFF + F.wave * STREAM_WAVE_BYTES; st.sbuf = F.lds + STREAM_OFF + NWAVES * STREAM_WAVE_BYTES + F.wave * 256;
        if (quad) {
            pg8::StaticOrder S; S.init(T, D, F.G, (int)blockIdx.x); pg8::Unit u0, u1; S.next(0, u0); S.next(1, u1);
            st.local = true; st.count = 12; st.xb0 = 64 * u0.pm + 16 * u0.pn + 2 * F.wave; st.xb1 = 64 * u1.pm + 16 * u1.pn + 2 * F.wave; st.vbase = 64 * (int)blockIdx.x + F.wave; st.gbase = 0; st.gstep = 0;
            const route_body::PanelTiles tts{u0.pm, u1.pm};
            route_body::route_phase(F.lds + RING_OFF, PQ, (const bf16*)(F.ws + WS_SUBK), (unsigned short*)(F.ws + WS_IDS), (float*)(F.ws + WS_GATES), 2 * u0.pn, tts, st, false);
            route_body::route_phase(F.lds + RING_OFF, PQ, (const bf16*)(F.ws + WS_SUBK), (unsigned short*)(F.ws + WS_IDS), (float*)(F.ws + WS_GATES), 2 * u0.pn + 1, tts, st, true);
        } else { const int h = F.vcu & 7, rank = F.vcu >> 3, nrank = (F.G - h + 7) >> 3;
            st.local = false; st.gbase = F.vcu * 8 + F.wave; st.gstep = F.G * 8; st.count = (16384 + 8192 - st.gbase + st.gstep - 1) / st.gstep; st.xb0 = st.xb1 = st.vbase = 0;
            const route_body::StrideTiles tts{rank, nrank, (T / 128 - rank + nrank - 1) / nrank};
            route_body::route_phase(F.lds + RING_OFF, PQ, (const bf16*)(F.ws + WS_SUBK), (unsigned short*)(F.ws + WS_IDS), (float*)(F.ws + WS_GATES), h, tts, st, true); }
        SEAM(7); }
    if (IN(8)) { peer_u(F, hi - lo > 1); SEAM(8); }
    if (IN(9)) { peer_combine(F); SEAM(9); }
    if (IN(10)) { peer_v(F, hi - lo > 1); SEAM(10); }
    if (IN(11)) { final_norm(F); }
#undef IN
#undef SEAM
#undef QSEAM
#undef GSEAM
}

extern "C" void kernel_launch(void* const* d_in, const int* in_sizes, int n_in, void* d_out, int out_size, void* d_ws, size_t ws_size, hipStream_t stream) {
    static int grid = 0;
    if (grid == 0) {
        if (n_in != 26 || in_sizes[0] != T * D || out_size != T * D || ws_size < WS_END) { fprintf(stderr, "kernel_launch: unexpected shapes (n_in %d, in0 %d, out %d, ws %zu); nothing launched\n", n_in, n_in > 0 ? in_sizes[0] : -1, out_size, ws_size); grid = -1; return; }
        int dev = 0, cus = 0, per_cu = 0;
        if (hipGetDevice(&dev) != hipSuccess || hipDeviceGetAttribute(&cus, hipDeviceAttributeMultiprocessorCount, dev) != hipSuccess) { grid = -1; return; }
        if (hipFuncSetAttribute((const void*)mk_fwd, hipFuncAttributeMaxDynamicSharedMemorySize, LDS_BYTES) != hipSuccess) { fprintf(stderr, "kernel_launch: hipFuncSetAttribute failed\n"); grid = -1; return; }
        if (hipOccupancyMaxActiveBlocksPerMultiprocessor(&per_cu, (const void*)mk_fwd, NWAVES * 64, LDS_BYTES) != hipSuccess || per_cu < 1) fprintf(stderr, "kernel_launch: occupancy query reports %d\n", per_cu);
        (void)hipGetLastError();
        grid = cus;
    }
    if (grid < 0) return;
    (void)hipMemsetAsync((char*)d_ws + WS_CTL, 0, CTL_ZERO_BYTES, stream);
    Args a{};
    for (int i = 0; i < 26; ++i) a.in[i] = (const float*)d_in[i];
    a.out = (float*)d_out; a.ws = (unsigned char*)d_ws;
#if MK_ONE_LAUNCH
    a.ph_lo = 0; a.ph_hi = NPHASE;
    hipLaunchKernelGGL(mk_fwd, dim3(grid), dim3(NWAVES * 64), LDS_BYTES, stream, a);
#else
    for (int p = 0; p < NPHASE; ++p) { a.ph_lo = p; a.ph_hi = p + 1; hipLaunchKernelGGL(mk_fwd, dim3(grid), dim3(NWAVES * 64), LDS_BYTES, stream, a); }
#endif
}
```

```cpp
#include <hip/hip_runtime.h>
#include <cstdio>
#include <cstdint>
namespace pg8 {
#define PG8_LAS __attribute__((address_space(3)))
typedef unsigned short bf16_t;
typedef short bf16x8 __attribute__((ext_vector_type(8)));
typedef float f32x4 __attribute__((ext_vector_type(4)));
typedef unsigned u32x4 __attribute__((ext_vector_type(4)));
constexpr int BM = 256, BK = 64, HALF = 128, HTB = HALF * BK * 2  , STAGE_BYTES = 8 * HTB, NXCD = 8, WGM = 8;

__host__ __device__ __forceinline__ int lds_byte(int r, int c) { const int st = (r >> 4) * 2 + (c >> 5), rr = r & 15, cc = c & 31, ob = rr * 64 + cc * 2; return st * 1024 + (ob ^ (((ob >> 9) & 1) << 5)); }
__host__ __device__ __forceinline__ void stage_rc(int b, int& R, int& C) { const int st = b / 1024, sb = b % 1024, swz = sb ^ (((sb >> 9) & 1) << 5); R = (st >> 1) * 16 + swz / 64; C = (st & 1) * 32 + (swz % 64) / 2; }
__host__ __device__ __forceinline__ int perm32(int rho) { const int n = rho >> 4, i = rho & 15; return 8 * (i >> 2) + 4 * n + (i & 3); }

struct Unit { int pm, pn; };
struct Gemm { const bf16_t* A; const bf16_t* Bt; int M, N, K; };

struct StaticOrder {
    int nM, nN, nwg, G, c;
    __host__ __device__ __forceinline__ void init(int M, int N, int G_, int c_) { nM = M / BM; nN = N / BM; nwg = nM * nN; G = G_; c = c_; }
    __host__ __device__ __forceinline__ bool next(int i, Unit& u) const {
        const long L = (long)i * G + c; if (L >= nwg) return false;
        int wgid = (int)L; { const int q = nwg / NXCD, r = nwg % NXCD, xcd = wgid % NXCD, off = wgid / NXCD; wgid = (xcd < r ? xcd * (q + 1) : r * (q + 1) + (xcd - r) * q) + off; }
        const int nig = WGM * nN, gid = wgid / nig, fm = gid * WGM, gsz = (nM - fm) < WGM ? (nM - fm) : WGM;
        u.pm = fm + ((wgid % nig) % gsz); u.pn = (wgid % nig) / gsz; return true;
    }
    __device__ __forceinline__ void a_ready(const Unit&) const {}
    __device__ __forceinline__ void done(const Unit&) const {}
};
struct OneUnit { int pm, pn; bool have;
    __device__ __forceinline__ bool next(int i, Unit& u) const { if (i != 0 || !have) return false; u.pm = pm; u.pn = pn; return true; }
    __device__ __forceinline__ void a_ready(const Unit&) const {}
    __device__ __forceinline__ void done(const Unit&) const {}
};
__device__ __forceinline__ unsigned cvt_pk_bf16(float lo, float hi) { unsigned r; asm volatile("v_cvt_pk_bf16_f32 %0, %1, %2" : "=v"(r) : "v"(lo), "v"(hi)); return r; }
typedef float f32x2 __attribute__((ext_vector_type(2)));
template <int CTRL> __device__ __forceinline__ float dppf(float x) { return __int_as_float(__builtin_amdgcn_update_dpp(0, __float_as_int(x), CTRL, 0xf, 0xf, true)); }
struct EpiStore {
    static constexpr bool PERM = true, AFTER_DRAIN = false, MIDK = false;
    bf16_t* O; int ldc; int slo, shi; float scale; float* KMP;
    __device__ __forceinline__ void operator()(const f32x4 (&acc)[2][2][4][2], const Unit& u, int wr, int wc, int fr, int fq) const {
        const int row0 = u.pm * BM + wr * 64 + fr, col0 = u.pn * BM + wc * 32 + 8 * fq; const float sc = (u.pn >= slo && u.pn < shi) ? scale : 1.0f;
#pragma unroll
        for (int ai = 0; ai < 2; ++ai)
#pragma unroll
            for (int m = 0; m < 4; ++m) { bf16_t* rowp = O + (size_t)(row0 + ai * HALF + m * 16) * ldc + col0;
#pragma unroll
                for (int bj = 0; bj < 2; ++bj) { const f32x4 v0 = acc[ai][bj][m][0] * sc, v1 = acc[ai][bj][m][1] * sc;
                    u32x4 w; w.x = cvt_pk_bf16(v0[0], v0[1]); w.y = cvt_pk_bf16(v0[2], v0[3]); w.z = cvt_pk_bf16(v1[0], v1[1]); w.w = cvt_pk_bf16(v1[2], v1[3]);
                    *(u32x4*)(rowp + bj * HALF) = w; } }
        if (KMP != nullptr && (u.pn == 6 || u.pn == 7)) {
            float cs[16];
#pragma unroll
            for (int bj = 0; bj < 2; ++bj)
#pragma unroll
                for (int n = 0; n < 2; ++n)
#pragma unroll
                    for (int e = 0; e < 4; ++e) { float a = 0.f;
#pragma unroll
                        for (int ai = 0; ai < 2; ++ai)
#pragma unroll
                            for (int m = 0; m < 4; ++m) a += acc[ai][bj][m][n][e];
                        cs[bj * 8 + n * 4 + e] = a; }
            const bool b3 = (fr & 8) != 0, b2 = (fr & 4) != 0, b1 = (fr & 2) != 0, b0 = (fr & 1) != 0; float r8[8], r4[4], r2[2], r1;
#pragma unroll
            for (int i = 0; i < 8; ++i) { const float sa = cs[i] + dppf<0x128>(cs[i]), sb = cs[i + 8] + dppf<0x128>(cs[i + 8]); r8[i] = b3 ? sb : sa; }
#pragma unroll
            for (int i = 0; i < 4; ++i) { const float sa = r8[i] + dppf<0x141>(r8[i]), sb = r8[i + 4] + dppf<0x141>(r8[i + 4]); r4[i] = b2 ? sb : sa; }
#pragma unroll
            for (int i = 0; i < 2; ++i) { const float sa = r4[i] + dppf<0x4E>(r4[i]), sb = r4[i + 2] + dppf<0x4E>(r4[i + 2]); r2[i] = b1 ? sb : sa; }
            { const float sa = r2[0] + dppf<0xB1>(r2[0]), sb = r2[1] + dppf<0xB1>(r2[1]); r1 = b0 ? sb : sa; }
            const int cg = (u.pn - 6) * 256 + 128 * (fr >> 3) + 32 * wc + 8 * fq + (fr & 7);
            KMP[((((size_t)wr * 16 + (u.pm >> 3)) * 8 + (cg >> 6)) * 8 + (u.pm & 7)) * 64 + (cg & 63)] = r1;
        }
    }
};
__device__ __forceinline__ float bfl(unsigned w) { return __uint_as_float(w << 16); }
__device__ __forceinline__ float bfh(unsigned w) { return __uint_as_float(w & 0xffff0000u); }
struct EpiResid {
    static constexpr bool PERM = true, AFTER_DRAIN = false, MIDK = false;
    const float* resf; const bf16_t* resb; bf16_t* O; float* SS; int ldc;
    __device__ __forceinline__ void operator()(const f32x4 (&acc)[2][2][4][2], const Unit& u, int wr, int wc, int fr, int fq) const {
        const int row0 = u.pm * BM + wr * 64 + fr, col0 = u.pn * BM + wc * 32 + 8 * fq;
#pragma unroll
        for (int ai = 0; ai < 2; ++ai)
#pragma unroll
            for (int m = 0; m < 4; ++m) { const int row = row0 + ai * HALF + m * 16; const size_t off = (size_t)row * ldc + col0; float ss = 0.f;
#pragma unroll
                for (int bj = 0; bj < 2; ++bj) { f32x4 v0 = acc[ai][bj][m][0], v1 = acc[ai][bj][m][1];
                    if (resf) { const f32x4 r0 = *(const f32x4*)(resf + off + bj * HALF), r1 = *(const f32x4*)(resf + off + bj * HALF + 4); v0 = v0 + r0; v1 = v1 + r1; }
                    else { const u32x4 r = *(const u32x4*)(resb + off + bj * HALF);
                        v0[0] += bfl(r.x); v0[1] += bfh(r.x); v0[2] += bfl(r.y); v0[3] += bfh(r.y); v1[0] += bfl(r.z); v1[1] += bfh(r.z); v1[2] += bfl(r.w); v1[3] += bfh(r.w); }
                    ss += (v0[0] * v0[0] + v0[1] * v0[1]) + (v0[2] * v0[2] + v0[3] * v0[3]) + (v1[0] * v1[0] + v1[1] * v1[1]) + (v1[2] * v1[2] + v1[3] * v1[3]);
                    u32x4 w; w.x = cvt_pk_bf16(v0[0], v0[1]); w.y = cvt_pk_bf16(v0[2], v0[3]); w.z = cvt_pk_bf16(v1[0], v1[1]); w.w = cvt_pk_bf16(v1[2], v1[3]);
                    *(u32x4*)(O + off + bj * HALF) = w; }
                ss += __shfl_xor(ss, 16); ss += __shfl_xor(ss, 32);
                if (fq == 0) SS[(size_t)row * 16 + u.pn * 4 + wc] = ss; }
    }
};
struct EpiScale {
    static constexpr bool PERM = true, AFTER_DRAIN = false, MIDK = false;
    const float* SS; bf16_t* O; int ldc; float eps;
    __device__ __forceinline__ void operator()(const f32x4 (&acc)[2][2][4][2], const Unit& u, int wr, int wc, int fr, int fq) const {
        const int row0 = u.pm * BM + wr * 64 + fr, col0 = u.pn * BM + wc * 32 + 8 * fq;
#pragma unroll
        for (int ai = 0; ai < 2; ++ai)
#pragma unroll
            for (int m = 0; m < 4; ++m) { const int row = row0 + ai * HALF + m * 16; bf16_t* rowp = O + (size_t)row * ldc + col0;
                const f32x4* sp = (const f32x4*)(SS + (size_t)row * 16); const f32x4 s0 = sp[0], s1 = sp[1], s2 = sp[2], s3 = sp[3];
                const float tot = ((s0[0] + s0[1]) + (s0[2] + s0[3])) + ((s1[0] + s1[1]) + (s1[2] + s1[3])) + ((s2[0] + s2[1]) + (s2[2] + s2[3])) + ((s3[0] + s3[1]) + (s3[2] + s3[3]));
                const float rs = 1.0f / sqrtf(tot * (1.0f / 1024.0f) + eps);
#pragma unroll
                for (int bj = 0; bj < 2; ++bj) { const f32x4 v0 = acc[ai][bj][m][0] * rs, v1 = acc[ai][bj][m][1] * rs;
                    u32x4 w; w.x = cvt_pk_bf16(v0[0], v0[1]); w.y = cvt_pk_bf16(v0[2], v0[3]); w.z = cvt_pk_bf16(v1[0], v1[1]); w.w = cvt_pk_bf16(v1[2], v1[3]);
                    *(u32x4*)(rowp + bj * HALF) = w; } }
    }
};

struct EpiResidGN {
    static constexpr bool PERM = true, AFTER_DRAIN = false, MIDK = true;
    const float* resf; bf16_t* O; float* SS; const float* SSL; const float* SSA; int ldc; float eps;
    __device__ __forceinline__ float rsum8(const float* p) const { const f32x4 a = *(const f32x4*)p, b = *(const f32x4*)(p + 4); return ((a[0] + a[1]) + (a[2] + a[3])) + ((b[0] + b[1]) + (b[2] + b[3])); }
    __device__ __forceinline__ void mid(f32x4 (&acc)[2][2][4][2], const Unit& u, int wr, int wc, int fr, int fq) const {
        int row0 = u.pm * BM + wr * 64 + fr; asm volatile("" : "+v"(row0));
#pragma unroll
        for (int ai = 0; ai < 2; ++ai)
#pragma unroll
            for (int m = 0; m < 4; ++m) { const int row = row0 + ai * HALF + m * 16;
                const float rl = 1.0f / sqrtf(rsum8(SSL + (size_t)row * 8) * (1.0f / 512.0f) + eps), rh = 1.0f / sqrtf(rsum8(SSA + (size_t)row * 8) * (1.0f / 512.0f) + eps); const float ratio = rl / rh;
#pragma unroll
                for (int bj = 0; bj < 2; ++bj) { acc[ai][bj][m][0] = acc[ai][bj][m][0] * ratio; acc[ai][bj][m][1] = acc[ai][bj][m][1] * ratio; }
                asm volatile("" ::: "memory"); }
    }
    __device__ __forceinline__ void operator()(const f32x4 (&acc)[2][2][4][2], const Unit& u, int wr, int wc, int fr, int fq) const {
        int row0 = u.pm * BM + wr * 64 + fr; asm volatile("" : "+v"(row0)); const int col0 = u.pn * BM + wc * 32 + 8 * fq;
#pragma unroll
        for (int ai = 0; ai < 2; ++ai)
#pragma unroll
            for (int m = 0; m < 4; ++m) { const int row = row0 + ai * HALF + m * 16; const size_t off = (size_t)row * ldc + col0; float ss = 0.f;
                const float rh = 1.0f / sqrtf(rsum8(SSA + (size_t)row * 8) * (1.0f / 512.0f) + eps);
#pragma unroll
                for (int bj = 0; bj < 2; ++bj) { const f32x4 r0 = *(const f32x4*)(resf + off + bj * HALF), r1 = *(const f32x4*)(resf + off + bj * HALF + 4);
                    const f32x4 v0 = acc[ai][bj][m][0] * rh + r0, v1 = acc[ai][bj][m][1] * rh + r1;
                    ss += (v0[0] * v0[0] + v0[1] * v0[1]) + (v0[2] * v0[2] + v0[3] * v0[3]) + (v1[0] * v1[0] + v1[1] * v1[1]) + (v1[2] * v1[2] + v1[3] * v1[3]);
                    u32x4 w; w.x = cvt_pk_bf16(v0[0], v0[1]); w.y = cvt_pk_bf16(v0[2], v0[3]); w.z = cvt_pk_bf16(v1[0], v1[1]); w.w = cvt_pk_bf16(v1[2], v1[3]);
                    *(u32x4*)(O + off + bj * HALF) = w; }
                ss += __shfl_xor(ss, 16); ss += __shfl_xor(ss, 32);
                if (fq == 0) SS[(size_t)row * 16 + u.pn * 4 + wc] = ss; }
    }
};

template <class Epi, class Sched, bool ALIGN_EPI = false, bool SP2 = false>
__device__ __forceinline__ void gemm_phase(PG8_LAS unsigned char* lds, const Gemm g, const Sched& S, const Epi& E) {
    const int tid = threadIdx.x, wid = __builtin_amdgcn_readfirstlane(tid >> 6), lane = tid & 63, wr = wid >> 2, wc = wid & 3, fr = lane & 15, fq = lane >> 4;
    const int K = g.K, nt = K / BK;
    unsigned voffA[2], voffB[2];
#pragma unroll
    for (int i = 0; i < 2; ++i) { int R, C; stage_rc(tid * 16 + i * 8192, R, C); const int Rb = Epi::PERM ? ((R & ~31) + perm32(R & 31)) : R;
        voffA[i] = (unsigned)(R * K + C) * 2u; voffB[i] = (unsigned)(Rb * K + C) * 2u; }
    const size_t kstep = (size_t)(BK * 2);
    const size_t hstep = (size_t)HALF * K * 2;
    const size_t tstep = 2 * hstep;
    const unsigned ldsw = (unsigned)wid * 1024u;
    const int aoff = lds_byte(wr * 64 + fr, fq * 8), boff = lds_byte(wc * 32 + fr, fq * 8);
#define PG8_SA(b, h) (((b) * 2 + (h)) * HTB)
#define PG8_SB(b, h) ((4 + (b) * 2 + (h)) * HTB)
#define PG8_STAGE(bufoff, gbase, voff) do { _Pragma("unroll") for (int _i = 0; _i < 2; ++_i) \
        __builtin_amdgcn_global_load_lds((const unsigned*)((const char*)(gbase) + (voff)[_i]), (PG8_LAS unsigned*)(lds + (bufoff) + ldsw + _i * 8192), 16, 0, 0); } while (0)
#define PG8_LDA(dst, b, h) do { _Pragma("unroll") for (int m = 0; m < 4; ++m) _Pragma("unroll") for (int k = 0; k < 2; ++k) dst[m][k] = *(const PG8_LAS bf16x8*)(lds + PG8_SA(b, h) + aoff + m * 2048 + k * 1024); } while (0)
#define PG8_LDB(dst, b, h) do { _Pragma("unroll") for (int n = 0; n < 2; ++n) _Pragma("unroll") for (int k = 0; k < 2; ++k) dst[n][k] = *(const PG8_LAS bf16x8*)(lds + PG8_SB(b, h) + boff + n * 2048 + k * 1024); } while (0)
#define PG8_MMA(ai, bj, At, Bt) do { __builtin_amdgcn_s_setprio(1); _Pragma("unroll") for (int m = 0; m < 4; ++m) _Pragma("unroll") for (int n = 0; n < 2; ++n) _Pragma("unroll") for (int k = 0; k < 2; ++k) \
        acc[ai][bj][m][n] = __builtin_amdgcn_mfma_f32_16x16x32_bf16(Bt[n][k], At[m][k], acc[ai][bj][m][n], 0, 0, 0); __builtin_amdgcn_s_setprio(0); } while (0)
#define PG8_WAIT_V(n) asm volatile("s_waitcnt vmcnt(" #n ")" ::: "memory")
#define PG8_WAIT_L(n) asm volatile("s_waitcnt lgkmcnt(" #n ")" ::: "memory")
#define PG8_BAR __builtin_amdgcn_s_barrier()
#define PG8_SCHED __builtin_amdgcn_sched_barrier(0)
    Unit cur, nxt; int ui = 0;
    if (!S.next(0, cur)) return;
    f32x4 acc[2][2][4][2];
#pragma unroll
    for (int a = 0; a < 2; ++a)
#pragma unroll
        for (int b = 0; b < 2; ++b)
#pragma unroll
            for (int m = 0; m < 4; ++m)
#pragma unroll
                for (int n = 0; n < 2; ++n) acc[a][b][m][n] = (f32x4){0.f, 0.f, 0.f, 0.f};
    bf16x8 At[4][2], B0[2][2], B1[2][2];
    const char* cA = (const char*)g.A + (size_t)cur.pm * tstep; const char* cB = (const char*)g.Bt + (size_t)cur.pn * tstep;
    S.a_ready(cur);
    if constexpr (SP2) {
        PG8_STAGE(PG8_SB(0, 0), cB, voffB); PG8_STAGE(PG8_SB(0, 1), cB + hstep, voffB); PG8_STAGE(PG8_SA(0, 0), cA, voffA); PG8_STAGE(PG8_SA(0, 1), cA + hstep, voffA);
        if (wr == 1) PG8_BAR;
        PG8_WAIT_V(2); PG8_BAR;
        PG8_STAGE(PG8_SB(1, 0), cB + kstep, voffB); PG8_STAGE(PG8_SA(1, 0), cA + kstep, voffA); PG8_STAGE(PG8_SB(1, 1), cB + hstep + kstep, voffB);
        PG8_WAIT_V(6); PG8_BAR;
    } else {
        PG8_STAGE(PG8_SB(0, 0), cB, voffB); PG8_STAGE(PG8_SA(0, 0), cA, voffA); PG8_STAGE(PG8_SB(0, 1), cB + hstep, voffB); PG8_STAGE(PG8_SA(0, 1), cA + hstep, voffA);
        if (wr == 1) PG8_BAR;
        PG8_WAIT_V(4); PG8_BAR;
        PG8_STAGE(PG8_SB(1, 0), cB + kstep, voffB); PG8_STAGE(PG8_SA(1, 0), cA + kstep, voffA); PG8_STAGE(PG8_SB(1, 1), cB + hstep + kstep, voffB);
        PG8_WAIT_V(6); PG8_BAR;
    }
    for (;;) {
        const bool has_next = S.next(ui + 1, nxt);
        const char* nA = has_next ? (const char*)g.A + (size_t)nxt.pm * tstep : cA; const char* nB = has_next ? (const char*)g.Bt + (size_t)nxt.pn * tstep : cB;
        for (int t = 0; t < nt; t += 2) {
            const bool last = (t == nt - 2);
            const char* a1 = cA + (size_t)(t + 1) * kstep;
            const char* a2 = last ? nA : cA + (size_t)(t + 2) * kstep; const char* b2 = last ? nB : cB + (size_t)(t + 2) * kstep;
            const char* a3 = a2 + kstep; const char* b3 = b2 + kstep;
            if constexpr (Epi::MIDK) { if (t == (nt >> 1)) E.mid(acc, cur, wr, wc, fr, fq); }
            if (last && has_next) S.a_ready(nxt);
            if constexpr (SP2) {
            PG8_LDB(B0, 0, 0); PG8_LDB(B1, 0, 1); PG8_SCHED; PG8_LDA(At, 0, 0); PG8_STAGE(PG8_SA(1, 1), a1 + hstep, voffA);
            PG8_WAIT_V(8); PG8_WAIT_L(0); PG8_BAR; PG8_MMA(0, 0, At, B0); PG8_MMA(0, 1, At, B1); PG8_BAR; PG8_SCHED;
            PG8_LDA(At, 0, 1); PG8_STAGE(PG8_SB(0, 0), b2, voffB); PG8_STAGE(PG8_SB(0, 1), b2 + hstep, voffB); PG8_STAGE(PG8_SA(0, 0), a2, voffA);
            PG8_WAIT_V(8); PG8_WAIT_L(0); PG8_BAR; PG8_MMA(1, 0, At, B0); PG8_MMA(1, 1, At, B1); PG8_BAR; PG8_SCHED;
            PG8_LDB(B0, 1, 0); PG8_LDB(B1, 1, 1); PG8_SCHED; PG8_LDA(At, 1, 0); PG8_STAGE(PG8_SA(0, 1), a2 + hstep, voffA);
            PG8_WAIT_V(8); PG8_WAIT_L(0); PG8_BAR; PG8_MMA(0, 0, At, B0); PG8_MMA(0, 1, At, B1); PG8_BAR; PG8_SCHED;
            PG8_LDA(At, 1, 1); PG8_STAGE(PG8_SB(1, 0), b3, voffB); PG8_STAGE(PG8_SB(1, 1), b3 + hstep, voffB); PG8_STAGE(PG8_SA(1, 0), a3, voffA);
            PG8_WAIT_V(8); PG8_WAIT_L(0); PG8_BAR; PG8_MMA(1, 0, At, B0); PG8_MMA(1, 1, At, B1); PG8_BAR; PG8_SCHED;
            } else {
            PG8_LDB(B0, 0, 0); PG8_SCHED; PG8_LDA(At, 0, 0); PG8_STAGE(PG8_SA(1, 1), a1 + hstep, voffA);
            PG8_WAIT_L(8); PG8_BAR; PG8_WAIT_L(0); PG8_MMA(0, 0, At, B0); PG8_BAR; PG8_SCHED;
            PG8_LDB(B1, 0, 1); PG8_STAGE(PG8_SB(0, 0), b2, voffB);
            PG8_BAR; PG8_WAIT_L(0); PG8_MMA(0, 1, At, B1); PG8_BAR;
            PG8_LDA(At, 0, 1); PG8_STAGE(PG8_SA(0, 0), a2, voffA);
            PG8_BAR; PG8_WAIT_L(0); PG8_MMA(1, 0, At, B0); PG8_BAR; PG8_SCHED;
            PG8_STAGE(PG8_SB(0, 1), b2 + hstep, voffB);
            PG8_WAIT_V(6); PG8_BAR; PG8_MMA(1, 1, At, B1); PG8_BAR;
            PG8_LDB(B0, 1, 0); PG8_SCHED; PG8_LDA(At, 1, 0); PG8_STAGE(PG8_SA(0, 1), a2 + hstep, voffA);
            PG8_WAIT_L(8); PG8_BAR; PG8_WAIT_L(0); PG8_MMA(0, 0, At, B0); PG8_BAR; PG8_SCHED;
            PG8_LDB(B1, 1, 1); PG8_STAGE(PG8_SB(1, 0), b3, voffB);
            PG8_BAR; PG8_WAIT_L(0); PG8_MMA(0, 1, At, B1); PG8_BAR;
            PG8_LDA(At, 1, 1); PG8_STAGE(PG8_SA(1, 0), a3, voffA);
            PG8_BAR; PG8_WAIT_L(0); PG8_MMA(1, 0, At, B0); PG8_BAR; PG8_SCHED;
            PG8_STAGE(PG8_SB(1, 1), b3 + hstep, voffB);
            PG8_WAIT_V(6); PG8_BAR; PG8_MMA(1, 1, At, B1); PG8_BAR;
            }
        }
        if constexpr (ALIGN_EPI) { if (wr == 0) PG8_BAR; }
        if constexpr (!Epi::AFTER_DRAIN) { E(acc, cur, wr, wc, fr, fq); S.done(cur); }
        if (!has_next) break;
#pragma unroll
        for (int a = 0; a < 2; ++a)
#pragma unroll
            for (int b = 0; b < 2; ++b)
#pragma unroll
                for (int m = 0; m < 4; ++m)
#pragma unroll
                    for (int n = 0; n < 2; ++n) acc[a][b][m][n] = (f32x4){0.f, 0.f, 0.f, 0.f};
        cur = nxt; cA = nA; cB = nB; ++ui;
        if constexpr (ALIGN_EPI) { if (wr == 1) PG8_BAR; }
    }
    PG8_WAIT_V(0);
    if constexpr (!ALIGN_EPI) { if (wr == 0) PG8_BAR; }
    PG8_BAR;
    if constexpr (Epi::AFTER_DRAIN) { E.fused(acc, cur, wr, wc, fr, fq, lds, wid, lane); S.done(cur); }
#undef PG8_SA
#undef PG8_SB
#undef PG8_STAGE
#undef PG8_LDA
#undef PG8_LDB
#undef PG8_MMA
#undef PG8_WAIT_V
#undef PG8_WAIT_L
#undef PG8_BAR
#undef PG8_SCHED
}
}
#define GAS __attribute__((address_space(1)))
#define LAS __attribute__((address_space(3)))
typedef unsigned short bf16;
typedef unsigned v4u __attribute__((ext_vector_type(4)));
typedef float f32x4 __attribute__((ext_vector_type(4)));
typedef short bf16x8 __attribute__((ext_vector_type(8)));
typedef GAS unsigned gu32;
typedef GAS unsigned long long gu64;
#define RLX_AGENT __ATOMIC_RELAXED, __HIP_MEMORY_SCOPE_AGENT
#define LDS_WAIT() asm volatile("s_waitcnt lgkmcnt(0)" ::: "memory")
#define VM_WAIT() asm volatile("s_waitcnt vmcnt(0)" ::: "memory")
__device__ __forceinline__ unsigned long long rt() { return __builtin_amdgcn_s_memrealtime(); }
__device__ __forceinline__ unsigned f2bf(float f) { unsigned u = __builtin_bit_cast(unsigned, f); return (u + 0x7fffu + ((u >> 16) & 1u)) >> 16; }
__device__ __forceinline__ unsigned pk2(float lo, float hi) { return f2bf(lo) | (f2bf(hi) << 16); }

#define XB_TMO      128
#define XB_XCNT(j)  (256  + 64 * (j))
#define XB_XSUB(j)  (1280 + 64 * (j))
#define XB_XGEN(j)  (2304 + 64 * (j))
#define XB_TOP      3328
#define XB_TOPGEN   3392
#define XCD_BAR_WORDS 3456
#define XB_SPIN_CAP (1u << 18)

__device__ __forceinline__ unsigned xb_ld(unsigned* p)              { return __hip_atomic_load(p, __ATOMIC_RELAXED, __HIP_MEMORY_SCOPE_AGENT); }
__device__ __forceinline__ unsigned xb_add(unsigned* p, unsigned v) { return __hip_atomic_fetch_add(p, v, __ATOMIC_RELAXED, __HIP_MEMORY_SCOPE_AGENT); }
__device__ __forceinline__ unsigned xb_xcc_id() { return (unsigned)__builtin_amdgcn_s_getreg((3 << 11) | 20) & 0xFu; }
#define XB_SPIN(cond, bar) do { unsigned _sp = 0; while (cond) { __builtin_amdgcn_s_sleep(1); \
    if ((++_sp & 255u) == 0u) { if (xb_ld(&(bar)[XB_TMO])) break; if (_sp > XB_SPIN_CAP) { atomicAdd(&(bar)[XB_TMO], 1u); break; } } } } while (0)

struct XcdBarrier {
    unsigned* bar; unsigned x;
    volatile LAS unsigned* st;
};

__device__ __forceinline__ XcdBarrier xcd_barrier_post(unsigned* bar, volatile LAS unsigned* st) {
    XcdBarrier b; b.bar = bar; b.x = xb_xcc_id(); b.st = st;
    if (threadIdx.x == 0) { const unsigned r_ = xb_add(&bar[XB_XCNT(b.x)], 1u); st[2] = r_; st[3] = b.x; }
    return b;
}
__device__ __forceinline__ void xcd_barrier_complete(unsigned* bar, unsigned x, unsigned& nloc, unsigned& nx) {
    const unsigned G = gridDim.x * gridDim.y * gridDim.z;
    unsigned sum, cnt, mine, sp = 0u;
    for (;;) {
        sum = 0u; cnt = 0u; mine = 0u;
#pragma unroll
        for (unsigned j = 0; j < 16; ++j) { const unsigned c = xb_ld(&bar[XB_XCNT(j)]); sum += c; cnt += (c > 0u) ? 1u : 0u; mine = (j == x) ? c : mine; }
        if (sum == G) break;
        __builtin_amdgcn_s_sleep(1);
        if ((++sp & 255u) == 0u) { if (xb_ld(&bar[XB_TMO])) break; if (sp > XB_SPIN_CAP) { atomicAdd(&bar[XB_TMO], 1u); break; } }
    }
    nloc = mine > 0u ? mine : 1u; nx = cnt > 0u ? cnt : 1u;
}

__device__ __forceinline__ void xcd_barrier(const XcdBarrier& b) {
    asm volatile("s_waitcnt vmcnt(0)" ::: "memory");
    __syncthreads();
    if (threadIdx.x == 0) {
        unsigned* bar = b.bar;
        __builtin_amdgcn_s_waitcnt(0);
        unsigned nloc = b.st[0], nx = b.st[1];
        if (nloc == 0u) { xcd_barrier_complete(bar, b.x, nloc, nx); b.st[0] = nloc; b.st[1] = nx; }
        const unsigned old = xb_add(&bar[XB_XSUB(b.x)], 1u);
        const unsigned gen = old / nloc;
        if (old + 1u == (gen + 1u) * nloc) {
            __builtin_amdgcn_fence(__ATOMIC_RELEASE, "agent");
            asm volatile("s_waitcnt vmcnt(0)" ::: "memory");
            const unsigned og = xb_add(&bar[XB_TOP], 1u);
            const unsigned tg = og / nx;
            if (og + 1u == (tg + 1u) * nx) xb_add(&bar[XB_TOPGEN], 1u);
            else XB_SPIN(xb_ld(&bar[XB_TOPGEN]) == tg, bar);
            __builtin_amdgcn_fence(__ATOMIC_ACQUIRE, "agent");
            xb_add(&bar[XB_XGEN(b.x)], 1u);
            asm volatile("s_waitcnt vmcnt(0)" ::: "memory");
        } else {
            XB_SPIN(xb_ld(&bar[XB_XGEN(b.x)]) == gen, bar);
            __builtin_amdgcn_fence(__ATOMIC_ACQUIRE, "agent");
            asm volatile("s_waitcnt vmcnt(0)" ::: "memory");
        }
    }
    __syncthreads();
}

constexpr int NWAVES = 8;
constexpr int BATCH = 16, SEQ = 2048, T = BATCH * SEQ, D = 1024, DIN = 2560, NMEM = 256, TM = BATCH * NMEM;
constexpr int DLRU = 512, LBLK = 8, LBD = 64;
constexpr int AH = 8, AD = 64, MOBA = 256, NB = SEQ / MOBA;
constexpr int CH = 4, CD = 256;
constexpr int PKEYS = 128, PHEADS = 8, PTOP = 16, PHALF = 128, PEXP = PHEADS * PTOP;
constexpr float EPS = 1e-6f;
constexpr int COL_LX = 0, COL_LG = 512, COL_Q = 1024, COL_K = 1536, COL_V = 2048;

constexpr size_t MiB = 1u << 20;
constexpr size_t WS_CTL = 0, CTL_ZERO_BYTES = 64 * 1024;
constexpr size_t WS_WIN = 2 * MiB, WS_WOUT = 7 * MiB, WS_WCQ = 9 * MiB, WS_WCKV = 11 * MiB, WS_WCO = 15 * MiB, WS_WPQ = 17 * MiB, WS_SUBK = 21 * MiB;
constexpr size_t WS_KMEAN = 23 * MiB;
constexpr size_t WS_MEMN = 24 * MiB;
constexpr size_t WS_KCVC = 32 * MiB;
constexpr size_t WS_SS1 = 48 * MiB, WS_SS2 = 50 * MiB;
constexpr size_t WS_IDS = 52 * MiB;
constexpr size_t WS_GATES = 60 * MiB;
constexpr size_t WS_A = 80 * MiB;
constexpr size_t WS_B = 144 * MiB;
constexpr size_t WS_C = 304 * MiB;
constexpr size_t WS_E = 368 * MiB;
constexpr size_t WS_SU = 76 * MiB;
constexpr size_t WS_SS3 = 77 * MiB;
constexpr size_t WS_HS = 78 * MiB;
constexpr size_t WS_SSL = 79 * MiB, WS_SSA = 22 * MiB;
constexpr size_t WS_XQ = 144 * MiB;
constexpr size_t WS_VQ = 272 * MiB;
constexpr size_t WS_ACTW = 288 * MiB;
constexpr size_t WS_UQ = 496 * MiB;
constexpr size_t WS_END = 512 * MiB;
constexpr int XQ_LD = 2048;
constexpr int CW_TMO = 0, CW_BAR = 4096, CW_QUAD = 8192  , CW_XID = 12288  , CW_G32 = 12800  , CW_WCNT = 13312  ;

constexpr int RING_OFF = 0, RING_BYTES = 131072;
constexpr int STREAM_OFF = 81920, STREAM_WAVE_BYTES = 8192;
constexpr int LDSCTL_OFF = 155648, MISC_OFF = LDSCTL_OFF + 320;
constexpr int LDS_BYTES = 163840;

__device__ __forceinline__ float bf2f(bf16 b) { return __uint_as_float(((unsigned)b) << 16); }
__device__ __forceinline__ float bflo(unsigned w) { return __uint_as_float(w << 16); }
__device__ __forceinline__ float bfhi(unsigned w) { return __uint_as_float(w & 0xffff0000u); }
__device__ __forceinline__ float wave_sum(float v) {
#pragma unroll
    for (int o = 1; o < 64; o <<= 1) v += __shfl_xor(v, o);
    return v;
}
__device__ __forceinline__ float wave_max(float v) {
#pragma unroll
    for (int o = 1; o < 64; o <<= 1) v = fmaxf(v, __shfl_xor(v, o));
    return v;
}
__device__ __forceinline__ unsigned wave_umax(unsigned v) {
#pragma unroll
    for (int o = 1; o < 64; o <<= 1) { const unsigned w = (unsigned)__shfl_xor((int)v, o); v = v > w ? v : w; }
    return v;
}
__device__ __forceinline__ float gelu_erf(float v) { return 0.5f * v * (1.0f + erff(v * 0.70710678118654752f)); }
__device__ __forceinline__ float sigmoidf_(float v) { return 1.0f / (1.0f + __expf(-v)); }
__device__ __forceinline__ unsigned ordf(float f) { const unsigned u = __float_as_uint(f); return (u & 0x80000000u) ? ~u : (u | 0x80000000u); }

struct Frame {
    LAS unsigned char* lds;
    volatile LAS unsigned* MISC;
    gu32* ctl;
    int tid, lane, wave, vcu, G;
    const float* in[26]; float* out; unsigned char* ws;
};

__device__ __forceinline__ void p0_transpose_item(const float* W, int K, int N, bf16* WT, int row_off, LAS float* scr, int item, int lane, const float* g0, const float* g1) {
    const int nblk = N / 32, kb = item / nblk, nb = item % nblk, k0 = 64 * kb, n0 = 32 * nb;
#pragma unroll 8
    for (int i = 0; i < 32; ++i) { const int kk = 2 * i + (lane >> 5); const int k = k0 + kk; float gv = 1.f; if (g0) gv = (k < 512) ? g0[k] : g1[k - 512];
        scr[kk * 33 + (lane & 31)] = W[(size_t)k * N + n0 + (lane & 31)] * gv; }
    LDS_WAIT(); asm volatile("" ::: "memory");
    const int c = lane & 7;
#pragma unroll
    for (int j = 0; j < 4; ++j) { const int n = (lane >> 3) + 8 * j; const LAS float* s = scr + (8 * c) * 33 + n;
        v4u o; o.x = pk2(s[0 * 33], s[1 * 33]); o.y = pk2(s[2 * 33], s[3 * 33]); o.z = pk2(s[4 * 33], s[5 * 33]); o.w = pk2(s[6 * 33], s[7 * 33]);
        *(GAS v4u*)(WT + (size_t)(row_off + n0 + n) * K + k0 + 8 * c) = o; }
    LDS_WAIT(); asm volatile("" ::: "memory");
}
template <int R> __device__ __forceinline__ void rms_rows_to_bf16(int lane, const float* xrow, const float* g, bf16* orow) {
    f32x4 v[R][4]; float s[R];
#pragma unroll
    for (int r = 0; r < R; ++r) { const GAS f32x4* xr = (const GAS f32x4*)(xrow + (size_t)r * D) + lane;
#pragma unroll
        for (int j = 0; j < 4; ++j) v[r][j] = __builtin_nontemporal_load(xr + 64 * j); }
    const GAS f32x4* gr = (const GAS f32x4*)g + lane; f32x4 gg[4];
#pragma unroll
    for (int j = 0; j < 4; ++j) gg[j] = gr[64 * j];
#pragma unroll
    for (int r = 0; r < R; ++r) { float a = 0.f;
#pragma unroll
        for (int j = 0; j < 4; ++j) a += (v[r][j].x * v[r][j].x + v[r][j].y * v[r][j].y) + (v[r][j].z * v[r][j].z + v[r][j].w * v[r][j].w);
        s[r] = a; }
#pragma unroll
    for (int o = 1; o < 64; o <<= 1) {
#pragma unroll
        for (int r = 0; r < R; ++r) s[r] += __shfl_xor(s[r], o); }
#pragma unroll
    for (int r = 0; r < R; ++r) { const float rs = 1.f / sqrtf(s[r] * (1.f / D) + EPS); GAS unsigned long long* o8 = (GAS unsigned long long*)(orow + (size_t)r * D) + lane;
#pragma unroll
        for (int j = 0; j < 4; ++j) o8[64 * j] = (unsigned long long)pk2(v[r][j].x * rs * gg[j].x, v[r][j].y * rs * gg[j].y) | ((unsigned long long)pk2(v[r][j].z * rs * gg[j].z, v[r][j].w * rs * gg[j].w) << 32); }
}
__device__ __forceinline__ void p0_prologue(Frame& F, bool split) {
    LAS float* scr = (LAS float*)(F.lds + RING_OFF + F.wave * 16384);
    const int gw = F.vcu * NWAVES + F.wave, NGW = F.G * NWAVES;
    bf16* Win_t = (bf16*)(F.ws + WS_WIN); bf16* Wout_t = (bf16*)(F.ws + WS_WOUT); bf16* Wcq_t = (bf16*)(F.ws + WS_WCQ); bf16* Wckv_t = (bf16*)(F.ws + WS_WCKV);
    bf16* Wco_t = (bf16*)(F.ws + WS_WCO); bf16* Wpq_t = (bf16*)(F.ws + WS_WPQ);
    constexpr int I_IN = (D / 64) * (DIN / 32), I_SQ = (D / 64) * (D / 32), I_PQ = (D / 64) * (2048 / 32);
    constexpr int NITEMS = I_IN + 5 * I_SQ + I_PQ;
    for (int it = gw; it < NITEMS; it += NGW) {
        int r = it;
        if (r < I_IN) { p0_transpose_item(F.in[3], D, DIN, Win_t, 0, scr, r, F.lane, nullptr, nullptr); continue; } r -= I_IN;
        if (r < I_SQ) { p0_transpose_item(F.in[13], D, D, Wout_t, 0, scr, r, F.lane, F.in[11], F.in[12]); continue; } r -= I_SQ;
        if (r < I_SQ) { p0_transpose_item(F.in[16], D, D, Wcq_t, 0, scr, r, F.lane, F.in[14], F.in[14] + 512); continue; } r -= I_SQ;
        if (r < I_SQ) { p0_transpose_item(F.in[17], D, D, Wckv_t, 0, scr, r, F.lane, nullptr, nullptr); continue; } r -= I_SQ;
        if (r < I_SQ) { p0_transpose_item(F.in[18], D, D, Wckv_t, D, scr, r, F.lane, nullptr, nullptr); continue; } r -= I_SQ;
        if (r < I_SQ) { p0_transpose_item(F.in[19], D, D, Wco_t, 0, scr, r, F.lane, nullptr, nullptr); continue; } r -= I_SQ;
        p0_transpose_item(F.in[21], D, 2048, Wpq_t, 0, scr, r, F.lane, F.in[20], F.in[20] + 512);
    }
    bf16* H = (bf16*)(F.ws + WS_A); bf16* MEMN = (bf16*)(F.ws + WS_MEMN);
    for (int m = 2 * gw; m < TM; m += 2 * NGW) rms_rows_to_bf16<2>(F.lane, F.in[1] + (size_t)m * D, F.in[15], MEMN + (size_t)m * D);
    { bf16* SUBK = (bf16*)(F.ws + WS_SUBK); const float* sk = F.in[22]; const int gt = F.vcu * (NWAVES * 64) + F.tid, NGT = F.G * NWAVES * 64;
      for (int i = gt; i < PHEADS * 2 * PKEYS * PHALF / 4; i += NGT) { const f32x4 v = ((const GAS f32x4*)sk)[i]; ((GAS unsigned long long*)SUBK)[i] = (unsigned long long)pk2(v.x, v.y) | ((unsigned long long)pk2(v.z, v.w) << 32); } }
    if (split) {
        asm volatile("s_waitcnt vmcnt(0)" ::: "memory"); __syncthreads();
        if (F.tid == 0) { __builtin_amdgcn_fence(__ATOMIC_RELEASE, "agent"); asm volatile("s_waitcnt vmcnt(0)" ::: "memory"); __hip_atomic_fetch_add(F.ctl + CW_WCNT, 1u, RLX_AGENT); }
        const int lw = ((int)blockIdx.x >> 3) * NWAVES + F.wave, nlw = (F.G >> 3) * NWAVES, r0 = ((int)blockIdx.x & 7) * (T / 8);
        for (int m = 4 * lw; m < T / 8; m += 4 * nlw) rms_rows_to_bf16<4>(F.lane, F.in[0] + (size_t)(r0 + m) * D, F.in[2], H + (size_t)(r0 + m) * D);
    } else
        for (int m = 4 * gw; m < T; m += 4 * NGW) rms_rows_to_bf16<4>(F.lane, F.in[0] + (size_t)m * D, F.in[2], H + (size_t)m * D);
}

typedef float f32x2_ __attribute__((ext_vector_type(2)));
struct PeerStream {
    int k, count; int lane;
    bool local; int gbase, gstep, xb0, xb1, vbase;
    __device__ __forceinline__ int item_of(int kk) const { return local ? (kk >= 8 ? 16384 + (((kk - 8) >> 1) ? xb1 : xb0) + (kk & 1) : vbase + 8 * kk) : gbase + kk * gstep; }
    const float* U; const float* V; const float* gf; signed char* UQ; float* SU; unsigned char* VQ;
    const bf16* X2; const float* SS2; signed char* XQ; float* HS;
    LAS unsigned char* buf; LAS unsigned char* sbuf;
    __device__ __forceinline__ void issue(int kk) { const int item = item_of(kk);
        if (item < 16384) {
#pragma unroll
            for (int j = 0; j < 4; ++j) __builtin_amdgcn_global_load_lds((const unsigned*)(V + (size_t)item * D + j * 256 + 4 * lane), (LAS unsigned*)(buf + 4096 + j * 1024), 16, 0, 0);
        } else { const int t = 4 * (item - 16384);
#pragma unroll
            for (int j = 0; j < 8; ++j) __builtin_amdgcn_global_load_lds((const unsigned*)(X2 + (size_t)(t + (j >> 1)) * D + (j & 1) * 512 + 8 * lane), (LAS unsigned*)(buf + j * 1024), 16, 0, 0);
            __builtin_amdgcn_global_load_lds((const unsigned*)(SS2 + (size_t)(t + (lane >> 4)) * 16 + (lane & 15)), (LAS unsigned*)sbuf, 4, 0, 0);
        }
    }
    template <bool WAIT = true> __device__ __forceinline__ void finish(int kk) { const int item = item_of(kk);
        if constexpr (WAIT) asm volatile("s_waitcnt vmcnt(0)" ::: "memory");
        if (item < 16384) { const int e = item;
            v4u o2;
#pragma unroll
            for (int i = 0; i < 4; ++i) { const f32x4 w = *(const LAS f32x4*)(buf + 4096 + 64 * lane + 16 * i) * 16.0f;
                int p = __builtin_amdgcn_cvt_pk_fp8_f32(w[0], w[1], 0, false); p = __builtin_amdgcn_cvt_pk_fp8_f32(w[2], w[3], p, true); o2[i] = (unsigned)p; }
            *(v4u*)(VQ + ((size_t)(lane >> 3) * (PKEYS * PKEYS) + e) * 128 + 16 * (lane & 7)) = o2;
        } else { const int t = 4 * (item - 16384);
#pragma unroll
            for (int q = 0; q < 4; ++q) { const v4u wa = *(const LAS v4u*)(buf + 2048 * q + 32 * lane), wb = *(const LAS v4u*)(buf + 2048 * q + 32 * lane + 16); const unsigned w[8] = {wa.x, wa.y, wa.z, wa.w, wb.x, wb.y, wb.z, wb.w};
                float am = 0.f;
#pragma unroll
                for (int i = 0; i < 8; ++i) am = fmaxf(am, fmaxf(fabsf(bflo(w[i])), fabsf(bfhi(w[i]))));
                am = wave_max(am); const float inv = am > 0.f ? 127.0f / am : 0.f;
                v4u o;
#pragma unroll
                for (int i = 0; i < 4; ++i) { const int q0 = (int)rintf(bflo(w[2 * i]) * inv), q1 = (int)rintf(bfhi(w[2 * i]) * inv), q2 = (int)rintf(bflo(w[2 * i + 1]) * inv), q3 = (int)rintf(bfhi(w[2 * i + 1]) * inv);
                    o[i] = (unsigned)(q0 & 0xff) | ((unsigned)(q1 & 0xff) << 8) | ((unsigned)(q2 & 0xff) << 16) | ((unsigned)(q3 & 0xff) << 24); }
                *(v4u*)(XQ + (size_t)(t + q) * XQ_LD + 16 * lane) = o;
                float a = *(const LAS float*)(sbuf + 64 * q + 4 * (lane & 15)); a += __shfl_xor(a, 1); a += __shfl_xor(a, 2); a += __shfl_xor(a, 4); a += __shfl_xor(a, 8);
                if (lane == 0) HS[t + q] = (1.f / sqrtf(a * (1.f / D) + EPS)) * am * (1.0f / 127.0f); }
        }
        asm volatile("s_waitcnt lgkmcnt(0)" ::: "memory");
    }
};
template <int WHICH> __device__ __forceinline__ void convert_rows(Frame& F, int i0, int i1) {
    const float* SRC = WHICH ? F.in[24] : F.in[23]; signed char* UQ = (signed char*)(F.ws + WS_UQ); float* SU = (float*)(F.ws + WS_SU); unsigned char* VQ = F.ws + WS_VQ;
    int lane = F.lane; asm volatile("" : "+v"(lane));
    f32x4 gg[4];
#pragma unroll
    for (int i = 0; i < 4; ++i) gg[i] = WHICH ? (f32x4){16.f, 16.f, 16.f, 16.f} : *(const f32x4*)(F.in[20] + 16 * lane + 4 * i);
    asm volatile("s_waitcnt vmcnt(0)" ::: "memory");
    LAS unsigned char* const b0 = F.lds + RING_OFF + F.wave * 16384;
#define CT_ISSUE(item, buf) do { _Pragma("unroll") for (int j = 0; j < 4; ++j) \
        __builtin_amdgcn_global_load_lds((const unsigned*)(SRC + (size_t)(item) * D + j * 256 + 4 * lane), (LAS unsigned*)((buf) + j * 1024), 16, 0, 0); } while (0)
    int it = i0 + F.wave, par = 0;
#pragma unroll
    for (int k = 0; k < 3; ++k) if (it + 8 * k < i1) CT_ISSUE(it + 8 * k, b0 + k * 4096);
    for (; it < i1; it += 8, par = (par + 1) & 3) {
        LAS unsigned char* const buf = b0 + par * 4096;
        if (it + 24 < i1) { CT_ISSUE(it + 24, b0 + ((par + 3) & 3) * 4096); asm volatile("s_waitcnt vmcnt(12)" ::: "memory"); }
        else if (it + 16 < i1) asm volatile("s_waitcnt vmcnt(8)" ::: "memory");
        else if (it + 8 < i1) asm volatile("s_waitcnt vmcnt(4)" ::: "memory");
        else asm volatile("s_waitcnt vmcnt(0)" ::: "memory");
        const int e = it; f32x4 v[4];
#pragma unroll
        for (int i = 0; i < 4; ++i) v[i] = *(const LAS f32x4*)(buf + 64 * lane + 16 * i) * gg[i];
        v4u o;
        if constexpr (WHICH == 0) { float am = 0.f;
#pragma unroll
            for (int i = 0; i < 4; ++i) am = fmaxf(am, fmaxf(fmaxf(fabsf(v[i][0]), fabsf(v[i][1])), fmaxf(fabsf(v[i][2]), fabsf(v[i][3]))));
            am = wave_max(am); const float inv = am > 0.f ? 127.0f / am : 0.f;
#pragma unroll
            for (int i = 0; i < 4; ++i) { const int q0 = (int)rintf(v[i][0] * inv), q1 = (int)rintf(v[i][1] * inv), q2 = (int)rintf(v[i][2] * inv), q3 = (int)rintf(v[i][3] * inv);
                o[i] = (unsigned)(q0 & 0xff) | ((unsigned)(q1 & 0xff) << 8) | ((unsigned)(q2 & 0xff) << 16) | ((unsigned)(q3 & 0xff) << 24); }
            *(v4u*)(UQ + ((size_t)(lane >> 3) * (PKEYS * PKEYS) + e) * 128 + 16 * (lane & 7)) = o;
            if (lane == 0) SU[e] = am * (1.0f / 127.0f);
        } else {
#pragma unroll
            for (int i = 0; i < 4; ++i) { int p = __builtin_amdgcn_cvt_pk_fp8_f32(v[i][0], v[i][1], 0, false); p = __builtin_amdgcn_cvt_pk_fp8_f32(v[i][2], v[i][3], p, true); o[i] = (unsigned)p; }
            *(v4u*)(VQ + ((size_t)(lane >> 3) * (PKEYS * PKEYS) + e) * 128 + 16 * (lane & 7)) = o;
        }
        asm volatile("s_waitcnt lgkmcnt(0)" ::: "memory");
    }
#undef CT_ISSUE
    asm volatile("s_waitcnt vmcnt(0) lgkmcnt(0)\n\ts_barrier" ::: "memory");
}
__device__ __forceinline__ void table_share(const Frame& F, int k, int n, int& i0, int& i1) {
    const int per = (PKEYS * PKEYS + F.G - 1) / F.G, lo = (int)blockIdx.x * per, hi = (lo + per < PKEYS * PKEYS) ? lo + per : PKEYS * PKEYS;
    i0 = lo + (k * per) / n; i1 = lo + ((k + 1) * per) / n; if (i0 > hi) i0 = hi; if (i1 > hi) i1 = hi;
}
__device__ __forceinline__ void xcd_split(Frame& F, bool census, int& part, int& rank, int& nrank) {
    part = (int)(blockIdx.x & 7); rank = (int)(blockIdx.x >> 3); nrank = (F.G - part + 7) >> 3;
    if (census && (F.G & 7) == 0) { const unsigned x = F.MISC[11], r = F.MISC[10]; unsigned pre = 0u; gu32* bar = F.ctl + CW_BAR;
#pragma unroll
        for (unsigned j = 0; j < 16; ++j) { const unsigned c = __hip_atomic_load(bar + XB_XCNT(j), RLX_AGENT); pre += (j < x) ? c : 0u; }
        const unsigned gi = pre + r, per = (unsigned)F.G >> 3; part = (int)(gi / per); rank = (int)(gi % per); nrank = (int)per; }
}
template <int CTRL> __device__ __forceinline__ int dpp_i(int x) { return __builtin_amdgcn_update_dpp(0, x, CTRL, 0xf, 0xf, true); }
template <int CTRL> __device__ __forceinline__ float dpp_f(float x) { return __int_as_float(__builtin_amdgcn_update_dpp(0, __float_as_int(x), CTRL, 0xf, 0xf, true)); }
constexpr int DPP_XOR1 = 0xB1  , DPP_XOR2 = 0x4E  , DPP_HMIRROR = 0x141  , DPP_ROR8 = 0x128  ;
__device__ __forceinline__ float swap32_add(float a, float b) { const auto r = __builtin_amdgcn_permlane32_swap(__float_as_uint(a), __float_as_uint(b), false, false); return __uint_as_float(r[0]) + __uint_as_float(r[1]); }
__device__ __forceinline__ float swap16_add(float a, float b) { const auto r = __builtin_amdgcn_permlane16_swap(__float_as_uint(a), __float_as_uint(b), false, false); return __uint_as_float(r[0]) + __uint_as_float(r[1]); }
struct PuMeta { v4u ida, idb; v4u xq; };
__device__ __forceinline__ void pu_load(PuMeta& m, int t, int g, int col16, const unsigned short* IDS, const signed char* XQ) {
    const v4u* ip = (const v4u*)(IDS + (size_t)t * PEXP + g * 16); m.ida = ip[0]; m.idb = ip[1]; m.xq = *(const v4u*)(XQ + (size_t)t * XQ_LD + col16);
}
__device__ __forceinline__ unsigned pu_id(const PuMeta& m, int i) { const unsigned w = (i < 8) ? m.ida[(i & 7) >> 1] : m.idb[(i & 7) >> 1]; return (i & 1) ? (w >> 16) : (w & 0xffffu); }
__device__ __forceinline__ void peer_u(Frame& F, bool census) {
    const unsigned short* IDS = (const unsigned short*)(F.ws + WS_IDS); const signed char* XQ = (const signed char*)(F.ws + WS_XQ); const signed char* UQ = (const signed char*)(F.ws + WS_UQ); int* PD = (int*)(F.ws + WS_E);
    int part, rank, nrank; xcd_split(F, census, part, rank, nrank); const int lane = F.lane, g = lane >> 3, l7 = lane & 7;
    const signed char* slab = UQ + (size_t)part * (PKEYS * PKEYS) * 128 + 16 * l7; const int col16 = 128 * part + 16 * l7;
    const bool b4 = (lane & 4) != 0, b2 = (lane & 2) != 0, b1 = (lane & 1) != 0;
    const int t0 = rank * NWAVES + F.wave, tstep = nrank * NWAVES;
    PuMeta m[4]; v4u q[2][16]; v4u xc[2];
#pragma unroll
    for (int k = 0; k < 4; ++k) { const int t = t0 + k * tstep; pu_load(m[k], t < T ? t : t0, g, col16, IDS, XQ); }
#define PU_ISSUE(buf, mk) do { _Pragma("unroll") for (int i_ = 0; i_ < 16; ++i_) q[buf][i_] = *(const v4u*)(slab + (size_t)pu_id((mk), i_) * 128); xc[buf] = (mk).xq; } while (0)
    PU_ISSUE(0, m[0]);
    { const int tp = t0 + 4 * tstep; if (tp < T) pu_load(m[0], tp, g, col16, IDS, XQ); }
    for (int tb = t0; tb < T; tb += 4 * tstep) {
#pragma unroll
        for (int k4 = 0; k4 < 4; ++k4) { const int k = k4 & 1;
            const int t = tb + k4 * tstep;
            if (t < T) {
                const int tn = t + tstep;
                if (tn < T) PU_ISSUE(k ^ 1, m[(k4 + 1) & 3]);
                { const int tp = t + 5 * tstep; if (tp < T) pu_load(m[(k4 + 1) & 3], tp, g, col16, IDS, XQ); }
                int d[16];
#pragma unroll
                for (int i = 0; i < 16; ++i) { const v4u uu = q[k][i]; const v4u xx = xc[k];
                    int a = __builtin_amdgcn_sdot4((int)uu.x, (int)xx.x, 0, false); a = __builtin_amdgcn_sdot4((int)uu.y, (int)xx.y, a, false); a = __builtin_amdgcn_sdot4((int)uu.z, (int)xx.z, a, false); d[i] = __builtin_amdgcn_sdot4((int)uu.w, (int)xx.w, a, false); }
                int r8[8], r4[4], r2[2];
#pragma unroll
                for (int i = 0; i < 8; ++i) { const int sa = d[i] + dpp_i<DPP_HMIRROR>(d[i]), sb = d[i + 8] + dpp_i<DPP_HMIRROR>(d[i + 8]); r8[i] = b4 ? sb : sa; }
#pragma unroll
                for (int i = 0; i < 4; ++i) { const int sa = r8[i] + dpp_i<DPP_XOR2>(r8[i]), sb = r8[i + 4] + dpp_i<DPP_XOR2>(r8[i + 4]); r4[i] = b2 ? sb : sa; }
#pragma unroll
                for (int i = 0; i < 2; ++i) { const int sa = r4[i] + dpp_i<DPP_XOR1>(r4[i]), sb = r4[i + 2] + dpp_i<DPP_XOR1>(r4[i + 2]); r2[i] = b1 ? sb : sa; }
                { const int q0_ = (r2[0] + 32) >> 6, q1_ = (r2[1] + 32) >> 6;
                  PD[((size_t)t * 8 + part) * 64 + lane] = (int)(((unsigned)q0_ & 0xffffu) | ((unsigned)q1_ << 16)); }
            }
        }
    }
#undef PU_ISSUE
}
__device__ __forceinline__ void peer_combine(Frame& F) {
    const int* PD = (const int*)(F.ws + WS_E); const unsigned short* IDS = (const unsigned short*)(F.ws + WS_IDS); const float* GATES = (const float*)(F.ws + WS_GATES); const float* SU = (const float*)(F.ws + WS_SU);
    const float* HS = (const float*)(F.ws + WS_HS); unsigned* PK = (unsigned*)(F.ws + WS_ACTW);
    const int gw = F.vcu * NWAVES + F.wave, NGW = F.G * NWAVES, lane = F.lane, g = lane >> 3, l7 = lane & 7;
    const int ii0 = 2 * (l7 & 1) + 4 * ((l7 >> 1) & 1) + 8 * ((l7 >> 2) & 1), p0 = 8 * ii0 + g, p1 = 8 * (ii0 + 1) + g, q0 = g * 16 + ii0, q1 = q0 + 1;
    for (int t = 2 * gw; t < T; t += 2 * NGW) {
        uint2 v[2][8]; float hs[2], g0[2], g1[2]; int id0[2], id1[2];
#pragma unroll
        for (int r = 0; r < 2; ++r) {
#pragma unroll
            for (int x = 0; x < 8; ++x) { const int w_ = PD[((size_t)(t + r) * 8 + x) * 64 + lane]; v[r][x] = make_uint2((unsigned)((w_ << 16) >> 16), (unsigned)(w_ >> 16)); }
            hs[r] = HS[t + r]; id0[r] = IDS[(size_t)(t + r) * PEXP + q0]; id1[r] = IDS[(size_t)(t + r) * PEXP + q1]; g0[r] = GATES[(size_t)(t + r) * PEXP + p0]; g1[r] = GATES[(size_t)(t + r) * PEXP + p1]; }
        float su0[2], su1[2];
#pragma unroll
        for (int r = 0; r < 2; ++r) { su0[r] = SU[id0[r]]; su1[r] = SU[id1[r]]; }
#pragma unroll
        for (int r = 0; r < 2; ++r) { int s0 = 0, s1 = 0;
#pragma unroll
            for (int x = 0; x < 8; ++x) { s0 += (int)v[r][x].x; s1 += (int)v[r][x].y; }
            const float w0 = g0[r] * gelu_erf(hs[r] * su0[r] * (64.0f * (float)s0)) * 0.0625f, w1 = g1[r] * gelu_erf(hs[r] * su1[r] * (64.0f * (float)s1)) * 0.0625f;
            *(uint2*)(PK + (size_t)(t + r) * PEXP + q0) = make_uint2((f2bf(w0) << 16) | (unsigned)id0[r], (f2bf(w1) << 16) | (unsigned)id1[r]); }
    }
}
struct PvMeta { v4u pk[4]; unsigned xw; };
__device__ __forceinline__ void pv_load(PvMeta& m, int t, int g, int col, const unsigned* PK, const bf16* X2) {
    const v4u* pp = (const v4u*)(PK + (size_t)t * PEXP + g * 16);
#pragma unroll
    for (int i = 0; i < 4; ++i) m.pk[i] = pp[i];
    m.xw = *(const unsigned*)(X2 + (size_t)t * D + col);
}
__device__ __forceinline__ void peer_v(Frame& F, bool census) {
    const bf16* X2 = (const bf16*)(F.ws + WS_C); const unsigned* PK = (const unsigned*)(F.ws + WS_ACTW);
    const unsigned char* VQ = F.ws + WS_VQ; bf16* X3 = (bf16*)(F.ws + WS_A);
    int part, rank, nrank; xcd_split(F, census, part, rank, nrank); const int lane = F.lane, g = lane >> 3, l7 = lane & 7;
    const unsigned char* slab = VQ + (size_t)part * (PKEYS * PKEYS) * 128 + 16 * l7;
    const bool hi = lane >= 32, b16 = (lane & 16) != 0, b8 = (lane & 8) != 0;
    const int col = 128 * part + 16 * l7 + 2 * g;
    const int t0 = rank * NWAVES + F.wave, tstep = nrank * NWAVES;
    PvMeta m[4]; v4u qa[8], qb[8]; float wa[8], wb[8];
#pragma unroll
    for (int k = 0; k < 4; ++k) { const int t = t0 + k * tstep; pv_load(m[k], t < T ? t : t0, g, col, PK, X2); }
#define PV_ISSUE(qx, wx, mk, h_) do { _Pragma("unroll") for (int i_ = 0; i_ < 8; ++i_) { const unsigned p_ = (mk).pk[2 * (h_) + (i_ >> 2)][i_ & 3]; wx[i_] = __uint_as_float(p_ & 0xffff0000u); qx[i_] = *(const v4u*)(slab + (size_t)(p_ & 0xffffu) * 128); } } while (0)
#define PV_HALF(qx, wx) do { _Pragma("unroll") for (int i_ = 0; i_ < 8; ++i_) { const float w_ = wx[i_]; \
        _Pragma("unroll") for (int kk = 0; kk < 4; ++kk) { const f32x2_ lo = __builtin_amdgcn_cvt_pk_f32_fp8((int)qx[i_][kk], false), hi2 = __builtin_amdgcn_cvt_pk_f32_fp8((int)qx[i_][kk], true); \
            acc2[2 * kk] += lo * w_; acc2[2 * kk + 1] += hi2 * w_; } } } while (0)
    PV_ISSUE(qa, wa, m[0], 0);
    for (int tb = t0; tb < T; tb += 4 * tstep) {
#pragma unroll
        for (int k = 0; k < 4; ++k) {
            const int t = tb + k * tstep;
            if (t < T) {
                PV_ISSUE(qb, wb, m[k], 1); const unsigned xw = m[k].xw;
                f32x2_ acc2[8];
#pragma unroll
                for (int i = 0; i < 8; ++i) acc2[i] = (f32x2_){0.f, 0.f};
                PV_HALF(qa, wa);
                const int tn = t + tstep;
                if (tn < T) { PV_ISSUE(qa, wa, m[(k + 1) & 3], 0); }
                { const int tp = t + 4 * tstep; if (tp < T) pv_load(m[k], tp, g, col, PK, X2); }
                PV_HALF(qb, wb);
                float acc[16];
#pragma unroll
                for (int i = 0; i < 8; ++i) { acc[2 * i] = acc2[i].x; acc[2 * i + 1] = acc2[i].y; }
                float r8[8], r4[4], r2[2];
#pragma unroll
                for (int i = 0; i < 8; ++i) r8[i] = swap32_add(acc[i], acc[i + 8]);
#pragma unroll
                for (int i = 0; i < 4; ++i) r4[i] = swap16_add(r8[i], r8[i + 4]);
#pragma unroll
                for (int i = 0; i < 2; ++i) { const float sa = r4[i] + dpp_f<DPP_ROR8>(r4[i]), sb = r4[i + 2] + dpp_f<DPP_ROR8>(r4[i + 2]); r2[i] = b8 ? sb : sa; }
                const float y0 = bflo(xw) + r2[0], y1 = bfhi(xw) + r2[1];
                *(unsigned*)(X3 + (size_t)t * D + col) = pk2(y0, y1);
            }
        }
    }
#undef PV_ISSUE
#undef PV_HALF
}
__device__ __forceinline__ void final_norm(Frame& F) {
    const bf16* X3 = (const bf16*)(F.ws + WS_A); const float* SS3 = (const float*)(F.ws + WS_SS3); const float* gfin = F.in[25];
    int tid_ = threadIdx.x; asm volatile("" : "+v"(tid_)); const int lane = tid_ & 63;
    const int gw = F.vcu * NWAVES + F.wave, NGW = F.G * NWAVES;
    f32x4 gg[4];
#pragma unroll
    for (int i = 0; i < 4; ++i) gg[i] = *(const f32x4*)(gfin + 256 * i + 4 * lane);
    for (int t = 4 * gw; t < T; t += 4 * NGW) {
        uint2 v[4][4]; float tot[4];
#pragma unroll
        for (int r = 0; r < 4; ++r)
#pragma unroll
            for (int i = 0; i < 4; ++i) v[r][i] = *(const uint2*)(X3 + (size_t)(t + r) * D + 256 * i + 4 * lane);
#pragma unroll
        for (int r = 0; r < 4; ++r) { float a = 0.f;
#pragma unroll
            for (int i = 0; i < 4; ++i) { const float x0 = bflo(v[r][i].x), x1 = bfhi(v[r][i].x), x2 = bflo(v[r][i].y), x3 = bfhi(v[r][i].y); a += (x0 * x0 + x1 * x1) + (x2 * x2 + x3 * x3); }
            tot[r] = a; }
#pragma unroll
        for (int o = 1; o < 64; o <<= 1)
#pragma unroll
            for (int r = 0; r < 4; ++r) tot[r] += __shfl_xor(tot[r], o);
#pragma unroll
        for (int r = 0; r < 4; ++r) { const float rs = 1.f / sqrtf(tot[r] * (1.f / D) + EPS);
#pragma unroll
            for (int i = 0; i < 4; ++i) { f32x4 o; o[0] = bflo(v[r][i].x) * rs * gg[i][0]; o[1] = bfhi(v[r][i].x) * rs * gg[i][1]; o[2] = bflo(v[r][i].y) * rs * gg[i][2]; o[3] = bfhi(v[r][i].y) * rs * gg[i][3];
                __builtin_nontemporal_store(o, (f32x4*)(F.out + (size_t)(t + r) * D + 256 * i + 4 * lane)); } }
    }
}

#include <hip/hip_bf16.h>
#include <cmath>
namespace attn_body {
using bf16=__hip_bfloat16;
using bf16x8=__attribute__((ext_vector_type(8)))short;
using s16x4=__attribute__((ext_vector_type(4)))short;
using f32x16=__attribute__((ext_vector_type(16)))float;
using u32x4=__attribute__((ext_vector_type(4)))unsigned;
constexpr int BATCH=16,NHEAD=8,SEQ=2048,D=64,DM=2560,DMO=1024;
constexpr int NW=8,QBLK=32,QB=QBLK*NW,KVBLK=64,NQB=SEQ/QB;
constexpr int ATTN_PITCH=DM, ATTN_UNIT_ROWS=QB;
__device__ __forceinline__ int crow(int r,int hi){return (r&3)+8*(r>>2)+4*hi;}
#define SBAR() __builtin_amdgcn_sched_barrier(0)
__device__ __forceinline__ void cmask(f32x16&p0,f32x16&p1,int jb,int qrel,int hi){
  const float NEG=-INFINITY; int kb=64*jb+4*hi;
  #pragma unroll
  for(int r=0;r<16;++r){int kv=kb+(r&3)+8*(r>>2); if(kv>qrel)p0[r]=NEG; if(kv+32>qrel)p1[r]=NEG;}
}

constexpr int NSLOT=3, SLOTB=8192;
constexpr int LDS_K=0, LDS_V=NSLOT*SLOTB, LDS_WS=2*NSLOT*SLOTB, LDS_OST=LDS_WS+NW*128*4, LDS_SEL=LDS_OST+NW*4096, LDS_BYTES=LDS_SEL+16*QB*4;
constexpr float C2=0.125f*1.4426950408889634f;
__device__ __forceinline__ void glds16(const void*gsrc,unsigned lds_dst){unsigned keep;
  asm volatile("s_mov_b32 %0, m0\n\ts_mov_b32 m0, %2\n\ts_nop 0\n\tglobal_load_lds_dwordx4 %1, off\n\ts_mov_b32 m0, %0":"=&s"(keep):"v"(gsrc),"s"(lds_dst):"memory");}
__device__ __forceinline__ float max3f(float a,float b,float c){float r;asm("v_max3_f32 %0, %1, %2, %3":"=v"(r):"v"(a),"v"(b),"v"(c));return r;}
__device__ __forceinline__ float max2f(float a,float b){float r;asm("v_max_f32_e32 %0, %1, %2":"=v"(r):"v"(a),"v"(b));return r;}
__device__ __forceinline__ float fadd_s(float a,float b){float r;asm("v_add_f32_e32 %0, %1, %2":"=v"(r):"v"(a),"v"(b));return r;}
__device__ __forceinline__ float fsub_s(float a,float b){float r;asm("v_sub_f32_e32 %0, %1, %2":"=v"(r):"v"(a),"v"(b));return r;}
typedef float f32x2_t __attribute__((ext_vector_type(2))); typedef __bf16 bf16x2_t __attribute__((ext_vector_type(2)));
__device__ __forceinline__ unsigned cvtpk_s(float lo,float hi){f32x2_t v={lo,hi};bf16x2_t b=__builtin_convertvector(v,bf16x2_t);return __builtin_bit_cast(unsigned,b);}
#define WAIT_BAR(N) asm volatile("s_waitcnt vmcnt(" #N ") lgkmcnt(0)\n\ts_barrier":::"memory")

__device__ __forceinline__ void qkt(f32x16&p0,f32x16&p1,const char*Kslot,const bf16x8*qr,const f32x16&negm,int r32,int hi){
  const char*kb=Kslot+hi*1024+r32*16;
  #pragma unroll
  for(int d0=0;d0<4;++d0){
    const bf16x8 b0=*reinterpret_cast<const bf16x8*>(kb+d0*2048);
    const bf16x8 b1=*reinterpret_cast<const bf16x8*>(kb+d0*2048+512);
    if(d0==0){p0=__builtin_amdgcn_mfma_f32_32x32x16_bf16(b0,qr[0],negm,0,0,0);p1=__builtin_amdgcn_mfma_f32_32x32x16_bf16(b1,qr[0],negm,0,0,0);}
    else{p0=__builtin_amdgcn_mfma_f32_32x32x16_bf16(b0,qr[d0],p0,0,0,0);p1=__builtin_amdgcn_mfma_f32_32x32x16_bf16(b1,qr[d0],p1,0,0,0);}}
}
typedef __attribute__((address_space(3))) const char* lds_cptr;
typedef short v4i16_t __attribute__((ext_vector_type(4)));
__device__ __forceinline__ void kload8(bf16x8*kf,lds_cptr kp){
  kf[0]=*(const __attribute__((address_space(3))) bf16x8*)(kp);      kf[1]=*(const __attribute__((address_space(3))) bf16x8*)(kp+512);
  kf[2]=*(const __attribute__((address_space(3))) bf16x8*)(kp+2048); kf[3]=*(const __attribute__((address_space(3))) bf16x8*)(kp+2560);
  kf[4]=*(const __attribute__((address_space(3))) bf16x8*)(kp+4096); kf[5]=*(const __attribute__((address_space(3))) bf16x8*)(kp+4608);
  kf[6]=*(const __attribute__((address_space(3))) bf16x8*)(kp+6144); kf[7]=*(const __attribute__((address_space(3))) bf16x8*)(kp+6656);
}
__device__ __forceinline__ void kload2(bf16x8*kf,lds_cptr kp,int j){ kf[2*j]=*(const __attribute__((address_space(3))) bf16x8*)(kp+j*2048); kf[2*j+1]=*(const __attribute__((address_space(3))) bf16x8*)(kp+j*2048+512); }
__device__ __forceinline__ s16x4 vtr(lds_cptr p){ return __builtin_bit_cast(s16x4,__builtin_amdgcn_ds_read_tr16_b64_v4i16((__attribute__((address_space(3))) v4i16_t*)p)); }
__device__ __forceinline__ float rowmax(const f32x16&p0,const f32x16&p1){
  float a=max3f(p0[0],p0[1],p1[0]),b=max3f(p0[2],p0[3],p1[1]);a=max3f(a,p1[2],p1[3]);
  #pragma unroll
  for(int r=4;r<16;r+=4){a=max3f(a,p0[r],p0[r+1]);b=max3f(b,p0[r+2],p0[r+3]);a=max3f(a,p1[r],p1[r+1]);b=max3f(b,p1[r+2],p1[r+3]);}
  const float m=max2f(a,b);
  auto rr=__builtin_amdgcn_permlane32_swap(__float_as_uint(m),__float_as_uint(m),false,false);
  return max2f(__uint_as_float(rr[0]),__uint_as_float(rr[1]));
}
__device__ __forceinline__ void pv(f32x16*o,int vb,bf16x8 pa0,bf16x8 pa1,bf16x8 pa2,bf16x8 pa3){
  #pragma unroll
  for(int d0=0;d0<2;++d0){s16x4 lo[4],hi[4];
    #pragma unroll
    for(int ks=0;ks<4;++ks){
      asm volatile("ds_read_b64_tr_b16 %0,%1 offset:%c2":"=&v"(lo[ks]):"v"(vb),"i"(d0*4096+ks*1024):"memory");
      asm volatile("ds_read_b64_tr_b16 %0,%1 offset:%c2":"=&v"(hi[ks]):"v"(vb),"i"(d0*4096+ks*1024+512):"memory");}
    asm volatile("s_waitcnt lgkmcnt(0)":::"memory");SBAR();
    #define PK(k) (bf16x8){lo[k][0],lo[k][1],lo[k][2],lo[k][3],hi[k][0],hi[k][1],hi[k][2],hi[k][3]}
    o[d0]=__builtin_amdgcn_mfma_f32_32x32x16_bf16(pa0,PK(0),o[d0],0,0,0);
    o[d0]=__builtin_amdgcn_mfma_f32_32x32x16_bf16(pa1,PK(1),o[d0],0,0,0);
    o[d0]=__builtin_amdgcn_mfma_f32_32x32x16_bf16(pa2,PK(2),o[d0],0,0,0);
    o[d0]=__builtin_amdgcn_mfma_f32_32x32x16_bf16(pa3,PK(3),o[d0],0,0,0);
    #undef PK
  }
}

#ifndef ATTN_STORE16
#define ATTN_STORE16(p,v) (*(u32x4*)(p)=(v))
#endif
template<int THRL> __device__ __forceinline__ void attn_unit(int b,int h,int qb,const bf16*Q,const bf16*__restrict__ K,const bf16*__restrict__ V,bf16*O,float*SSA,int ui,char*shm){
  int tid_=threadIdx.x; asm volatile("":"+v"(tid_)); const int tid=tid_,lane=tid&63,r32=lane&31,hi=lane>>5; const int wid=__builtin_amdgcn_readfirstlane(tid>>6);
  const long rowbase=(long)b*SEQ; const int q0=qb*QB;
  const bf16*Qw=Q+(rowbase+q0+wid*QBLK)*DM+h*D;
  const bf16*Kh=K+rowbase*DM+h*D,*Vh=V+rowbase*DM+h*D;
  const unsigned lds0=(unsigned)(uintptr_t)shm;
  float*wsf=(float*)(shm+LDS_WS)+wid*128; const unsigned*selp=(const unsigned*)(shm+LDS_SEL)+ui*QB+wid*QBLK+r32;

  const bf16*ksrc=Kh+(long)lane*DM+wid*8;
  const bf16*vsrc=Vh+(long)(16*(wid&3)+(lane>>2))*DM+(wid>>2)*32+(lane&3)*8;
  const unsigned kdst=lds0+LDS_K+wid*1024, vdst=lds0+LDS_V+wid*1024;
  const int tb4=4*qb;
  #define PHYS(t) (((t)<4)?(tb4+(t)):((t)-4))
  #define DMA_K(t,slot) glds16(ksrc+(long)PHYS(t)*KVBLK*DM,(unsigned)__builtin_amdgcn_readfirstlane(kdst+(slot)))
  #define DMA_V(t,slot) glds16(vsrc+(long)PHYS(t)*KVBLK*DM,(unsigned)__builtin_amdgcn_readfirstlane(vdst+(slot)))
  const int vb0=(int)(lds0+LDS_V)+((lane>>4)&1)*32+(lane&3)*8+(4*hi+((lane&15)>>2))*64;
  const char*Kbase=shm+LDS_K; bf16x8 kf[8];
  const lds_cptr shm3=(lds_cptr)shm; const lds_cptr kp0=shm3+LDS_K+hi*1024+r32*16; const lds_cptr vp0=shm3+LDS_V+((lane>>4)&1)*32+(lane&3)*8+(4*hi+((lane&15)>>2))*64;
  const int NT=(q0+QB)/KVBLK;
  DMA_K(0,0);DMA_V(0,0);DMA_K(1,SLOTB);
  bf16x8 qr[4];
  #pragma unroll
  for(int d0=0;d0<4;++d0)qr[d0]=*reinterpret_cast<const bf16x8*>(&Qw[(long)r32*DM+d0*16+hi*8]);

  float mhat=0.f,l_reg=0.f;f32x16 o[2];o[0]=f32x16{};o[1]=f32x16{};const f32x16 negm0=f32x16{};
  const int qrel=wid*QBLK+r32;
  #define CMASK(P0,P1,t) do{ if((t)<4){cmask(P0,P1,(t),qrel,hi);} }while(0)
  bool resc=false;
  #define START(P0,P1) do{ const float rm=rowmax(P0,P1); resc=false; \
    { const float dl=rm; mhat=fadd_s(mhat,dl); \
      _Pragma("unroll") for(int r=0;r<16;++r){P0[r]=fsub_s(P0[r],dl);P1[r]=fsub_s(P1[r],dl);} \
    } \
    _Pragma("unroll") for(int r=0;r<16;++r)P0[r]=__builtin_amdgcn_exp2f(P0[r]); }while(0)
  #define RESC() do{ if(resc){ asm volatile("s_waitcnt lgkmcnt(0)":::"memory"); \
      _Pragma("unroll") for(int d_=0;d_<2;++d_) _Pragma("unroll") for(int r=0;r<16;++r)o[d_][r]*=wsf[crow(r,hi)]; } }while(0)
  f32x16 pA0,pA1,pB0,pB1;
  int sl_prev=0,sl_cur=0,sl_next=SLOTB;
  #define ROT() do{sl_prev=sl_cur;sl_cur=sl_next;sl_next=(sl_next==(NSLOT-1)*SLOTB)?0:sl_next+SLOTB;}while(0)
  DMA_K(2,2*SLOTB);
  WAIT_BAR(3);
  qkt(pA0,pA1,Kbase,qr,negm0,r32,hi);asm volatile("s_nop 15\n\ts_nop 7":"+v"(pA0),"+v"(pA1));CMASK(pA0,pA1,0);
  START(pA0,pA1);
  _Pragma("unroll") for(int r=0;r<16;++r)pA1[r]=__builtin_amdgcn_exp2f(pA1[r]);
  WAIT_BAR(0);
  DMA_K(3,0);DMA_V(1,SLOTB);
  ROT();
  kload8(kf,kp0+sl_cur);
  WAIT_BAR(2);
  s16x4 vlo[8],vhi[8]; u32x4 pw0,pw1,pw2,pw3;
  #define PKW(P,B) cvtpk_s(P[B],P[B+1])
  #define PAF(k) __builtin_bit_cast(bf16x8,pw##k)
  #define VFR(i) (bf16x8){vlo[i][0],vlo[i][1],vlo[i][2],vlo[i][3],vhi[i][0],vhi[i][1],vhi[i][2],vhi[i][3]}
  #define PIN(x) asm volatile("":"+v"(x))
  #define MX3(a,b,c) __builtin_fmaxf(__builtin_fmaxf((a),(b)),(c))
  #define GAPA(MF,A0,A1,A2,A3,W0,W1,PW) do{ MF; sacc+=A0; sacc+=A1; sacc+=A2; sacc+=A3; PIN(sacc); W0; W1; PIN(PW); SBAR(); }while(0)
  #define EX(v) __builtin_amdgcn_exp2f(v)
  #define GAPB(MF,X,B) do{ MF; X[B]=EX(X[B]); X[B+1]=EX(X[B+1]); X[B+2]=EX(X[B+2]); X[B+3]=EX(X[B+3]); PIN(X); SBAR(); }while(0)
  #define VRD(i) do{ vlo[i]=vtr(vp_+(((i)>>2)*4096+((i)&3)*1024)); vhi[i]=vtr(vp_+(((i)>>2)*4096+((i)&3)*1024+512)); }while(0)
  #define KRD(G,j) do{ if(G){ kload2(kf,kp0+sl_next,j); SBAR(); } }while(0)
  #define STEP(C0,C1,P0,P1,t,GK,GV,GL) do{ SBAR(); \
    const lds_cptr vp_=vp0+sl_prev; \
    float sacc; { const unsigned sw_=*selp; const float nm_=((sw_>>(((t)<4)?31:((((t)-4)>>2)&7)))&1u)?-mhat:-1.0e30f; f32x16 negm; _Pragma("unroll") for(int r=0;r<16;++r)negm[r]=nm_; asm volatile("":"+v"(negm)); \
    VRD(0); SBAR(); sacc=(P0[0]+P0[1]); \
    GAPA(C0=__builtin_amdgcn_mfma_f32_32x32x16_bf16(kf[0],qr[0],negm,0,0,0), P0[2],P0[3],P0[4],P0[5],     pw0[0]=PKW(P0,0), pw0[1]=PKW(P0,2), pw0); \
    VRD(4); SBAR(); GAPA(C1=__builtin_amdgcn_mfma_f32_32x32x16_bf16(kf[1],qr[0],negm,0,0,0), P0[6],P0[7],P0[8],P0[9],     pw0[2]=PKW(P0,4), pw0[3]=PKW(P0,6), pw0); \
    } \
    VRD(1); SBAR(); GAPA(C0=__builtin_amdgcn_mfma_f32_32x32x16_bf16(kf[2],qr[1],C0,0,0,0),   P0[10],P0[11],P0[12],P0[13], pw1[0]=PKW(P0,8), pw1[1]=PKW(P0,10), pw1); \
    VRD(5); SBAR(); GAPA(C1=__builtin_amdgcn_mfma_f32_32x32x16_bf16(kf[3],qr[1],C1,0,0,0),   P0[14],P0[15],P1[0],P1[1],   pw1[2]=PKW(P0,12),pw1[3]=PKW(P0,14), pw1); \
    VRD(2); SBAR(); GAPA(C0=__builtin_amdgcn_mfma_f32_32x32x16_bf16(kf[4],qr[2],C0,0,0,0),   P1[2],P1[3],P1[4],P1[5],     pw2[0]=PKW(P1,0), pw2[1]=PKW(P1,2), pw2); \
    VRD(6); SBAR(); GAPA(C1=__builtin_amdgcn_mfma_f32_32x32x16_bf16(kf[5],qr[2],C1,0,0,0),   P1[6],P1[7],P1[8],P1[9],     pw2[2]=PKW(P1,4), pw2[3]=PKW(P1,6), pw2); \
    VRD(3); SBAR(); GAPA(C0=__builtin_amdgcn_mfma_f32_32x32x16_bf16(kf[6],qr[3],C0,0,0,0),   P1[10],P1[11],P1[12],P1[13], pw3[0]=PKW(P1,8), pw3[1]=PKW(P1,10), pw3); \
    VRD(7); SBAR(); GAPA(C1=__builtin_amdgcn_mfma_f32_32x32x16_bf16(kf[7],qr[3],C1,0,0,0),   P1[14],P1[15],0.f,0.f,       pw3[2]=PKW(P1,12),pw3[3]=PKW(P1,14), pw3); \
    l_reg+=sacc; \
    if(GK){DMA_K((t)+3,sl_cur);} if(GV){DMA_V((t)+1,sl_next);} \
    CMASK(C0,C1,t); \
    { float a=MX3(C0[0],C0[1],C1[0]),b=MX3(C0[2],C0[3],C1[1]); a=MX3(a,C1[2],C1[3]); \
      _Pragma("unroll") for(int r=4;r<16;r+=4){a=MX3(a,C0[r],C0[r+1]);b=MX3(b,C0[r+2],C0[r+3]);a=MX3(a,C1[r],C1[r+1]);b=MX3(b,C1[r+2],C1[r+3]);} \
      float rm=__builtin_fmaxf(a,b); { auto rr=__builtin_amdgcn_permlane32_swap(__float_as_uint(rm),__float_as_uint(rm),false,false); rm=__builtin_fmaxf(__uint_as_float(rr[0]),__uint_as_float(rr[1])); } \
      resc=false; \
      if(__builtin_expect(__any(rm>(float)THRL),0)){ const float dl=__builtin_fmaxf(rm,0.f); mhat+=dl; \
        _Pragma("unroll") for(int r=0;r<16;++r){C0[r]-=dl;C1[r]-=dl;} \
        const float f=__builtin_amdgcn_exp2f(-dl); l_reg*=f; if(hi==0)wsf[r32]=f; resc=true; } } \
    SBAR(); \
    GAPB(o[0]=__builtin_amdgcn_mfma_f32_32x32x16_bf16(PAF(0),VFR(0),o[0],0,0,0), C0,0); \
    GAPB(o[1]=__builtin_amdgcn_mfma_f32_32x32x16_bf16(PAF(0),VFR(4),o[1],0,0,0), C0,4); \
    KRD(GL,0); GAPB(o[0]=__builtin_amdgcn_mfma_f32_32x32x16_bf16(PAF(1),VFR(1),o[0],0,0,0), C0,8); \
    KRD(GL,1); GAPB(o[1]=__builtin_amdgcn_mfma_f32_32x32x16_bf16(PAF(1),VFR(5),o[1],0,0,0), C0,12); \
    KRD(GL,2); GAPB(o[0]=__builtin_amdgcn_mfma_f32_32x32x16_bf16(PAF(2),VFR(2),o[0],0,0,0), C1,0); \
    KRD(GL,3); GAPB(o[1]=__builtin_amdgcn_mfma_f32_32x32x16_bf16(PAF(2),VFR(6),o[1],0,0,0), C1,4); \
    GAPB(o[0]=__builtin_amdgcn_mfma_f32_32x32x16_bf16(PAF(3),VFR(3),o[0],0,0,0), C1,8); \
    GAPB(o[1]=__builtin_amdgcn_mfma_f32_32x32x16_bf16(PAF(3),VFR(7),o[1],0,0,0), C1,12); \
    }while(0)
  int t=1;
  for(;t+5<NT;t+=2){
    STEP(pB0,pB1,pA0,pA1,t,true,true,true);     WAIT_BAR(2); RESC(); ROT();
    STEP(pA0,pA1,pB0,pB1,t+1,true,true,true);   WAIT_BAR(2); RESC(); ROT();
  }
  #define ENDW(tt) do{ if((tt)+3<NT){WAIT_BAR(2);} else if((tt)+2<NT){WAIT_BAR(1);} else {WAIT_BAR(0);} }while(0)
  for(;t+1<NT;t+=2){
    STEP(pB0,pB1,pA0,pA1,t,(t+3<NT),(t+1<NT),(t+1<NT));       ENDW(t);   RESC(); ROT();
    STEP(pA0,pA1,pB0,pB1,t+1,(t+4<NT),(t+2<NT),(t+2<NT));     ENDW(t+1); RESC(); ROT();
  }
  STEP(pB0,pB1,pA0,pA1,NT-1,false,false,false); RESC();
  { float sacc=pB0[0]+pB0[1]; _Pragma("unroll") for(int r=2;r<16;++r)sacc+=pB0[r]; _Pragma("unroll") for(int r=0;r<16;++r)sacc+=pB1[r]; l_reg+=sacc;
    pw0=(u32x4){PKW(pB0,0),PKW(pB0,2),PKW(pB0,4),PKW(pB0,6)};pw1=(u32x4){PKW(pB0,8),PKW(pB0,10),PKW(pB0,12),PKW(pB0,14)};pw2=(u32x4){PKW(pB1,0),PKW(pB1,2),PKW(pB1,4),PKW(pB1,6)};pw3=(u32x4){PKW(pB1,8),PKW(pB1,10),PKW(pB1,12),PKW(pB1,14)};
    SBAR(); pv(o,vb0+sl_cur,PAF(0),PAF(1),PAF(2),PAF(3)); }
  #undef PKW
  #undef PAF
  #undef VFR
  #undef PIN
  #undef MX3
  #undef GAPA
  #undef GAPB
  #undef EX
  #undef VRD
  #undef KRD
  #undef STEP
  #undef ENDW
  {auto rr=__builtin_amdgcn_permlane32_swap(__float_as_uint(l_reg),__float_as_uint(l_reg),false,false);l_reg=__uint_as_float(rr[0])+__uint_as_float(rr[1]);}
  if(hi==0)wsf[32+r32]=l_reg;asm volatile("s_waitcnt lgkmcnt(0)":::"memory");
  float rli[16];
  #pragma unroll
  for(int r=0;r<16;++r)rli[r]=__builtin_amdgcn_rcpf(wsf[32+crow(r,hi)]);
  bf16*Ow=O+(rowbase+q0+wid*QBLK)*DMO+h*D;
  { bf16*stg=(bf16*)(shm+LDS_OST)+wid*2048;
    #pragma unroll
    for(int r=0;r<16;++r){const int orow=crow(r,hi);
      #pragma unroll
      for(int d0=0;d0<2;++d0)stg[orow*64+d0*32+r32]=__float2bfloat16(o[d0][r]*rli[r]);}
    asm volatile("s_waitcnt lgkmcnt(0)":::"memory");
    #pragma unroll
    for(int i=0;i<4;++i){const int row=i*8+(lane>>3),ch=lane&7; const u32x4 v=*(const u32x4*)(stg+row*64+ch*8); ATTN_STORE16(Ow+(long)row*DMO+ch*8,v);
      float sq=0.f;
      #pragma unroll
      for(int e=0;e<4;++e){const float lo_=__uint_as_float(v[e]<<16),hi_=__uint_as_float(v[e]&0xffff0000u); sq+=lo_*lo_+hi_*hi_;}
      sq+=__shfl_xor(sq,1); sq+=__shfl_xor(sq,2); sq+=__shfl_xor(sq,4);
      if(ch==0)SSA[(rowbase+q0+wid*QBLK+row)*8+h]=sq; } }
  asm volatile("s_waitcnt lgkmcnt(0)\n\ts_barrier":::"memory");
  #undef DMA_K
  #undef DMA_V
  #undef PHYS
  #undef CMASK
  #undef START
  #undef RESC
  #undef ROT
}
constexpr int ATTN_LDS_BYTES=LDS_BYTES;
struct AttnTensors { const bf16* Q; const bf16* K; const bf16* V; bf16* O; const float* KM; float* SSA; };
struct AttnUnit { int bh; int qb; };
struct StaticOrder {
  int vcu,G;
  __device__ __forceinline__ explicit StaticOrder(int grid,int block):vcu((grid%8==0)?((block%8)*(grid/8)+block/8):block),G(grid){}
  __device__ __forceinline__ bool next(int i,AttnUnit&u)const{ const int it=(i>>2)*G+vcu; if(it>=2*BATCH*NHEAD)return false; const int j=i&3,s=it&1; u.bh=it>>1; u.qb=s?((j==0)?6:(j==1)?5:(j==2)?2:1):((j==0)?7:(j==1)?4:(j==2)?3:0); return true; }
  __device__ __forceinline__ void a_ready(const AttnUnit&)const{}
  __device__ __forceinline__ void done(const AttnUnit&)const{}
};
__device__ __forceinline__ void attn_select(int b,int h,int qb,const bf16*Q,const float*__restrict__ KM,int ui,char*shm){
  int tid_=threadIdx.x; asm volatile("":"+v"(tid_)); const int tid=tid_,lane=tid&63,r32=lane&31,hi=lane>>5; const int wid=__builtin_amdgcn_readfirstlane(tid>>6);
  unsigned*selw=(unsigned*)(shm+LDS_SEL)+ui*QB+wid*QBLK+r32; float*kml=(float*)(shm+LDS_K);
  unsigned word=0xffffffffu;
  if(qb>3){
    if(tid<qb*64){ const long ki=((long)(b*NHEAD+h)*8)*64+tid; kml[tid]=(KM[ki]+KM[(long)BATCH*NHEAD*8*64+ki])*(1.0f/256.0f); }
    const bf16*qrow=Q+((long)b*SEQ+qb*QB+wid*QBLK+r32)*DM+h*D+hi*8; uint4 qv[4];
    #pragma unroll
    for(int d0=0;d0<4;++d0)qv[d0]=*reinterpret_cast<const uint4*>(qrow+d0*16);
    asm volatile("s_waitcnt vmcnt(0) lgkmcnt(0)\n\ts_barrier":::"memory");
    float g1=-3.0e38f,g2=-3.0e38f,g3=-3.0e38f; int i1=0,i2=0,i3=0;
    #pragma unroll 1
    for(int n=0;n<qb;++n){ const float*km=kml+n*64+hi*8; float a=0.f;
      #pragma unroll
      for(int d0=0;d0<4;++d0){ const float4 k0=*(const float4*)(km+d0*16),k1=*(const float4*)(km+d0*16+4); const uint4 q4=qv[d0];
        a+=__uint_as_float(q4.x<<16)*k0.x+__uint_as_float(q4.x&0xffff0000u)*k0.y+__uint_as_float(q4.y<<16)*k0.z+__uint_as_float(q4.y&0xffff0000u)*k0.w
          +__uint_as_float(q4.z<<16)*k1.x+__uint_as_float(q4.z&0xffff0000u)*k1.y+__uint_as_float(q4.w<<16)*k1.z+__uint_as_float(q4.w&0xffff0000u)*k1.w; }
      a+=__shfl_xor(a,32);
      if(a>g1){g3=g2;i3=i2;g2=g1;i2=i1;g1=a;i1=n;} else if(a>g2){g3=g2;i3=i2;g2=a;i2=n;} else if(a>g3){g3=a;i3=n;} }
    word=0x80000000u|(1u<<i1)|(1u<<i2)|(1u<<i3); }
  if(hi==0)*selw=word;
  asm volatile("s_waitcnt lgkmcnt(0)\n\ts_barrier":::"memory");
}
__device__ __forceinline__ int attn_qb(int role,int j){ return role?((j==0)?5:(j==1)?3:(j==2)?2:0):((j==0)?7:(j==1)?6:(j==2)?4:1); }
template<int THRL=8> __device__ __forceinline__ void attn_item(char*lds,const AttnTensors&T,int it){
  const int bh=it>>1,role=it&1,b=bh/NHEAD,h=bh%NHEAD; const int nu=4;
  for(int j=0;j<nu;++j)attn_select(b,h,attn_qb(role,j),T.Q,T.KM,j,lds);
  for(int j=0;j<nu;++j)attn_unit<THRL>(b,h,attn_qb(role,j),T.Q,T.K,T.V,T.O,T.SSA,j,lds);
}
template<class Sched,int THRL=8> __device__ __forceinline__ void attn_phase(char*lds,const AttnTensors&T,const Sched&S){
  AttnUnit u;
  for(int i=0;i<16&&S.next(i,u);++i)attn_select(u.bh/NHEAD,u.bh%NHEAD,u.qb,T.Q,T.KM,i,lds);
  for(int i=0;i<16&&S.next(i,u);++i){ S.a_ready(u); attn_unit<THRL>(u.bh/NHEAD,u.bh%NHEAD,u.qb,T.Q,T.K,T.V,T.O,T.SSA,i,lds); S.done(u); }
}
#undef SBAR
#undef WAIT_BAR
}

namespace cross_body {
typedef short bf16x8 __attribute__((ext_vector_type(8)));
typedef float f32x4 __attribute__((ext_vector_type(4)));
typedef unsigned u32x2 __attribute__((ext_vector_type(2)));
typedef unsigned u32x4 __attribute__((ext_vector_type(4)));
#define CB_LAS __attribute__((address_space(3)))
constexpr int TILE_OFF = 0, PW_OFF = 65536, LDS_BYTES = 65536 + 8 * 8192;
#define CB_BAR() asm volatile("s_waitcnt lgkmcnt(0)\n\ts_barrier" ::: "memory")
#define CB_VMWAIT() asm volatile("s_waitcnt vmcnt(0)" ::: "memory")
__device__ __forceinline__ void cross_stage(CB_LAS unsigned char* buf, const unsigned short* KC, const unsigned short* VT, int b, int hd, int i, int wid, const unsigned (&voK)[4], const unsigned (&voV)[4]) {
    if (i < 4) { const unsigned short* base = KC + (size_t)(b * 256 + 64 * i) * 1024 + hd * 256;
#pragma unroll
        for (int q = 0; q < 4; ++q) __builtin_amdgcn_global_load_lds((const unsigned*)(base + voK[q]), (CB_LAS unsigned*)(buf + (wid * 4 + q) * 1024), 16, 0, 0);
    } else { const unsigned short* base = VT + (size_t)(hd * 256) * 4096 + b * 256 + 64 * (i - 4);
#pragma unroll
        for (int q = 0; q < 4; ++q) __builtin_amdgcn_global_load_lds((const unsigned*)(base + voV[q]), (CB_LAS unsigned*)(buf + (wid * 4 + q) * 1024), 16, 0, 0);
    }
}
__device__ __forceinline__ void cross_unit(CB_LAS unsigned char* lds, const unsigned short* QC, const unsigned short* KC, const unsigned short* VT, unsigned short* OC, int b, int hd, int t0, bf16x8 (&qf)[8], bool first, bool has_next, int nb_, int nhd, int nt0, int zz = 0) {
    const int tid = threadIdx.x + zz, lane = tid & 63, n = lane & 15, g = lane >> 4; const int wid = __builtin_amdgcn_readfirstlane(tid >> 6);
    CB_LAS unsigned char* pw = lds + PW_OFF + wid * 8192;
    unsigned voK[4], voV[4];
#pragma unroll
    for (int q = 0; q < 4; ++q) { const int off = (wid * 4 + q) * 1024 + lane * 16; { const int row = off >> 9, c = (off >> 4) & 31, sc = c ^ (row & 15); voK[q] = (unsigned)(row * 1024 + 8 * sc); }
        { const int row = off >> 7, c = (off >> 4) & 7, sc = c ^ ((row >> 1) & 7); voV[q] = (unsigned)(row * 4096 + 8 * sc); } }
    if (first) {
        CB_BAR();
        cross_stage(lds + TILE_OFF, KC, VT, b, hd, 0, wid, voK, voV);
        const unsigned short* qrow = QC + (size_t)(t0 + wid * 16 + n) * 1024 + hd * 256 + 8 * g;
#pragma unroll
        for (int ks = 0; ks < 8; ++ks) qf[ks] = *(const bf16x8*)(qrow + 32 * ks);
    }
    f32x4 s[16];
#pragma unroll
    for (int i = 0; i < 16; ++i) s[i] = (f32x4){0.f, 0.f, 0.f, 0.f};
#pragma unroll
    for (int kt = 0; kt < 4; ++kt) {
        CB_LAS unsigned char* tile = lds + TILE_OFF + (kt & 1) * 32768;
        CB_VMWAIT(); CB_BAR();
        cross_stage(lds + TILE_OFF + ((kt + 1) & 1) * 32768, KC, VT, b, hd, kt + 1, wid, voK, voV);
#pragma unroll
        for (int nb = 0; nb < 4; ++nb) { const int row = 16 * nb + n;
#pragma unroll
            for (int ks = 0; ks < 8; ++ks) { const bf16x8 kf = *(const CB_LAS bf16x8*)(tile + row * 512 + (((4 * ks + g) ^ (row & 15)) << 4));
                s[kt * 4 + nb] = __builtin_amdgcn_mfma_f32_16x16x32_bf16(kf, qf[ks], s[kt * 4 + nb], 0, 0, 0); }
            if (nb & 1) __builtin_amdgcn_sched_barrier(0); }
    }
    float mx = -3.0e38f;
#pragma unroll
    for (int i = 0; i < 16; ++i) mx = fmaxf(mx, fmaxf(fmaxf(s[i][0], s[i][1]), fmaxf(s[i][2], s[i][3])));
    mx = fmaxf(mx, __shfl_xor(mx, 16)); mx = fmaxf(mx, __shfl_xor(mx, 32));
    const float c2 = 0.0625f * 1.4426950408889634f; float l = 0.f;
#pragma unroll
    for (int i = 0; i < 16; ++i) {
        f32x4 p; p[0] = __builtin_amdgcn_exp2f((s[i][0] - mx) * c2); p[1] = __builtin_amdgcn_exp2f((s[i][1] - mx) * c2); p[2] = __builtin_amdgcn_exp2f((s[i][2] - mx) * c2); p[3] = __builtin_amdgcn_exp2f((s[i][3] - mx) * c2);
        l += (p[0] + p[1]) + (p[2] + p[3]);
        u32x2 w; w.x = pg8::cvt_pk_bf16(p[0], p[1]); w.y = pg8::cvt_pk_bf16(p[2], p[3]);
        *(CB_LAS u32x2*)(pw + n * 512 + (((2 * i + (g >> 1)) ^ n) << 4) + ((g & 1) << 3)) = w;
    }
    l += __shfl_xor(l, 16); l += __shfl_xor(l, 32);
    const float linv = 1.0f / l;
    f32x4 o[16];
#pragma unroll
    for (int i = 0; i < 16; ++i) o[i] = (f32x4){0.f, 0.f, 0.f, 0.f};
#pragma unroll
    for (int kt = 0; kt < 4; ++kt) {
        CB_LAS unsigned char* tile = lds + TILE_OFF + (kt & 1) * 32768;
        CB_VMWAIT(); CB_BAR();
        if (kt < 3) cross_stage(lds + TILE_OFF + ((kt + 1) & 1) * 32768, KC, VT, b, hd, 5 + kt, wid, voK, voV);
        else if (has_next) {
            cross_stage(lds + TILE_OFF, KC, VT, nb_, nhd, 0, wid, voK, voV);
            const unsigned short* qrow = QC + (size_t)(nt0 + wid * 16 + n) * 1024 + nhd * 256 + 8 * g;
#pragma unroll
            for (int ks = 0; ks < 8; ++ks) qf[ks] = *(const bf16x8*)(qrow + 32 * ks); }
        bf16x8 pf[2];
#pragma unroll
        for (int ks = 0; ks < 2; ++ks) pf[ks] = *(const CB_LAS bf16x8*)(pw + n * 512 + (((8 * kt + 4 * ks + g) ^ n) << 4));
#pragma unroll
        for (int db = 0; db < 16; ++db) { const int row = 16 * db + n;
#pragma unroll
            for (int ks = 0; ks < 2; ++ks) { const bf16x8 vf = *(const CB_LAS bf16x8*)(tile + row * 128 + (((4 * ks + g) ^ ((row >> 1) & 7)) << 4));
                o[db] = __builtin_amdgcn_mfma_f32_16x16x32_bf16(vf, pf[ks], o[db], 0, 0, 0); }
            if ((db & 7) == 7) __builtin_amdgcn_sched_barrier(0); }
    }
    asm volatile("s_waitcnt lgkmcnt(0)" ::: "memory");
#pragma unroll
    for (int db = 0; db < 16; ++db) { u32x2 w; w.x = pg8::cvt_pk_bf16(o[db][0] * linv, o[db][1] * linv); w.y = pg8::cvt_pk_bf16(o[db][2] * linv, o[db][3] * linv);
        *(CB_LAS u32x2*)(pw + n * 512 + (((2 * db + (g >> 1)) ^ n) << 4) + ((g & 1) << 3)) = w; }
    asm volatile("s_waitcnt lgkmcnt(0)" ::: "memory");
#pragma unroll
    for (int i = 0; i < 8; ++i) { const int row = 2 * i + (lane >> 5), c = lane & 31; const u32x4 v = *(const CB_LAS u32x4*)(pw + row * 512 + ((c ^ row) << 4));
        *(u32x4*)(OC + (size_t)(t0 + wid * 16 + row) * 1024 + hd * 256 + 8 * c) = v; }
    asm volatile("s_waitcnt lgkmcnt(0)" ::: "memory");
}
__device__ __forceinline__ void cross_phase(CB_LAS unsigned char* lds, const unsigned short* QC, const unsigned short* KC, const unsigned short* VT, unsigned short* OC, int vcu, int G) {
    bf16x8 qf[8]; bool first = true;
    for (int u = vcu; u < 16 * 4 * 16; u += G) { const int tt = u & 15, hd = (u >> 4) & 3, b = u >> 6; const int un = u + G; const bool hn = un < 16 * 4 * 16;
        cross_unit(lds, QC, KC, VT, OC, b, hd, b * 2048 + tt * 128, qf, first, hn, un >> 6, (un >> 4) & 3, (un >> 6) * 2048 + (un & 15) * 128); first = false; }
    CB_VMWAIT(); CB_BAR();
}
#undef CB_BAR
#undef CB_VMWAIT
#undef CB_LAS
}

namespace route_body {
typedef short bf16x8 __attribute__((ext_vector_type(8)));
typedef float f32x4 __attribute__((ext_vector_type(4)));
typedef unsigned u32x2 __attribute__((ext_vector_type(2)));
typedef unsigned u32x4 __attribute__((ext_vector_type(4)));
#define RB_LAS __attribute__((address_space(3)))
constexpr int SUB_OFF = 0, LIST_OFF = 65536, LDS_BYTES = 65536 + 8 * 2048;
__device__ __forceinline__ unsigned ordf(float f) { return __float_as_uint(f); }
__device__ __forceinline__ float unordf(unsigned k) { return __uint_as_float(k); }
__device__ __forceinline__ unsigned umax_(unsigned a, unsigned b) { unsigned r; asm("v_max_f32 %0, %1, %2" : "=v"(r) : "v"(a), "v"(b)); return r; }
__device__ __forceinline__ unsigned umin_(unsigned a, unsigned b) { unsigned r; asm("v_min_f32 %0, %1, %2" : "=v"(r) : "v"(a), "v"(b)); return r; }
#define RB_CE(x, i, l) do { const unsigned hi_ = umax_(x[i], x[l]), lo_ = umin_(x[i], x[l]); x[i] = hi_; x[l] = lo_; } while (0)
#define RB_CEA(x, i, l) do { const unsigned hi_ = umax_(x[i], x[l]), lo_ = umin_(x[i], x[l]); x[i] = lo_; x[l] = hi_; } while (0)
__device__ __forceinline__ void sort16(unsigned (&x)[16]) {
#pragma unroll
    for (int p = 1; p < 16; p <<= 1)
#pragma unroll
        for (int k = p; k >= 1; k >>= 1)
#pragma unroll
            for (int j = k % p; j <= 15 - k; j += 2 * k)
#pragma unroll
                for (int i = 0; i <= ((k - 1) < (15 - j - k) ? (k - 1) : (15 - j - k)); ++i)
                    if ((i + j) / (2 * p) == (i + j + k) / (2 * p)) RB_CE(x, i + j, i + j + k);
}
__device__ __forceinline__ void bmerge16(unsigned (&x)[16]) {
#pragma unroll
    for (int j = 8; j > 0; j >>= 1)
#pragma unroll
        for (int i = 0; i < 16; ++i) { const int l = i ^ j; if (l > i) RB_CE(x, i, l); }
}
__device__ __forceinline__ void mergetop(unsigned (&a)[16], const unsigned (&b)[16]) {
#pragma unroll
    for (int i = 0; i < 16; ++i) a[i] = umax_(a[i], b[15 - i]);
    bmerge16(a);
}
__device__ __forceinline__ void xmergetop(unsigned (&a)[16], int mask) {
    unsigned b[16];
#pragma unroll
    for (int i = 0; i < 16; ++i) b[i] = (unsigned)__shfl_xor((int)a[i], mask);
    mergetop(a, b);
}
__device__ __forceinline__ unsigned cand(float fa, float fb, int i, int j) { return (ordf(fa + fb) & ~0xFFu) | (unsigned)(255 - (i * 16 + j)); }

struct StrideTiles { int first, step, n; __device__ __forceinline__ int count() const { return n; } __device__ __forceinline__ int at(int k) const { return first + k * step; } };
struct PanelTiles { int pm0, pm1; __device__ __forceinline__ int count() const { return 4; } __device__ __forceinline__ int at(int k) const { return 2 * ((k >> 1) ? pm1 : pm0) + (k & 1); } };
template <class ST, class TT> __device__ __forceinline__ void route_phase(RB_LAS unsigned char* lds, const unsigned short* PQ, const unsigned short* SUBK, unsigned short* IDS, float* GATES, int h, const TT& tts, ST& st, bool drain) {
    const int tid = threadIdx.x, lane = tid & 63, n = lane & 15, g = lane >> 4; const int wid = __builtin_amdgcn_readfirstlane(tid >> 6);
    RB_LAS unsigned char* sub = lds + SUB_OFF; RB_LAS unsigned* lst = (RB_LAS unsigned*)(lds + LIST_OFF + wid * 2048) + n * 32;
    __syncthreads();
#pragma unroll
    for (int i = 0; i < 8; ++i) { const int off = (wid * 8 + i) * 1024 + lane * 16, R = off >> 8, c = (off >> 4) & 15, sc = c ^ (R & 15);
        __builtin_amdgcn_global_load_lds((const unsigned*)(SUBK + ((size_t)h * 256 + R) * 128 + 8 * sc), (RB_LAS unsigned*)(sub + (wid * 8 + i) * 1024), 16, 0, 0); }
    asm volatile("s_waitcnt vmcnt(0)" ::: "memory");
    __syncthreads();
    for (int ti = 0; ti < tts.count(); ++ti) { const int tt = tts.at(ti);
        const int t = tt * 128 + wid * 16 + n;
        bf16x8 qf[8];
        { const unsigned short* qrow = PQ + (size_t)t * 2048 + h * 256 + 8 * g;
#pragma unroll
          for (int ks = 0; ks < 8; ++ks) qf[ks] = *(const bf16x8*)(qrow + 32 * ks); }
        unsigned key[2][2][16];
#pragma unroll
        for (int p = 0; p < 2; ++p)
#pragma unroll
            for (int kblk = 0; kblk < 8; ++kblk) { const int R = p * 128 + 16 * kblk + n; f32x4 s = (f32x4){0.f, 0.f, 0.f, 0.f};
#pragma unroll
                for (int ks = 0; ks < 4; ++ks) { const bf16x8 kf = *(const RB_LAS bf16x8*)(sub + R * 256 + (((4 * ks + g) ^ (R & 15)) << 4));
                    s = __builtin_amdgcn_mfma_f32_16x16x32_bf16(kf, qf[p * 4 + ks], s, 0, 0, 0); }
#pragma unroll
                for (int r = 0; r < 4; ++r) key[p][kblk >> 2][(kblk & 3) * 4 + r] = (ordf(s[r]) & ~0x7Fu) | (unsigned)(127 - (16 * kblk + 4 * g + r)); }
        const bool shave = st.k < st.count; if (shave) st.issue(st.k);
        unsigned top[2][16];
#pragma unroll
        for (int p = 0; p < 2; ++p) {
            sort16(key[p][0]); sort16(key[p][1]); mergetop(key[p][0], key[p][1]); xmergetop(key[p][0], 16); xmergetop(key[p][0], 32);
#pragma unroll
            for (int i = 0; i < 16; ++i) top[p][i] = key[p][0][i];
        }
#pragma unroll
        for (int r = 0; r < 4; ++r) { const unsigned va = g == 0 ? top[0][r] : g == 1 ? top[0][4 + r] : g == 2 ? top[0][8 + r] : top[0][12 + r];
            const unsigned vb = g == 0 ? top[1][r] : g == 1 ? top[1][4 + r] : g == 2 ? top[1][8 + r] : top[1][12 + r]; lst[4 * g + r] = va; lst[16 + 4 * g + r] = vb; }
        float fa[16], fb[16];
#pragma unroll
        for (int i = 0; i < 16; ++i) { fa[i] = unordf(top[0][i] & ~0x7Fu); fb[i] = unordf(top[1][i] & ~0x7Fu); }
        unsigned c[16];
#pragma unroll
        for (int i = 0; i < 16; ++i) c[i] = 0xFF800000u;
        if (g == 0) {
#pragma unroll
            for (int j = 0; j < 16; ++j) c[j] = cand(fa[0], fb[j], 0, j);
        } else if (g == 1) {
#pragma unroll
            for (int j = 0; j < 8; ++j) c[j] = cand(fa[1], fb[j], 1, j);
#pragma unroll
            for (int j = 0; j < 3; ++j) c[8 + j] = cand(fa[4], fb[j], 4, j);
            c[11] = cand(fa[8], fb[0], 8, 0); c[12] = cand(fa[9], fb[0], 9, 0); c[13] = cand(fa[10], fb[0], 10, 0);
        } else if (g == 2) {
#pragma unroll
            for (int j = 0; j < 5; ++j) c[j] = cand(fa[2], fb[j], 2, j);
#pragma unroll
            for (int j = 0; j < 4; ++j) c[5 + j] = cand(fa[3], fb[j], 3, j);
#pragma unroll
            for (int i = 11; i < 16; ++i) c[9 + (i - 11)] = cand(fa[i], fb[0], i, 0);
        } else {
#pragma unroll
            for (int i = 5; i < 8; ++i) { c[2 * (i - 5)] = cand(fa[i], fb[0], i, 0); c[2 * (i - 5) + 1] = cand(fa[i], fb[1], i, 1); }
        }
        sort16(c); xmergetop(c, 16); xmergetop(c, 32);
        const float mxs = unordf(c[0] & ~0xFFu);
        asm volatile("s_waitcnt lgkmcnt(0)" ::: "memory");
        unsigned ids[4]; float pe[4]; float ls = 0.f;
#pragma unroll
        for (int r = 0; r < 4; ++r) { const unsigned key = g == 0 ? c[r] : g == 1 ? c[4 + r] : g == 2 ? c[8 + r] : c[12 + r]; const int pos = 255 - (int)(key & 0xFFu);
            const unsigned ka_ = lst[pos >> 4], kb_ = lst[16 + (pos & 15)];
            ids[r] = (127u - (ka_ & 0x7Fu)) * 128u + (127u - (kb_ & 0x7Fu));
            const float sv = unordf(ka_ & ~0x7Fu) + unordf(kb_ & ~0x7Fu); pe[r] = __builtin_amdgcn_exp2f((sv - mxs) * 1.4426950408889634f); ls += pe[r]; }
        ls += __shfl_xor(ls, 16); ls += __shfl_xor(ls, 32);
        const float linv = 1.0f / ls;
#pragma unroll
        for (int r = 0; r < 4; ++r) { const int k = 4 * g + r; IDS[(size_t)t * 128 + (k & 7) * 16 + 2 * h + (k >> 3)] = (unsigned short)ids[r]; }
        *(f32x4*)(GATES + (size_t)t * 128 + h * 16 + 4 * g) = (f32x4){pe[0] * linv, pe[1] * linv, pe[2] * linv, pe[3] * linv};
        asm volatile("s_waitcnt lgkmcnt(0)" ::: "memory");
        if (shave) { st.finish(st.k); ++st.k; }
    }
    __syncthreads();
    if (drain && st.k < st.count) {
        RB_LAS unsigned char* const bA = st.buf; RB_LAS unsigned char* const sA = st.sbuf; RB_LAS unsigned char* const bB = lds + SUB_OFF + wid * 8192; RB_LAS unsigned char* const sB = lds + LIST_OFF + wid * 256;
        st.issue(st.k);
        for (int par = 0; st.k < st.count; ++st.k, par ^= 1) {
            if (st.k + 1 < st.count) { st.buf = par ? bA : bB; st.sbuf = par ? sA : sB; st.issue(st.k + 1); if (st.item_of(st.k + 1) < 16384) asm volatile("s_waitcnt vmcnt(4)" ::: "memory"); else asm volatile("s_waitcnt vmcnt(9)" ::: "memory"); } else asm volatile("s_waitcnt vmcnt(0)" ::: "memory");
            st.buf = par ? bB : bA; st.sbuf = par ? sB : sA; st.template finish<false>(st.k); }
        st.buf = bA; st.sbuf = sA; }
    __syncthreads();
}
#undef RB_CE
#undef RB_CEA
#undef RB_LAS
}

namespace lru_body {
typedef short bf16x8 __attribute__((ext_vector_type(8)));
typedef float f32x4 __attribute__((ext_vector_type(4)));
typedef unsigned u32x4 __attribute__((ext_vector_type(4)));
#define LB_LAS __attribute__((address_space(3)))
#define LB_BAR() asm volatile("s_waitcnt lgkmcnt(0)\n\ts_barrier" ::: "memory")
#define LB_LDSWAIT() do { asm volatile("s_waitcnt lgkmcnt(0)" ::: "memory"); __builtin_amdgcn_sched_barrier(0); } while (0)
constexpr int XS_OFF = 0  , XC_OFF = 17408  , WT_OFF = 33792  , RI_OFF = 50176  , EX_OFF = 119808  , LDS_BYTES = 123904;
constexpr int RSTR = 68;
__device__ __forceinline__ float bf(unsigned short b) { return __uint_as_float(((unsigned)b) << 16); }
__device__ __forceinline__ float sigm(float v) { return __builtin_amdgcn_rcpf(1.0f + __builtin_amdgcn_exp2f(-1.4426950408889634f * v)); }
__device__ __forceinline__ float gelu_as(float v) {
    const float av = fabsf(v), t = __builtin_amdgcn_rcpf(1.0f + 0.2316418882f * av);
    float q = t * 0.5307027145f + (-0.7265760135f); q = q * t + 0.7107068705f; q = q * t + (-0.142248368f); q = q * t + 0.127414796f; q = q * t;
    const float e = __builtin_amdgcn_exp2f(v * v * (-0.72134752044f)); const float m = v * (q * e); return v < 0.f ? m : v - m;
}
typedef float f32x2 __attribute__((ext_vector_type(2)));
__device__ __forceinline__ f32x2 exp2_2(f32x2 v) { return (f32x2){__builtin_amdgcn_exp2f(v.x), __builtin_amdgcn_exp2f(v.y)}; }
__device__ __forceinline__ f32x2 rcp_2(f32x2 v) { return (f32x2){__builtin_amdgcn_rcpf(v.x), __builtin_amdgcn_rcpf(v.y)}; }
__device__ __forceinline__ f32x2 sqrt_2(f32x2 v) { return (f32x2){__builtin_amdgcn_sqrtf(v.x), __builtin_amdgcn_sqrtf(v.y)}; }
__device__ __forceinline__ f32x2 splat2(float v) { return (f32x2){v, v}; }
__device__ __forceinline__ f32x2 gelu_as2(f32x2 v) {
    const f32x2 av = (f32x2){fabsf(v.x), fabsf(v.y)}, t = rcp_2(splat2(1.0f) + splat2(0.2316418882f) * av);
    f32x2 q = t * splat2(0.5307027145f) + splat2(-0.7265760135f); q = q * t + splat2(0.7107068705f); q = q * t + splat2(-0.142248368f); q = q * t + splat2(0.127414796f); q = q * t;
    const f32x2 e = exp2_2(v * v * splat2(-0.72134752044f)); const f32x2 m = v * (q * e); const f32x2 d = v - m;
    return (f32x2){v.x < 0.f ? m.x : d.x, v.y < 0.f ? m.y : d.y};
}
__device__ __forceinline__ void lru_item(LB_LAS unsigned char* lds, int b, int blk, const unsigned short* PROJ, unsigned short* MIXED, float* SSL, const float* conv_w, const float* conv_b, const float* wa, const float* ba_, const float* wx,
                                         const float* bx_, const float* lam) {
    int tid_ = threadIdx.x; asm volatile("" : "+v"(tid_)); const int tid = tid_, c = tid & 63, n = tid & 15, g = (tid >> 4) & 3; const int s = __builtin_amdgcn_readfirstlane(tid >> 6);
    const int cb = blk * 64;
    LB_LAS unsigned short* XS = (LB_LAS unsigned short*)(lds + XS_OFF); LB_LAS unsigned char* XC = lds + XC_OFF; LB_LAS unsigned char* WT = lds + WT_OFF;
    LB_LAS float* RI = (LB_LAS float*)(lds + RI_OFF); LB_LAS float* EX = (LB_LAS float*)(lds + EX_OFF);
    __syncthreads();
    for (int i = tid; i < 2 * 4096; i += 512) { const int mat = i >> 12, d = (i >> 6) & 63, e = i & 63; const float v = (mat ? wx : wa)[(size_t)(blk * 64 + d) * 64 + e];
        *(LB_LAS unsigned short*)(WT + mat * 8192 + e * 128 + ((((d >> 3) ^ ((e >> 1) & 7))) << 4) + (d & 7) * 2) = (unsigned short)f2bf(v); }
    const float w0 = conv_w[0 * 512 + cb + c], w1 = conv_w[1 * 512 + cb + c], w2 = conv_w[2 * 512 + cb + c], w3 = conv_w[3 * 512 + cb + c], cbias = conv_b[cb + c];
    const float ba = ba_[cb + c], bx = bx_[cb + c], sp8 = 8.0f * log1pf(expf(-lam[cb + c]));
    const size_t tbase = (size_t)b * 2048;
    u32x4 xv[3];
#define LB_XLOAD(T0) do { _Pragma("unroll") for (int p_ = 0; p_ < 3; ++p_) { const int idx_ = tid + 512 * p_, row_ = idx_ >> 3, ch_ = idx_ & 7; const long tok_ = (long)(T0) - 3 + row_; \
        xv[p_] = (u32x4){0u, 0u, 0u, 0u}; if (row_ < 131 && tok_ >= 0) xv[p_] = *(const u32x4*)(PROJ + (tbase + tok_) * 2560 + cb + 8 * ch_); } } while (0)
#define LB_XSTORE() do { _Pragma("unroll") for (int p_ = 0; p_ < 3; ++p_) { const int idx_ = tid + 512 * p_, row_ = idx_ >> 3, ch_ = idx_ & 7; if (row_ < 131) *(LB_LAS u32x4*)(XS + row_ * 64 + 8 * ch_) = xv[p_]; } } while (0)
    LB_XLOAD(0); LB_XSTORE();
    float carry = 0.f;
    for (int k = 0; k < 16; ++k) {
        const int T0 = 128 * k;
        LB_BAR();
        unsigned short gt[16];
#pragma unroll
        for (int i = 0; i < 16; ++i) gt[i] = PROJ[(tbase + T0 + 16 * s + i) * 2560 + 512 + cb + c];
        float xc[16];
        { float xs[19];
          unsigned short xr[19];
#pragma unroll
          for (int j = 0; j < 19; ++j) xr[j] = XS[(16 * s + j) * 64 + c];
          LB_LDSWAIT();
#pragma unroll
          for (int j = 0; j < 19; ++j) xs[j] = bf(xr[j]);
#pragma unroll
          for (int i = 0; i < 16; i += 2) { const f32x2 r = splat2(cbias) + splat2(w0) * (f32x2){xs[i], xs[i + 1]} + splat2(w1) * (f32x2){xs[i + 1], xs[i + 2]} + splat2(w2) * (f32x2){xs[i + 2], xs[i + 3]} + splat2(w3) * (f32x2){xs[i + 3], xs[i + 4]};
              xc[i] = r.x; xc[i + 1] = r.y; const unsigned w = pg8::cvt_pk_bf16(r.x, r.y); const int tok = 16 * s + i;
              *(LB_LAS unsigned short*)(XC + tok * 128 + ((((c >> 3) ^ ((tok >> 1) & 7))) << 4) + (c & 7) * 2) = (unsigned short)w;
              *(LB_LAS unsigned short*)(XC + (tok + 1) * 128 + ((((c >> 3) ^ ((tok >> 1) & 7))) << 4) + (c & 7) * 2) = (unsigned short)(w >> 16); } }
        LB_BAR();
        if (k + 1 < 16) LB_XLOAD(T0 + 128);
        { bf16x8 af[2], wf[2][4][2]; f32x4 acc[2][4];
#pragma unroll
          for (int ks = 0; ks < 2; ++ks) { const int row = 16 * s + n; af[ks] = *(const LB_LAS bf16x8*)(XC + row * 128 + (((4 * ks + g) ^ ((row >> 1) & 7)) << 4)); }
#pragma unroll
          for (int mat = 0; mat < 2; ++mat)
#pragma unroll
            for (int nt = 0; nt < 4; ++nt)
#pragma unroll
                for (int ks = 0; ks < 2; ++ks) { const int row = 16 * nt + n; wf[mat][nt][ks] = *(const LB_LAS bf16x8*)(WT + mat * 8192 + row * 128 + (((4 * ks + g) ^ ((row >> 1) & 7)) << 4)); }
#pragma unroll
          for (int mat = 0; mat < 2; ++mat)
#pragma unroll
            for (int nt = 0; nt < 4; ++nt) { acc[mat][nt] = __builtin_amdgcn_mfma_f32_16x16x32_bf16(af[0], wf[mat][nt][0], (f32x4){0.f, 0.f, 0.f, 0.f}, 0, 0, 0);
                acc[mat][nt] = __builtin_amdgcn_mfma_f32_16x16x32_bf16(af[1], wf[mat][nt][1], acc[mat][nt], 0, 0, 0); }
#pragma unroll
          for (int mat = 0; mat < 2; ++mat)
#pragma unroll
            for (int nt = 0; nt < 4; ++nt)
#pragma unroll
                for (int r = 0; r < 4; ++r) RI[mat * 128 * RSTR + (16 * s + 4 * g + r) * RSTR + 16 * nt + n] = acc[mat][nt][r]; }
        LB_BAR();
        float av[16], bv[16]; float A = 1.f, B = 0.f;
        { float pr[16], pi[16];
#pragma unroll
          for (int i = 0; i < 16; ++i) { const int tok = 16 * s + i; pr[i] = RI[tok * RSTR + c]; pi[i] = RI[128 * RSTR + tok * RSTR + c]; }
          LB_LDSWAIT();
          const f32x2 nl2 = splat2(-1.4426950408889634f), one2 = splat2(1.0f), nsp2 = splat2(-1.4426950408889634f * sp8);
#pragma unroll
          for (int i = 0; i < 16; i += 2) {
            const f32x2 gr = rcp_2(one2 + exp2_2(nl2 * ((f32x2){pr[i], pr[i + 1]} + splat2(ba)))), gi = rcp_2(one2 + exp2_2(nl2 * ((f32x2){pi[i], pi[i + 1]} + splat2(bx))));
            const f32x2 a = exp2_2(nsp2 * gr); f32x2 om = one2 - a * a; om = (f32x2){fmaxf(om.x, 0.f), fmaxf(om.y, 0.f)};
            const f32x2 b = sqrt_2(om) * (gi * (f32x2){xc[i], xc[i + 1]});
            av[i] = a.x; av[i + 1] = a.y; bv[i] = b.x; bv[i + 1] = b.y; A *= a.x; B = a.x * B + b.x; A *= a.y; B = a.y * B + b.y; } }
        EX[(s * 64 + c) * 2] = A; EX[(s * 64 + c) * 2 + 1] = B;
        LB_BAR();
        float hin = carry, hall = carry;
        { float ea[8], eb[8];
#pragma unroll
          for (int w = 0; w < 8; ++w) { ea[w] = EX[(w * 64 + c) * 2]; eb[w] = EX[(w * 64 + c) * 2 + 1]; }
          LB_LDSWAIT();
#pragma unroll
          for (int w = 0; w < 8; ++w) { hall = ea[w] * hall + eb[w]; if (w < s) hin = hall; } }
        carry = hall;
        float h = hin;
        float sq[16];
#pragma unroll
        for (int i = 0; i < 16; i += 2) { const float h0 = av[i] * h + bv[i]; h = av[i + 1] * h0 + bv[i + 1];
            const f32x2 y = (f32x2){h0, h} * gelu_as2((f32x2){bf(gt[i]), bf(gt[i + 1])}); const unsigned w = pg8::cvt_pk_bf16(y.x, y.y);
            MIXED[(tbase + T0 + 16 * s + i) * 1024 + cb + c] = (unsigned short)w; MIXED[(tbase + T0 + 16 * s + i + 1) * 1024 + cb + c] = (unsigned short)(w >> 16);
            const f32x2 yf = (f32x2){__uint_as_float(w << 16), __uint_as_float(w & 0xffff0000u)}; const f32x2 q2 = yf * yf; sq[i] = q2.x; sq[i + 1] = q2.y; }
        {
          const bool h3 = (c & 8) != 0, h2 = (c & 4) != 0; float r8[8], r4[4], r2[2], r1;
#pragma unroll
          for (int i = 0; i < 8; ++i) r8[i] = swap32_add(sq[i], sq[i + 8]);
#pragma unroll
          for (int i = 0; i < 4; ++i) r4[i] = swap16_add(r8[i], r8[i + 4]);
#pragma unroll
          for (int i = 0; i < 2; ++i) { const float sa = r4[i] + dpp_f<DPP_ROR8>(r4[i]), sb = r4[i + 2] + dpp_f<DPP_ROR8>(r4[i + 2]); r2[i] = h3 ? sb : sa; }
          { const float sa = r2[0] + dpp_f<DPP_HMIRROR>(r2[0]), sb = r2[1] + dpp_f<DPP_HMIRROR>(r2[1]); r1 = h2 ? sb : sa; }
          r1 += dpp_f<DPP_XOR2>(r1); r1 += dpp_f<DPP_XOR1>(r1);
          if ((c & 3) == 0) SSL[(tbase + T0 + 16 * s + (c >> 2)) * 8 + blk] = r1; }
        if (k + 1 < 16) LB_XSTORE();
    }
    __syncthreads();
#undef LB_XLOAD
#undef LB_XSTORE
}
#undef LB_BAR
#undef LB_LDSWAIT
#undef LB_LAS
}

struct QuadSync { gu32* cnt; unsigned* bar; unsigned gen; unsigned n; bool local; };
__device__ __forceinline__ void quad_sync(QuadSync& q) {
    asm volatile("s_waitcnt vmcnt(0)" ::: "memory");
    __syncthreads();
    ++q.gen;
    if (threadIdx.x == 0) {
        if (!q.local) { __builtin_amdgcn_fence(__ATOMIC_RELEASE, "agent"); asm volatile("s_waitcnt vmcnt(0)" ::: "memory"); }
        __hip_atomic_fetch_add(q.cnt, 1u, RLX_AGENT);
        const unsigned want = q.n * q.gen;
        XB_SPIN(xb_ld((unsigned*)q.cnt) < want, q.bar);
        __builtin_amdgcn_fence(__ATOMIC_ACQUIRE, "agent");
        asm volatile("s_waitcnt vmcnt(0)" ::: "memory");
    }
    __syncthreads();
}
struct QuadOrder { pg8::StaticOrder S;
    __device__ __forceinline__ bool next(int i, pg8::Unit& u) const { pg8::Unit v; if (!S.next(i >> 1, v)) return false; u.pm = v.pm; u.pn = 2 * v.pn + (i & 1); return true; }
    __device__ __forceinline__ void a_ready(const pg8::Unit&) const {}
    __device__ __forceinline__ void done(const pg8::Unit&) const {}
};
constexpr int NPHASE = 12;
#ifndef MK_ONE_LAUNCH
#define MK_ONE_LAUNCH 1
#endif
struct Args { const float* in[26]; float* out; unsigned char* ws; int ph_lo, ph_hi; };
__global__ void __launch_bounds__(NWAVES * 64, 2) mk_fwd(Args args) {
    extern __shared__ __attribute__((aligned(16))) unsigned char lds[];
    Frame F;
    F.lds = (LAS unsigned char*)lds;
    F.MISC = (volatile LAS unsigned*)(F.lds + MISC_OFF);
    F.tid = threadIdx.x; F.lane = F.tid & 63; F.wave = __builtin_amdgcn_readfirstlane(F.tid >> 6);
    F.G = gridDim.x; { const int bx = blockIdx.x; F.vcu = (F.G % 8 == 0) ? (bx % 8) * (F.G / 8) + bx / 8 : bx; }
    F.ws = args.ws; F.out = args.out; F.ctl = (gu32*)(args.ws + WS_CTL);
#pragma unroll
    for (int i = 0; i < 26; ++i) F.in[i] = args.in[i];
    for (int u = F.tid; u < (LDS_BYTES - LDSCTL_OFF) / 4; u += NWAVES * 64) ((LAS unsigned*)(F.lds + LDSCTL_OFF))[u] = 0u;
    __syncthreads();
    const int lo = args.ph_lo, hi = args.ph_hi;
    if (threadIdx.x == 0) __hip_atomic_store(F.ctl + CW_XID + blockIdx.x, xb_xcc_id() + 1u, RLX_AGENT);
    XcdBarrier bar; bar.bar = (unsigned*)(F.ctl + CW_BAR); bar.x = 0; bar.st = nullptr;
    if (hi - lo > 1) bar = xcd_barrier_post((unsigned*)(F.ctl + CW_BAR), F.MISC + 8);
#define IN(k) (lo <= (k) && (k) < hi)
#define SEAM(k) do { if (IN(k) && IN((k) + 1)) xcd_barrier(bar); } while (0)
#define QSEAM(k) do { if (IN(k) && IN((k) + 1)) { if (quad) quad_sync(qs); else xcd_barrier(bar); } } while (0)
    const bool quad = (F.G == 256) && (hi - lo > 1); QuadSync qs; qs.cnt = F.ctl + CW_QUAD + 64 * (blockIdx.x & 63); qs.bar = (unsigned*)(F.ctl + CW_BAR); qs.gen = 0u; qs.n = 4u; qs.local = false;
    QuadSync gs; gs.cnt = F.ctl + CW_G32 + 64 * (blockIdx.x & 7); gs.bar = qs.bar; gs.gen = 0u; gs.n = 32u; gs.local = false;
#define GSEAM(k) do { if (IN(k) && IN((k) + 1)) { if (quad) quad_sync(gs); else xcd_barrier(bar); } } while (0)
    bf16* Win_t = (bf16*)(F.ws + WS_WIN); bf16* Wout_t = (bf16*)(F.ws + WS_WOUT); bf16* Wcq_t = (bf16*)(F.ws + WS_WCQ); bf16* Wckv_t = (bf16*)(F.ws + WS_WCKV);
    bf16* Wco_t = (bf16*)(F.ws + WS_WCO); bf16* Wpq_t = (bf16*)(F.ws + WS_WPQ);
    bf16* H = (bf16*)(F.ws + WS_A); bf16* X1 = (bf16*)(F.ws + WS_A); bf16* PROJ = (bf16*)(F.ws + WS_B); bf16* QC = (bf16*)(F.ws + WS_B); bf16* OC = (bf16*)(F.ws + WS_B + 64 * MiB);
    bf16* MIXED = (bf16*)(F.ws + WS_C); bf16* X2 = (bf16*)(F.ws + WS_C); bf16* MEMN = (bf16*)(F.ws + WS_MEMN); bf16* KCVC = (bf16*)(F.ws + WS_KCVC); bf16* PQ = (bf16*)(F.ws + WS_E);
    float* SS1 = (float*)(F.ws + WS_SS1); float* SS2 = (float*)(F.ws + WS_SS2);

    if (quad && lo < 1) { unsigned same = 1u; const unsigned x0 = xb_ld((unsigned*)(F.ctl + CW_XID + (blockIdx.x & 7)));
        for (int j = 1; j < 32; ++j) same &= (xb_ld((unsigned*)(F.ctl + CW_XID + (blockIdx.x & 7) + 8 * j)) == x0) ? 1u : 0u;
        gs.local = (same != 0u) && (x0 != 0u); }
    if (IN(0)) { p0_prologue(F, quad && IN(1));
        if (quad && IN(1)) { quad_sync(gs);
            if (threadIdx.x == 0) { XB_SPIN(xb_ld((unsigned*)(F.ctl + CW_WCNT)) < (unsigned)F.G, qs.bar); __builtin_amdgcn_fence(__ATOMIC_ACQUIRE, "agent"); asm volatile("s_waitcnt vmcnt(0)" ::: "memory"); }
            __syncthreads(); }
        else SEAM(0); }
#define STAG_SPLIT(k, n) int a0, a1; table_share(F, k, n, a0, a1); const int am = a0 + ((((int)blockIdx.x >> 3) & 3) * (a1 - a0) + 1) / 3
#define STAG_BEFORE(WHICH, k, n) do { STAG_SPLIT(k, n); if (am > a0) convert_rows<WHICH>(F, a0, am < a1 ? am : a1); } while (0)
#define STAG_AFTER(WHICH, k, n) do { STAG_SPLIT(k, n); if (am < a1) convert_rows<WHICH>(F, am, a1); } while (0)
    if (IN(1)) {
        STAG_BEFORE(0, 0, 1);
        { pg8::Gemm g{H, Win_t, T, DIN, D}; pg8::StaticOrder S; S.init(T, DIN, F.G, (int)blockIdx.x); pg8::EpiStore E{PROJ, DIN, 4, 6, attn_body::C2, (float*)(F.ws + WS_KMEAN)};
          pg8::gemm_phase<pg8::EpiStore, pg8::StaticOrder, true, true>(F.lds + RING_OFF, g, S, E); }
        STAG_AFTER(0, 0, 1);
        GSEAM(1);
    }
    if (IN(2)) {
        const attn_body::AttnTensors AT{(const attn_body::bf16*)(PROJ + COL_Q), (const attn_body::bf16*)(PROJ + COL_K), (const attn_body::bf16*)(PROJ + COL_V), (attn_body::bf16*)(MIXED + DLRU), (const float*)(F.ws + WS_KMEAN), (float*)(F.ws + WS_SSA)};
        for (int it = F.vcu; it < 2 * BATCH * AH; it += F.G) {
            if (it & 1) lru_body::lru_item(F.lds + RING_OFF, (it >> 1) / LBLK, (it >> 1) % LBLK, PROJ, MIXED, (float*)(F.ws + WS_SSL), F.in[4], F.in[5], F.in[6], F.in[7], F.in[8], F.in[9], F.in[10]);
            else { int gi = it >> 1;
                if (quad) { const int x = it >> 5, e = (it & 31) >> 1; gi = (e < 8) ? 4 * (2 * x + (e >> 2)) + (e & 3) : 64 + 16 * ((e - 8) & 3) + 2 * x + ((e - 8) >> 2); }
                if (gi < 64) { pg8::Gemm g{MEMN, Wckv_t, TM, D, D}; pg8::OneUnit S{gi >> 2, gi & 3, true}; pg8::EpiStore E{KCVC, D, 0, 0, 1.0f, nullptr};
                    pg8::gemm_phase<pg8::EpiStore, pg8::OneUnit, true, true>(F.lds + RING_OFF, g, S, E); }
                else { pg8::Gemm g{Wckv_t + (size_t)D * D, MEMN, D, TM, D}; pg8::OneUnit S{(gi - 64) >> 4, (gi - 64) & 15, true}; pg8::EpiStore E{KCVC + (size_t)TM * D, TM, 0, 0, 1.0f, nullptr};
                    pg8::gemm_phase<pg8::EpiStore, pg8::OneUnit, true, true>(F.lds + RING_OFF, g, S, E); } }
            attn_body::attn_item((char*)lds + RING_OFF, AT, it); }
        GSEAM(2); }
    if (quad && IN(3) && lo < 3) { unsigned same = 1u; const unsigned x0 = xb_ld((unsigned*)(F.ctl + CW_XID + (blockIdx.x & 63)));
#pragma unroll
        for (int j = 1; j < 4; ++j) same &= (xb_ld((unsigned*)(F.ctl + CW_XID + (blockIdx.x & 63) + 64 * j)) == x0) ? 1u : 0u;
        qs.local = (same != 0u) && (x0 != 0u); }
    if (IN(3)) { pg8::Gemm g{MIXED, Wout_t, T, D, D}; pg8::StaticOrder S; S.init(T, D, F.G, (int)blockIdx.x); pg8::EpiResidGN E{F.in[0], X1, SS1, (const float*)(F.ws + WS_SSL), (const float*)(F.ws + WS_SSA), D, EPS};
        pg8::gemm_phase<pg8::EpiResidGN, pg8::StaticOrder, true, true>(F.lds + RING_OFF, g, S, E); QSEAM(3); }
    if (IN(4)) {
        pg8::Gemm g{X1, Wcq_t, T, D, D}; pg8::StaticOrder S; S.init(T, D, F.G, (int)blockIdx.x); pg8::EpiScale E{SS1, QC, D, EPS};
        pg8::gemm_phase<pg8::EpiScale, pg8::StaticOrder, true, true>(F.lds + RING_OFF, g, S, E);
        __builtin_amdgcn_fence(__ATOMIC_ACQUIRE, "agent");
        { cross_body::bf16x8 qf[8]; int zz = 0; asm volatile("" : "+s"(zz)); bool first = true;
          for (int i = 0; ; ++i) { pg8::Unit u, un; if (!S.next(i, u)) break; const bool more = S.next(i + 1, un);
              const int b = u.pm >> 3, t0 = u.pm * 256;
              cross_body::cross_unit(F.lds + RING_OFF, QC, KCVC, KCVC + (size_t)TM * D, OC, b, u.pn, t0, qf, first, true, b, u.pn, t0 + 128, zz);
              cross_body::cross_unit(F.lds + RING_OFF, QC, KCVC, KCVC + (size_t)TM * D, OC, b, u.pn, t0 + 128, qf, false, more, un.pm >> 3, un.pn, un.pm * 256, zz);
              first = false; }
          asm volatile("s_waitcnt vmcnt(0) lgkmcnt(0)\n\ts_barrier" ::: "memory"); }
        QSEAM(4); }
    if (IN(5)) { pg8::Gemm g{OC, Wco_t, T, D, D}; pg8::StaticOrder S; S.init(T, D, F.G, (int)blockIdx.x); pg8::EpiResid E{nullptr, X1, X2, SS2, D};
        pg8::gemm_phase<pg8::EpiResid, pg8::StaticOrder, true, true>(F.lds + RING_OFF, g, S, E); QSEAM(5); }
    if (IN(6)) { pg8::Gemm g{X2, Wpq_t, T, 2048, D}; pg8::EpiScale E{SS2, PQ, 2048, EPS};
        if (quad) { QuadOrder S; S.S.init(T, D, F.G, (int)blockIdx.x); pg8::gemm_phase<pg8::EpiScale, QuadOrder, true, true>(F.lds + RING_OFF, g, S, E); }
        else { pg8::StaticOrder S; S.init(T, 2048, F.G, (int)blockIdx.x); pg8::gemm_phase<pg8::EpiScale, pg8::StaticOrder, true, true>(F.lds + RING_OFF, g, S, E); }
        SEAM(6); }
    if (IN(7)) { PeerStream st; st.k = 0; st.lane = F.lane; st.U = F.in[23]; st.V = F.in[24]; st.gf = F.in[20]; st.UQ = (signed char*)(F.ws + WS_UQ); st.SU = (float*)(F.ws + WS_SU); st.VQ = F.ws + WS_VQ;
        st.X2 = X2; st.SS2 = SS2; st.XQ = (signed char*)(F.ws + WS_XQ); st.HS = (float*)(F.ws + WS_HS); st.buf = F.lds + STREAM_OFF + F.wave * STREAM_WAVE_BYTES; st.sbuf = F.lds + STREAM_OFF + NWAVES * STREAM_WAVE_BYTES + F.wave * 256;
        if (quad) {
            pg8::StaticOrder S; S.init(T, D, F.G, (int)blockIdx.x); pg8::Unit u0, u1; S.next(0, u0); S.next(1, u1);
            st.local = true; st.count = 12; st.xb0 = 64 * u0.pm + 16 * u0.pn + 2 * F.wave; st.xb1 = 64 * u1.pm + 16 * u1.pn + 2 * F.wave; st.vbase = 64 * (int)blockIdx.x + F.wave; st.gbase = 0; st.gstep = 0;
            const route_body::PanelTiles tts{u0.pm, u1.pm};
            route_body::route_phase(F.lds + RING_OFF, PQ, (const bf16*)(F.ws + WS_SUBK), (unsigned short*)(F.ws + WS_IDS), (float*)(F.ws + WS_GATES), 2 * u0.pn, tts, st, false);
            route_body::route_phase(F.lds + RING_OFF, PQ, (const bf16*)(F.ws + WS_SUBK), (unsigned short*)(F.ws + WS_IDS), (float*)(F.ws + WS_GATES), 2 * u0.pn + 1, tts, st, true);
        } else { const int h = F.vcu & 7, rank = F.vcu >> 3, nrank = (F.G - h + 7) >> 3;
            st.local = false; st.gbase = F.vcu * 8 + F.wave; st.gstep = F.G * 8; st.count = (16384 + 8192 - st.gbase + st.gstep - 1) / st.gstep; st.xb0 = st.xb1 = st.vbase = 0;
            const route_body::StrideTiles tts{rank, nrank, (T / 128 - rank + nrank - 1) / nrank};
            route_body::route_phase(F.lds + RING_OFF, PQ, (const bf16*)(F.ws + WS_SUBK), (unsigned short*)(F.ws + WS_IDS), (float*)(F.ws + WS_GATES), h, tts, st, true); }
        SEAM(7); }
    if (IN(8)) { peer_u(F, hi - lo > 1); SEAM(8); }
    if (IN(9)) { peer_combine(F); SEAM(9); }
    if (IN(10)) { peer_v(F, hi - lo > 1); SEAM(10); }
    if (IN(11)) { final_norm(F); }
#undef IN
#undef SEAM
#undef QSEAM
#undef GSEAM
}

extern "C" void kernel_launch(void* const* d_in, const int* in_sizes, int n_in, void* d_out, int out_size, void* d_ws, size_t ws_size, hipStream_t stream) {
    static int grid = 0;
    if (grid == 0) {
        if (n_in != 26 || in_sizes[0] != T * D || out_size != T * D || ws_size < WS_END) { fprintf(stderr, "kernel_launch: unexpected shapes (n_in %d, in0 %d, out %d, ws %zu); nothing launched\n", n_in, n_in > 0 ? in_sizes[0] : -1, out_size, ws_size); grid = -1; return; }
        int dev = 0, cus = 0, per_cu = 0;
        if (hipGetDevice(&dev) != hipSuccess || hipDeviceGetAttribute(&cus, hipDeviceAttributeMultiprocessorCount, dev) != hipSuccess) { grid = -1; return; }
        if (hipFuncSetAttribute((const void*)mk_fwd, hipFuncAttributeMaxDynamicSharedMemorySize, LDS_BYTES) != hipSuccess) { fprintf(stderr, "kernel_launch: hipFuncSetAttribute failed\n"); grid = -1; return; }
        if (hipOccupancyMaxActiveBlocksPerMultiprocessor(&per_cu, (const void*)mk_fwd, NWAVES * 64, LDS_BYTES) != hipSuccess || per_cu < 1) fprintf(stderr, "kernel_launch: occupancy query reports %d\n", per_cu);
        (void)hipGetLastError();
        grid = cus;
    }
    if (grid < 0) return;
    (void)hipMemsetAsync((char*)d_ws + WS_CTL, 0, CTL_ZERO_BYTES, stream);
    Args a{};
    for (int i = 0; i < 26; ++i) a.in[i] = (const float*)d_in[i];
    a.out = (float*)d_out; a.ws = (unsigned char*)d_ws;
#if MK_ONE_LAUNCH
    a.ph_lo = 0; a.ph_hi = NPHASE;
    hipLaunchKernelGGL(mk_fwd, dim3(grid), dim3(NWAVES * 64), LDS_BYTES, stream, a);
#else
    for (int p = 0; p < NPHASE; ++p) { a.ph_lo = p; a.ph_hi = p + 1; hipLaunchKernelGGL(mk_fwd, dim3(grid), dim3(NWAVES * 64), LDS_BYTES, stream, a); }
#endif
}
```

```cpp
#include <hip/hip_runtime.h>
#include <cstdio>
#include <cstdint>
namespace pg8 {
#define PG8_LAS __attribute__((address_space(3)))
typedef unsigned short bf16_t;
typedef short bf16x8 __attribute__((ext_vector_type(8)));
typedef float f32x4 __attribute__((ext_vector_type(4)));
typedef unsigned u32x4 __attribute__((ext_vector_type(4)));
constexpr int BM = 256, BK = 64, HALF = 128, HTB = HALF * BK * 2  , STAGE_BYTES = 8 * HTB, NXCD = 8, WGM = 8;

__host__ __device__ __forceinline__ int lds_byte(int r, int c) { const int st = (r >> 4) * 2 + (c >> 5), rr = r & 15, cc = c & 31, ob = rr * 64 + cc * 2; return st * 1024 + (ob ^ (((ob >> 9) & 1) << 5)); }
__host__ __device__ __forceinline__ void stage_rc(int b, int& R, int& C) { const int st = b / 1024, sb = b % 1024, swz = sb ^ (((sb >> 9) & 1) << 5); R = (st >> 1) * 16 + swz / 64; C = (st & 1) * 32 + (swz % 64) / 2; }
__host__ __device__ __forceinline__ int perm32(int rho) { const int n = rho >> 4, i = rho & 15; return 8 * (i >> 2) + 4 * n + (i & 3); }

struct Unit { int pm, pn; };
struct Gemm { const bf16_t* A; const bf16_t* Bt; int M, N, K; };

struct StaticOrder {
    int nM, nN, nwg, G, c;
    __host__ __device__ __forceinline__ void init(int M, int N, int G_, int c_) { nM = M / BM; nN = N / BM; nwg = nM * nN; G = G_; c = c_; }
    __host__ __device__ __forceinline__ bool next(int i, Unit& u) const {
        const long L = (long)i * G + c; if (L >= nwg) return false;
        int wgid = (int)L; { const int q = nwg / NXCD, r = nwg % NXCD, xcd = wgid % NXCD, off = wgid / NXCD; wgid = (xcd < r ? xcd * (q + 1) : r * (q + 1) + (xcd - r) * q) + off; }
        const int nig = WGM * nN, gid = wgid / nig, fm = gid * WGM, gsz = (nM - fm) < WGM ? (nM - fm) : WGM;
        u.pm = fm + ((wgid % nig) % gsz); u.pn = (wgid % nig) / gsz; return true;
    }
    __device__ __forceinline__ void a_ready(const Unit&) const {}
    __device__ __forceinline__ void done(const Unit&) const {}
};
struct OneUnit { int pm, pn; bool have;
    __device__ __forceinline__ bool next(int i, Unit& u) const { if (i != 0 || !have) return false; u.pm = pm; u.pn = pn; return true; }
    __device__ __forceinline__ void a_ready(const Unit&) const {}
    __device__ __forceinline__ void done(const Unit&) const {}
};
__device__ __forceinline__ unsigned cvt_pk_bf16(float lo, float hi) { unsigned r; asm volatile("v_cvt_pk_bf16_f32 %0, %1, %2" : "=v"(r) : "v"(lo), "v"(hi)); return r; }
typedef float f32x2 __attribute__((ext_vector_type(2)));
template <int CTRL> __device__ __forceinline__ float dppf(float x) { return __int_as_float(__builtin_amdgcn_update_dpp(0, __float_as_int(x), CTRL, 0xf, 0xf, true)); }
struct EpiStore {
    static constexpr bool PERM = true, AFTER_DRAIN = false, MIDK = false;
    bf16_t* O; int ldc; int slo, shi; float scale; float* KMP;
    int glo = 0, ghi = 0;
    static __device__ __forceinline__ float gelu_as(float v) {
        const float av = fabsf(v), t = __builtin_amdgcn_rcpf(1.0f + 0.2316418882f * av);
        float q = t * 0.5307027145f + (-0.7265760135f); q = q * t + 0.7107068705f; q = q * t + (-0.142248368f); q = q * t + 0.127414796f; q = q * t;
        const float e = __builtin_amdgcn_exp2f(v * v * (-0.72134752044f)); const float m = v * (q * e); return v < 0.f ? m : v - m; }
    __device__ __forceinline__ void operator()(const f32x4 (&acc)[2][2][4][2], const Unit& u, int wr, int wc, int fr, int fq) const {
        const int row0 = u.pm * BM + wr * 64 + fr, col0 = u.pn * BM + wc * 32 + 8 * fq; const float sc = (u.pn >= slo && u.pn < shi) ? scale : 1.0f; const bool gel = u.pn >= glo && u.pn < ghi;
#pragma unroll
        for (int ai = 0; ai < 2; ++ai)
#pragma unroll
            for (int m = 0; m < 4; ++m) { bf16_t* rowp = O + (size_t)(row0 + ai * HALF + m * 16) * ldc + col0;
#pragma unroll
                for (int bj = 0; bj < 2; ++bj) { f32x4 v0 = acc[ai][bj][m][0] * sc, v1 = acc[ai][bj][m][1] * sc;
                    if (gel) {
#pragma unroll
                        for (int e = 0; e < 4; ++e) { v0[e] = gelu_as(v0[e]); v1[e] = gelu_as(v1[e]); } }
                    u32x4 w; w.x = cvt_pk_bf16(v0[0], v0[1]); w.y = cvt_pk_bf16(v0[2], v0[3]); w.z = cvt_pk_bf16(v1[0], v1[1]); w.w = cvt_pk_bf16(v1[2], v1[3]);
                    *(u32x4*)(rowp + bj * HALF) = w; } }
        if (KMP != nullptr && (u.pn == 6 || u.pn == 7)) {
            float cs[16];
#pragma unroll
            for (int bj = 0; bj < 2; ++bj)
#pragma unroll
                for (int n = 0; n < 2; ++n)
#pragma unroll
                    for (int e = 0; e < 4; ++e) { float a = 0.f;
#pragma unroll
                        for (int ai = 0; ai < 2; ++ai)
#pragma unroll
                            for (int m = 0; m < 4; ++m) a += acc[ai][bj][m][n][e];
                        cs[bj * 8 + n * 4 + e] = a; }
            const bool b3 = (fr & 8) != 0, b2 = (fr & 4) != 0, b1 = (fr & 2) != 0, b0 = (fr & 1) != 0; float r8[8], r4[4], r2[2], r1;
#pragma unroll
            for (int i = 0; i < 8; ++i) { const float sa = cs[i] + dppf<0x128>(cs[i]), sb = cs[i + 8] + dppf<0x128>(cs[i + 8]); r8[i] = b3 ? sb : sa; }
#pragma unroll
            for (int i = 0; i < 4; ++i) { const float sa = r8[i] + dppf<0x141>(r8[i]), sb = r8[i + 4] + dppf<0x141>(r8[i + 4]); r4[i] = b2 ? sb : sa; }
#pragma unroll
            for (int i = 0; i < 2; ++i) { const float sa = r4[i] + dppf<0x4E>(r4[i]), sb = r4[i + 2] + dppf<0x4E>(r4[i + 2]); r2[i] = b1 ? sb : sa; }
            { const float sa = r2[0] + dppf<0xB1>(r2[0]), sb = r2[1] + dppf<0xB1>(r2[1]); r1 = b0 ? sb : sa; }
            const int cg = (u.pn - 6) * 256 + 128 * (fr >> 3) + 32 * wc + 8 * fq + (fr & 7);
            KMP[((((size_t)wr * 16 + (u.pm >> 3)) * 8 + (cg >> 6)) * 8 + (u.pm & 7)) * 64 + (cg & 63)] = r1;
        }
    }
};
__device__ __forceinline__ float bfl(unsigned w) { return __uint_as_float(w << 16); }
__device__ __forceinline__ float bfh(unsigned w) { return __uint_as_float(w & 0xffff0000u); }
struct EpiResid {
    static constexpr bool PERM = true, AFTER_DRAIN = false, MIDK = false;
    const float* resf; const bf16_t* resb; bf16_t* O; float* SS; int ldc;
    __device__ __forceinline__ void operator()(const f32x4 (&acc)[2][2][4][2], const Unit& u, int wr, int wc, int fr, int fq) const {
        const int row0 = u.pm * BM + wr * 64 + fr, col0 = u.pn * BM + wc * 32 + 8 * fq; float ssv[2][4];
#pragma unroll
        for (int ai = 0; ai < 2; ++ai) {
            u32x4 rb[4][2];
            if (!resf) {
#pragma unroll
                for (int m = 0; m < 4; ++m)
#pragma unroll
                    for (int bj = 0; bj < 2; ++bj) rb[m][bj] = *(const u32x4*)(resb + (size_t)(row0 + ai * HALF + m * 16) * ldc + col0 + bj * HALF); }
#pragma unroll
            for (int m = 0; m < 4; ++m) { const int row = row0 + ai * HALF + m * 16; const size_t off = (size_t)row * ldc + col0; float ss = 0.f;
#pragma unroll
                for (int bj = 0; bj < 2; ++bj) { f32x4 v0 = acc[ai][bj][m][0], v1 = acc[ai][bj][m][1];
                    if (resf) { const f32x4 r0 = *(const f32x4*)(resf + off + bj * HALF), r1 = *(const f32x4*)(resf + off + bj * HALF + 4); v0 = v0 + r0; v1 = v1 + r1; }
                    else { const u32x4 r = rb[m][bj];
                        v0[0] += bfl(r.x); v0[1] += bfh(r.x); v0[2] += bfl(r.y); v0[3] += bfh(r.y); v1[0] += bfl(r.z); v1[1] += bfh(r.z); v1[2] += bfl(r.w); v1[3] += bfh(r.w); }
                    ss += (v0[0] * v0[0] + v0[1] * v0[1]) + (v0[2] * v0[2] + v0[3] * v0[3]) + (v1[0] * v1[0] + v1[1] * v1[1]) + (v1[2] * v1[2] + v1[3] * v1[3]);
                    u32x4 w; w.x = cvt_pk_bf16(v0[0], v0[1]); w.y = cvt_pk_bf16(v0[2], v0[3]); w.z = cvt_pk_bf16(v1[0], v1[1]); w.w = cvt_pk_bf16(v1[2], v1[3]);
                    *(u32x4*)(O + off + bj * HALF) = w; }
                ssv[ai][m] = ss; } }
#pragma unroll
        for (int ai = 0; ai < 2; ++ai)
#pragma unroll
            for (int m = 0; m < 4; ++m) ssv[ai][m] += __shfl_xor(ssv[ai][m], 16);
#pragma unroll
        for (int ai = 0; ai < 2; ++ai)
#pragma unroll
            for (int m = 0; m < 4; ++m) ssv[ai][m] += __shfl_xor(ssv[ai][m], 32);
        if (fq == 0) {
#pragma unroll
            for (int ai = 0; ai < 2; ++ai)
#pragma unroll
                for (int m = 0; m < 4; ++m) SS[(size_t)(row0 + ai * HALF + m * 16) * 16 + u.pn * 4 + wc] = ssv[ai][m]; }
    }
};
struct EpiScale {
    static constexpr bool PERM = true, AFTER_DRAIN = false, MIDK = false;
    const float* SS; bf16_t* O; int ldc; float eps;
    const PG8_LAS float* rsl = nullptr; int pm0 = 0;
    __device__ __forceinline__ void operator()(const f32x4 (&acc)[2][2][4][2], const Unit& u, int wr, int wc, int fr, int fq) const {
        const int row0 = u.pm * BM + wr * 64 + fr, col0 = u.pn * BM + wc * 32 + 8 * fq;
#pragma unroll
        for (int ai = 0; ai < 2; ++ai)
#pragma unroll
            for (int m = 0; m < 4; ++m) { const int row = row0 + ai * HALF + m * 16; bf16_t* rowp = O + (size_t)row * ldc + col0;
                float rs;
                if (rsl != nullptr) rs = rsl[((u.pm == pm0) ? 0 : 256) + wr * 64 + fr + ai * HALF + m * 16];
                else { const f32x4* sp = (const f32x4*)(SS + (size_t)row * 16); const f32x4 s0 = sp[0], s1 = sp[1], s2 = sp[2], s3 = sp[3];
                    const float tot = ((s0[0] + s0[1]) + (s0[2] + s0[3])) + ((s1[0] + s1[1]) + (s1[2] + s1[3])) + ((s2[0] + s2[1]) + (s2[2] + s2[3])) + ((s3[0] + s3[1]) + (s3[2] + s3[3]));
                    rs = 1.0f / sqrtf(tot * (1.0f / 1024.0f) + eps); }
#pragma unroll
                for (int bj = 0; bj < 2; ++bj) { const f32x4 v0 = acc[ai][bj][m][0] * rs, v1 = acc[ai][bj][m][1] * rs;
                    u32x4 w; w.x = cvt_pk_bf16(v0[0], v0[1]); w.y = cvt_pk_bf16(v0[2], v0[3]); w.z = cvt_pk_bf16(v1[0], v1[1]); w.w = cvt_pk_bf16(v1[2], v1[3]);
                    *(u32x4*)(rowp + bj * HALF) = w; } }
    }
};

struct EpiResidGN {
    static constexpr bool PERM = true, AFTER_DRAIN = false, MIDK = true;
    const float* resf; bf16_t* O; float* SS; const float* SSL; const float* SSA; int ldc; float eps;
    const PG8_LAS float* gn = nullptr; int pm0 = 0;
    __device__ __forceinline__ float rsum8(const float* p) const { const f32x4 a = *(const f32x4*)p, b = *(const f32x4*)(p + 4); return ((a[0] + a[1]) + (a[2] + a[3])) + ((b[0] + b[1]) + (b[2] + b[3])); }
    __device__ __forceinline__ void mid(f32x4 (&acc)[2][2][4][2], const Unit& u, int wr, int wc, int fr, int fq) const {
        int row0 = u.pm * BM + wr * 64 + fr; asm volatile("" : "+v"(row0));
#pragma unroll
        for (int ai = 0; ai < 2; ++ai)
#pragma unroll
            for (int m = 0; m < 4; ++m) { const int row = row0 + ai * HALF + m * 16;
                float ratio;
                if (gn != nullptr) ratio = gn[(((u.pm == pm0) ? 0 : 256) + wr * 64 + fr + ai * HALF + m * 16) * 2];
                else { const float rl = 1.0f / sqrtf(rsum8(SSL + (size_t)row * 8) * (1.0f / 512.0f) + eps), rh = 1.0f / sqrtf(rsum8(SSA + (size_t)row * 8) * (1.0f / 512.0f) + eps); ratio = rl / rh; }
#pragma unroll
                for (int bj = 0; bj < 2; ++bj) { acc[ai][bj][m][0] = acc[ai][bj][m][0] * ratio; acc[ai][bj][m][1] = acc[ai][bj][m][1] * ratio; }
                if (gn == nullptr) asm volatile("" ::: "memory"); }
    }
    __device__ __forceinline__ void operator()(const f32x4 (&acc)[2][2][4][2], const Unit& u, int wr, int wc, int fr, int fq) const {
        int row0 = u.pm * BM + wr * 64 + fr; asm volatile("" : "+v"(row0)); const int col0 = u.pn * BM + wc * 32 + 8 * fq; float ssv[2][4];
#pragma unroll
        for (int ai = 0; ai < 2; ++ai)
#pragma unroll
            for (int m = 0; m < 4; ++m) { const int row = row0 + ai * HALF + m * 16; const size_t off = (size_t)row * ldc + col0; float ss = 0.f;
                const float rh = (gn != nullptr) ? gn[(((u.pm == pm0) ? 0 : 256) + wr * 64 + fr + ai * HALF + m * 16) * 2 + 1] : 1.0f / sqrtf(rsum8(SSA + (size_t)row * 8) * (1.0f / 512.0f) + eps);
#pragma unroll
                for (int bj = 0; bj < 2; ++bj) { const f32x4 r0 = *(const f32x4*)(resf + off + bj * HALF), r1 = *(const f32x4*)(resf + off + bj * HALF + 4);
                    const f32x4 v0 = acc[ai][bj][m][0] * rh + r0, v1 = acc[ai][bj][m][1] * rh + r1;
                    ss += (v0[0] * v0[0] + v0[1] * v0[1]) + (v0[2] * v0[2] + v0[3] * v0[3]) + (v1[0] * v1[0] + v1[1] * v1[1]) + (v1[2] * v1[2] + v1[3] * v1[3]);
                    u32x4 w; w.x = cvt_pk_bf16(v0[0], v0[1]); w.y = cvt_pk_bf16(v0[2], v0[3]); w.z = cvt_pk_bf16(v1[0], v1[1]); w.w = cvt_pk_bf16(v1[2], v1[3]);
                    *(u32x4*)(O + off + bj * HALF) = w; }
                ssv[ai][m] = ss; }
#pragma unroll
        for (int ai = 0; ai < 2; ++ai)
#pragma unroll
            for (int m = 0; m < 4; ++m) ssv[ai][m] += __shfl_xor(ssv[ai][m], 16);
#pragma unroll
        for (int ai = 0; ai < 2; ++ai)
#pragma unroll
            for (int m = 0; m < 4; ++m) ssv[ai][m] += __shfl_xor(ssv[ai][m], 32);
        if (fq == 0) {
#pragma unroll
            for (int ai = 0; ai < 2; ++ai)
#pragma unroll
                for (int m = 0; m < 4; ++m) SS[(size_t)(row0 + ai * HALF + m * 16) * 16 + u.pn * 4 + wc] = ssv[ai][m]; }
    }
};

template <class Epi, class Sched, bool ALIGN_EPI = false, bool SP2 = false>
__device__ __forceinline__ void gemm_phase(PG8_LAS unsigned char* lds, const Gemm g, const Sched& S, const Epi& E) {
    const int tid = threadIdx.x, wid = __builtin_amdgcn_readfirstlane(tid >> 6), lane = tid & 63, wr = wid >> 2, wc = wid & 3, fr = lane & 15, fq = lane >> 4;
    const int K = g.K, nt = K / BK;
    unsigned voffA[2], voffB[2];
#pragma unroll
    for (int i = 0; i < 2; ++i) { int R, C; stage_rc(tid * 16 + i * 8192, R, C); const int Rb = Epi::PERM ? ((R & ~31) + perm32(R & 31)) : R;
        voffA[i] = (unsigned)(R * K + C) * 2u; voffB[i] = (unsigned)(Rb * K + C) * 2u; }
    const size_t kstep = (size_t)(BK * 2);
    const size_t hstep = (size_t)HALF * K * 2;
    const size_t tstep = 2 * hstep;
    const unsigned ldsw = (unsigned)wid * 1024u;
    const int aoff = lds_byte(wr * 64 + fr, fq * 8), boff = lds_byte(wc * 32 + fr, fq * 8);
#define PG8_SA(b, h) (((b) * 2 + (h)) * HTB)
#define PG8_SB(b, h) ((4 + (b) * 2 + (h)) * HTB)
#define PG8_STAGE(bufoff, gbase, voff) do { _Pragma("unroll") for (int _i = 0; _i < 2; ++_i) \
        __builtin_amdgcn_global_load_lds((const unsigned*)((const char*)(gbase) + (voff)[_i]), (PG8_LAS unsigned*)(lds + (bufoff) + ldsw + _i * 8192), 16, 0, 0); } while (0)
#define PG8_LDA(dst, b, h) do { _Pragma("unroll") for (int m = 0; m < 4; ++m) _Pragma("unroll") for (int k = 0; k < 2; ++k) dst[m][k] = *(const PG8_LAS bf16x8*)(lds + PG8_SA(b, h) + aoff + m * 2048 + k * 1024); } while (0)
#define PG8_LDB(dst, b, h) do { _Pragma("unroll") for (int n = 0; n < 2; ++n) _Pragma("unroll") for (int k = 0; k < 2; ++k) dst[n][k] = *(const PG8_LAS bf16x8*)(lds + PG8_SB(b, h) + boff + n * 2048 + k * 1024); } while (0)
#define PG8_MMA(ai, bj, At, Bt) do { __builtin_amdgcn_s_setprio(1); _Pragma("unroll") for (int m = 0; m < 4; ++m) _Pragma("unroll") for (int n = 0; n < 2; ++n) _Pragma("unroll") for (int k = 0; k < 2; ++k) \
        acc[ai][bj][m][n] = __builtin_amdgcn_mfma_f32_16x16x32_bf16(Bt[n][k], At[m][k], acc[ai][bj][m][n], 0, 0, 0); __builtin_amdgcn_s_setprio(0); } while (0)
#define PG8_WAIT_V(n) asm volatile("s_waitcnt vmcnt(" #n ")" ::: "memory")
#define PG8_WAIT_L(n) asm volatile("s_waitcnt lgkmcnt(" #n ")" ::: "memory")
#define PG8_BAR __builtin_amdgcn_s_barrier()
#define PG8_SCHED __builtin_amdgcn_sched_barrier(0)
    Unit cur, nxt; int ui = 0;
    if (!S.next(0, cur)) return;
    f32x4 acc[2][2][4][2];
#pragma unroll
    for (int a = 0; a < 2; ++a)
#pragma unroll
        for (int b = 0; b < 2; ++b)
#pragma unroll
            for (int m = 0; m < 4; ++m)
#pragma unroll
                for (int n = 0; n < 2; ++n) acc[a][b][m][n] = (f32x4){0.f, 0.f, 0.f, 0.f};
    bf16x8 At[4][2], B0[2][2], B1[2][2];
    const char* cA = (const char*)g.A + (size_t)cur.pm * tstep; const char* cB = (const char*)g.Bt + (size_t)cur.pn * tstep;
    S.a_ready(cur);
    if constexpr (SP2) {
        PG8_STAGE(PG8_SB(0, 0), cB, voffB); PG8_STAGE(PG8_SB(0, 1), cB + hstep, voffB); PG8_STAGE(PG8_SA(0, 0), cA, voffA); PG8_STAGE(PG8_SA(0, 1), cA + hstep, voffA);
        if (wr == 1) PG8_BAR;
        PG8_WAIT_V(2); PG8_BAR;
        PG8_STAGE(PG8_SB(1, 0), cB + kstep, voffB); PG8_STAGE(PG8_SA(1, 0), cA + kstep, voffA); PG8_STAGE(PG8_SB(1, 1), cB + hstep + kstep, voffB);
        PG8_WAIT_V(6); PG8_BAR;
    } else {
        PG8_STAGE(PG8_SB(0, 0), cB, voffB); PG8_STAGE(PG8_SA(0, 0), cA, voffA); PG8_STAGE(PG8_SB(0, 1), cB + hstep, voffB); PG8_STAGE(PG8_SA(0, 1), cA + hstep, voffA);
        if (wr == 1) PG8_BAR;
        PG8_WAIT_V(4); PG8_BAR;
        PG8_STAGE(PG8_SB(1, 0), cB + kstep, voffB); PG8_STAGE(PG8_SA(1, 0), cA + kstep, voffA); PG8_STAGE(PG8_SB(1, 1), cB + hstep + kstep, voffB);
        PG8_WAIT_V(6); PG8_BAR;
    }
    for (;;) {
        const bool has_next = S.next(ui + 1, nxt);
        const char* nA = has_next ? (const char*)g.A + (size_t)nxt.pm * tstep : cA; const char* nB = has_next ? (const char*)g.Bt + (size_t)nxt.pn * tstep : cB;
        for (int t = 0; t < nt; t += 2) {
            const bool last = (t == nt - 2);
            const char* a1 = cA + (size_t)(t + 1) * kstep;
            const char* a2 = last ? nA : cA + (size_t)(t + 2) * kstep; const char* b2 = last ? nB : cB + (size_t)(t + 2) * kstep;
            const char* a3 = a2 + kstep; const char* b3 = b2 + kstep;
            if constexpr (Epi::MIDK) { if (t == (nt >> 1)) E.mid(acc, cur, wr, wc, fr, fq); }
            if (last && has_next) S.a_ready(nxt);
            if constexpr (SP2) {
            PG8_LDB(B0, 0, 0); PG8_LDB(B1, 0, 1); PG8_SCHED; PG8_LDA(At, 0, 0); PG8_STAGE(PG8_SA(1, 1), a1 + hstep, voffA);
            PG8_WAIT_V(8); PG8_WAIT_L(0); PG8_BAR; PG8_MMA(0, 0, At, B0); PG8_MMA(0, 1, At, B1); PG8_BAR; PG8_SCHED;
            PG8_LDA(At, 0, 1); PG8_STAGE(PG8_SB(0, 0), b2, voffB); PG8_STAGE(PG8_SB(0, 1), b2 + hstep, voffB); PG8_STAGE(PG8_SA(0, 0), a2, voffA);
            PG8_WAIT_V(8); PG8_WAIT_L(0); PG8_BAR; PG8_MMA(1, 0, At, B0); PG8_MMA(1, 1, At, B1); PG8_BAR; PG8_SCHED;
            PG8_LDB(B0, 1, 0); PG8_LDB(B1, 1, 1); PG8_SCHED; PG8_LDA(At, 1, 0); PG8_STAGE(PG8_SA(0, 1), a2 + hstep, voffA);
            PG8_WAIT_V(8); PG8_WAIT_L(0); PG8_BAR; PG8_MMA(0, 0, At, B0); PG8_MMA(0, 1, At, B1); PG8_BAR; PG8_SCHED;
            PG8_LDA(At, 1, 1); PG8_STAGE(PG8_SB(1, 0), b3, voffB); PG8_STAGE(PG8_SB(1, 1), b3 + hstep, voffB); PG8_STAGE(PG8_SA(1, 0), a3, voffA);
            PG8_WAIT_V(8); PG8_WAIT_L(0); PG8_BAR; PG8_MMA(1, 0, At, B0); PG8_MMA(1, 1, At, B1); PG8_BAR; PG8_SCHED;
            } else {
            PG8_LDB(B0, 0, 0); PG8_SCHED; PG8_LDA(At, 0, 0); PG8_STAGE(PG8_SA(1, 1), a1 + hstep, voffA);
            PG8_WAIT_L(8); PG8_BAR; PG8_WAIT_L(0); PG8_MMA(0, 0, At, B0); PG8_BAR; PG8_SCHED;
            PG8_LDB(B1, 0, 1); PG8_STAGE(PG8_SB(0, 0), b2, voffB);
            PG8_BAR; PG8_WAIT_L(0); PG8_MMA(0, 1, At, B1); PG8_BAR;
            PG8_LDA(At, 0, 1); PG8_STAGE(PG8_SA(0, 0), a2, voffA);
            PG8_BAR; PG8_WAIT_L(0); PG8_MMA(1, 0, At, B0); PG8_BAR; PG8_SCHED;
            PG8_STAGE(PG8_SB(0, 1), b2 + hstep, voffB);
            PG8_WAIT_V(6); PG8_BAR; PG8_MMA(1, 1, At, B1); PG8_BAR;
            PG8_LDB(B0, 1, 0); PG8_SCHED; PG8_LDA(At, 1, 0); PG8_STAGE(PG8_SA(0, 1), a2 + hstep, voffA);
            PG8_WAIT_L(8); PG8_BAR; PG8_WAIT_L(0); PG8_MMA(0, 0, At, B0); PG8_BAR; PG8_SCHED;
            PG8_LDB(B1, 1, 1); PG8_STAGE(PG8_SB(1, 0), b3, voffB);
            PG8_BAR; PG8_WAIT_L(0); PG8_MMA(0, 1, At, B1); PG8_BAR;
            PG8_LDA(At, 1, 1); PG8_STAGE(PG8_SA(1, 0), a3, voffA);
            PG8_BAR; PG8_WAIT_L(0); PG8_MMA(1, 0, At, B0); PG8_BAR; PG8_SCHED;
            PG8_STAGE(PG8_SB(1, 1), b3 + hstep, voffB);
            PG8_WAIT_V(6); PG8_BAR; PG8_MMA(1, 1, At, B1); PG8_BAR;
            }
        }
        if constexpr (ALIGN_EPI) { if (wr == 0) PG8_BAR; }
        if constexpr (!Epi::AFTER_DRAIN) { E(acc, cur, wr, wc, fr, fq); S.done(cur); }
        if (!has_next) break;
#pragma unroll
        for (int a = 0; a < 2; ++a)
#pragma unroll
            for (int b = 0; b < 2; ++b)
#pragma unroll
                for (int m = 0; m < 4; ++m)
#pragma unroll
                    for (int n = 0; n < 2; ++n) acc[a][b][m][n] = (f32x4){0.f, 0.f, 0.f, 0.f};
        cur = nxt; cA = nA; cB = nB; ++ui;
        if constexpr (ALIGN_EPI) { if (wr == 1) PG8_BAR; }
    }
    PG8_WAIT_V(0);
    if constexpr (!ALIGN_EPI) { if (wr == 0) PG8_BAR; }
    PG8_BAR;
    if constexpr (Epi::AFTER_DRAIN) { E.fused(acc, cur, wr, wc, fr, fq, lds, wid, lane); S.done(cur); }
#undef PG8_SA
#undef PG8_SB
#undef PG8_STAGE
#undef PG8_LDA
#undef PG8_LDB
#undef PG8_MMA
#undef PG8_WAIT_V
#undef PG8_WAIT_L
#undef PG8_BAR
#undef PG8_SCHED
}
}
#define GAS __attribute__((address_space(1)))
#define LAS __attribute__((address_space(3)))
typedef unsigned short bf16;
typedef unsigned v4u __attribute__((ext_vector_type(4)));
typedef float f32x4 __attribute__((ext_vector_type(4)));
typedef short bf16x8 __attribute__((ext_vector_type(8)));
typedef GAS unsigned gu32;
typedef GAS unsigned long long gu64;
#define RLX_AGENT __ATOMIC_RELAXED, __HIP_MEMORY_SCOPE_AGENT
#define LDS_WAIT() asm volatile("s_waitcnt lgkmcnt(0)" ::: "memory")
#define VM_WAIT() asm volatile("s_waitcnt vmcnt(0)" ::: "memory")
__device__ __forceinline__ unsigned long long rt() { return __builtin_amdgcn_s_memrealtime(); }
__device__ __forceinline__ unsigned f2bf(float f) { unsigned u = __builtin_bit_cast(unsigned, f); return (u + 0x7fffu + ((u >> 16) & 1u)) >> 16; }
__device__ __forceinline__ unsigned pk2(float lo, float hi) { return f2bf(lo) | (f2bf(hi) << 16); }

#define XB_TMO      128
#define XB_XCNT(j)  (256  + 64 * (j))
#define XB_XSUB(j)  (1280 + 64 * (j))
#define XB_XGEN(j)  (2304 + 64 * (j))
#define XB_TOP      3328
#define XB_TOPGEN   3392
#define XCD_BAR_WORDS 3456
#define XB_SPIN_CAP (1u << 18)

__device__ __forceinline__ unsigned xb_ld(unsigned* p)              { return __hip_atomic_load(p, __ATOMIC_RELAXED, __HIP_MEMORY_SCOPE_AGENT); }
__device__ __forceinline__ unsigned xb_add(unsigned* p, unsigned v) { return __hip_atomic_fetch_add(p, v, __ATOMIC_RELAXED, __HIP_MEMORY_SCOPE_AGENT); }
__device__ __forceinline__ unsigned xb_xcc_id() { return (unsigned)__builtin_amdgcn_s_getreg((3 << 11) | 20) & 0xFu; }
#define XB_SPIN(cond, bar) do { unsigned _sp = 0; while (cond) { __builtin_amdgcn_s_sleep(1); \
    if ((++_sp & 255u) == 0u) { if (xb_ld(&(bar)[XB_TMO])) break; if (_sp > XB_SPIN_CAP) { atomicAdd(&(bar)[XB_TMO], 1u); break; } } } } while (0)

struct XcdBarrier {
    unsigned* bar; unsigned x;
    volatile LAS unsigned* st;
};

__device__ __forceinline__ XcdBarrier xcd_barrier_post(unsigned* bar, volatile LAS unsigned* st) {
    XcdBarrier b; b.bar = bar; b.x = xb_xcc_id(); b.st = st;
    if (threadIdx.x == 0) { const unsigned r_ = xb_add(&bar[XB_XCNT(b.x)], 1u); st[2] = r_; st[3] = b.x; }
    return b;
}
__device__ __forceinline__ void xcd_barrier_complete(unsigned* bar, unsigned x, unsigned& nloc, unsigned& nx) {
    const unsigned G = gridDim.x * gridDim.y * gridDim.z;
    unsigned sum, cnt, mine, sp = 0u;
    for (;;) {
        sum = 0u; cnt = 0u; mine = 0u;
#pragma unroll
        for (unsigned j = 0; j < 16; ++j) { const unsigned c = xb_ld(&bar[XB_XCNT(j)]); sum += c; cnt += (c > 0u) ? 1u : 0u; mine = (j == x) ? c : mine; }
        if (sum == G) break;
        __builtin_amdgcn_s_sleep(1);
        if ((++sp & 255u) == 0u) { if (xb_ld(&bar[XB_TMO])) break; if (sp > XB_SPIN_CAP) { atomicAdd(&bar[XB_TMO], 1u); break; } }
    }
    nloc = mine > 0u ? mine : 1u; nx = cnt > 0u ? cnt : 1u;
}

__device__ __forceinline__ void xcd_barrier(const XcdBarrier& b) {
    asm volatile("s_waitcnt vmcnt(0)" ::: "memory");
    __syncthreads();
    if (threadIdx.x == 0) {
        unsigned* bar = b.bar;
        __builtin_amdgcn_s_waitcnt(0);
        unsigned nloc = b.st[0], nx = b.st[1];
        if (nloc == 0u) { xcd_barrier_complete(bar, b.x, nloc, nx); b.st[0] = nloc; b.st[1] = nx; }
        const unsigned old = xb_add(&bar[XB_XSUB(b.x)], 1u);
        const unsigned gen = old / nloc;
        if (old + 1u == (gen + 1u) * nloc) {
            __builtin_amdgcn_fence(__ATOMIC_RELEASE, "agent");
            asm volatile("s_waitcnt vmcnt(0)" ::: "memory");
            const unsigned og = xb_add(&bar[XB_TOP], 1u);
            const unsigned tg = og / nx;
            if (og + 1u == (tg + 1u) * nx) xb_add(&bar[XB_TOPGEN], 1u);
            else XB_SPIN(xb_ld(&bar[XB_TOPGEN]) == tg, bar);
            __builtin_amdgcn_fence(__ATOMIC_ACQUIRE, "agent");
            xb_add(&bar[XB_XGEN(b.x)], 1u);
            asm volatile("s_waitcnt vmcnt(0)" ::: "memory");
        } else {
            XB_SPIN(xb_ld(&bar[XB_XGEN(b.x)]) == gen, bar);
            __builtin_amdgcn_fence(__ATOMIC_ACQUIRE, "agent");
            asm volatile("s_waitcnt vmcnt(0)" ::: "memory");
        }
    }
    __syncthreads();
}

constexpr int NWAVES = 8;
constexpr int BATCH = 16, SEQ = 2048, T = BATCH * SEQ, D = 1024, DIN = 2560, NMEM = 256, TM = BATCH * NMEM;
constexpr int DLRU = 512, LBLK = 8, LBD = 64;
constexpr int AH = 8, AD = 64, MOBA = 256, NB = SEQ / MOBA;
constexpr int CH = 4, CD = 256;
constexpr int PKEYS = 128, PHEADS = 8, PTOP = 16, PHALF = 128, PEXP = PHEADS * PTOP;
constexpr float EPS = 1e-6f;
constexpr int COL_LX = 0, COL_LG = 512, COL_Q = 1024, COL_K = 1536, COL_V = 2048;

constexpr size_t MiB = 1u << 20;
constexpr size_t WS_CTL = 0, CTL_ZERO_BYTES = 64 * 1024;
constexpr size_t WS_WIN = 2 * MiB, WS_WOUT = 7 * MiB, WS_WCQ = 9 * MiB, WS_WCKV = 11 * MiB, WS_WCO = 15 * MiB, WS_WPQ = 17 * MiB, WS_SUBK = 21 * MiB;
constexpr size_t WS_KMEAN = 23 * MiB;
constexpr size_t WS_MEMN = 24 * MiB;
constexpr size_t WS_KCVC = 32 * MiB;
constexpr size_t WS_SS1 = 48 * MiB, WS_SS2 = 50 * MiB;
constexpr size_t WS_IDS = 52 * MiB;
constexpr size_t WS_GATES = 60 * MiB;
constexpr size_t WS_A = 80 * MiB;
constexpr size_t WS_B = 144 * MiB;
constexpr size_t WS_C = 304 * MiB;
constexpr size_t WS_E = 368 * MiB;
constexpr size_t WS_SU = 76 * MiB;
constexpr size_t WS_SS3 = 77 * MiB;
constexpr size_t WS_HS = 78 * MiB;
constexpr size_t WS_SSL = 79 * MiB, WS_SSA = 22 * MiB;
constexpr size_t WS_XQ = 144 * MiB;
constexpr size_t WS_VQ = 160 * MiB, VQ_SLAB = 20 * MiB;
constexpr size_t WS_ACTW = 432 * MiB;
constexpr size_t WS_UQ = 496 * MiB;
constexpr size_t WS_END = 512 * MiB;
constexpr size_t GRP_SHIFT = 12u << 20;
constexpr int XQ_LD = 2048;
constexpr int CW_TMO = 0, CW_BAR = 4096, CW_QUAD = 8192  , CW_XID = 12288  , CW_G32 = 12800  , CW_WCNT = 13312  , CW_P2CNT = 13376  ;

constexpr int RING_OFF = 0, RING_BYTES = 131072;
constexpr int STREAM_OFF = 81920, STREAM_WAVE_BYTES = 8192;
constexpr int LDSCTL_OFF = 155648, MISC_OFF = LDSCTL_OFF + 320;
constexpr int LDS_BYTES = 163840;

__device__ __forceinline__ float bf2f(bf16 b) { return __uint_as_float(((unsigned)b) << 16); }
__device__ __forceinline__ float bflo(unsigned w) { return __uint_as_float(w << 16); }
__device__ __forceinline__ float bfhi(unsigned w) { return __uint_as_float(w & 0xffff0000u); }
__device__ __forceinline__ float wave_sum(float v) {
#pragma unroll
    for (int o = 1; o < 64; o <<= 1) v += __shfl_xor(v, o);
    return v;
}
__device__ __forceinline__ float wave_max(float v) {
#pragma unroll
    for (int o = 1; o < 64; o <<= 1) v = fmaxf(v, __shfl_xor(v, o));
    return v;
}
__device__ __forceinline__ unsigned wave_umax(unsigned v) {
#pragma unroll
    for (int o = 1; o < 64; o <<= 1) { const unsigned w = (unsigned)__shfl_xor((int)v, o); v = v > w ? v : w; }
    return v;
}
__device__ __forceinline__ float gelu_erf(float v) { return 0.5f * v * (1.0f + erff(v * 0.70710678118654752f)); }
__device__ __forceinline__ float sigmoidf_(float v) { return 1.0f / (1.0f + __expf(-v)); }
__device__ __forceinline__ unsigned ordf(float f) { const unsigned u = __float_as_uint(f); return (u & 0x80000000u) ? ~u : (u | 0x80000000u); }

struct Frame {
    LAS unsigned char* lds;
    volatile LAS unsigned* MISC;
    gu32* ctl;
    int tid, lane, wave, vcu, G;
    const float* in[26]; float* out; unsigned char* ws;
};

__device__ __forceinline__ void p0_transpose_item(const float* W, int K, int N, bf16* WT, int row_off, LAS float* scr, int item, int lane, const float* g0, const float* g1) {
    const int nblk = N / 32, kb = item / nblk, nb = item % nblk, k0 = 64 * kb, n0 = 32 * nb;
    f32x4 v[8]; float gv[8];
#pragma unroll
    for (int j = 0; j < 8; ++j) { const int k = k0 + (lane >> 3) + 8 * j; v[j] = *(const GAS f32x4*)(W + (size_t)k * N + n0 + 4 * (lane & 7)); gv[j] = g0 ? ((k < 512) ? g0[k] : g1[k - 512]) : 1.f; }
#pragma unroll
    for (int j = 0; j < 8; ++j) { LAS float* d = scr + ((lane >> 3) + 8 * j) * 33 + 4 * (lane & 7); d[0] = v[j].x * gv[j]; d[1] = v[j].y * gv[j]; d[2] = v[j].z * gv[j]; d[3] = v[j].w * gv[j]; }
    LDS_WAIT(); asm volatile("" ::: "memory");
    const int c = lane & 7;
#pragma unroll
    for (int j = 0; j < 4; ++j) { const int n = (lane >> 3) + 8 * j; const LAS float* s = scr + (8 * c) * 33 + n;
        v4u o; o.x = pk2(s[0 * 33], s[1 * 33]); o.y = pk2(s[2 * 33], s[3 * 33]); o.z = pk2(s[4 * 33], s[5 * 33]); o.w = pk2(s[6 * 33], s[7 * 33]);
        asm volatile("global_store_dwordx4 %0, %1, off sc0 sc1" :: "v"(WT + (size_t)(row_off + n0 + n) * K + k0 + 8 * c), "v"(o) : "memory"); }
    LDS_WAIT(); asm volatile("" ::: "memory");
}
template <int R, bool WT = false> __device__ __forceinline__ void rms_rows_to_bf16(int lane, const float* xrow, const float* g, bf16* orow) {
    f32x4 v[R][4]; float s[R];
#pragma unroll
    for (int r = 0; r < R; ++r) { const GAS f32x4* xr = (const GAS f32x4*)(xrow + (size_t)r * D) + lane;
#pragma unroll
        for (int j = 0; j < 4; ++j) v[r][j] = __builtin_nontemporal_load(xr + 64 * j); }
    const GAS f32x4* gr = (const GAS f32x4*)g + lane; f32x4 gg[4];
#pragma unroll
    for (int j = 0; j < 4; ++j) gg[j] = gr[64 * j];
#pragma unroll
    for (int r = 0; r < R; ++r) { float a = 0.f;
#pragma unroll
        for (int j = 0; j < 4; ++j) a += (v[r][j].x * v[r][j].x + v[r][j].y * v[r][j].y) + (v[r][j].z * v[r][j].z + v[r][j].w * v[r][j].w);
        s[r] = a; }
#pragma unroll
    for (int o = 1; o < 64; o <<= 1) {
#pragma unroll
        for (int r = 0; r < R; ++r) s[r] += __shfl_xor(s[r], o); }
#pragma unroll
    for (int r = 0; r < R; ++r) { const float rs = 1.f / sqrtf(s[r] * (1.f / D) + EPS); GAS unsigned long long* o8 = (GAS unsigned long long*)(orow + (size_t)r * D) + lane;
#pragma unroll
        for (int j = 0; j < 4; ++j) { const unsigned long long val = (unsigned long long)pk2(v[r][j].x * rs * gg[j].x, v[r][j].y * rs * gg[j].y) | ((unsigned long long)pk2(v[r][j].z * rs * gg[j].z, v[r][j].w * rs * gg[j].w) << 32);
            if constexpr (WT) __hip_atomic_store((unsigned long long*)(o8 + 64 * j), val, __ATOMIC_RELAXED, __HIP_MEMORY_SCOPE_SYSTEM); else o8[64 * j] = val; } }
}
__device__ __forceinline__ void p0_prologue(Frame& F, bool split) {
    LAS float* scr = (LAS float*)(F.lds + RING_OFF + F.wave * 16384);
    const int gw = F.vcu * NWAVES + F.wave, NGW = F.G * NWAVES;
    bf16* Win_t = (bf16*)(F.ws + WS_WIN); bf16* Wout_t = (bf16*)(F.ws + WS_WOUT); bf16* Wcq_t = (bf16*)(F.ws + WS_WCQ); bf16* Wckv_t = (bf16*)(F.ws + WS_WCKV);
    bf16* Wco_t = (bf16*)(F.ws + WS_WCO); bf16* Wpq_t = (bf16*)(F.ws + WS_WPQ);
    constexpr int I_IN = (D / 64) * (DIN / 32), I_SQ = (D / 64) * (D / 32), I_PQ = (D / 64) * (2048 / 32);
    constexpr int NITEMS = I_IN + 5 * I_SQ + I_PQ;
    for (int it = gw; it < NITEMS; it += NGW) {
        int r = it;
        if (r < I_IN) { p0_transpose_item(F.in[3], D, DIN, Win_t, 0, scr, r, F.lane, nullptr, nullptr); continue; } r -= I_IN;
        if (r < I_SQ) { p0_transpose_item(F.in[13], D, D, Wout_t, 0, scr, r, F.lane, F.in[11], F.in[12]); continue; } r -= I_SQ;
        if (r < I_SQ) { p0_transpose_item(F.in[16], D, D, Wcq_t, 0, scr, r, F.lane, F.in[14], F.in[14] + 512); continue; } r -= I_SQ;
        if (r < I_SQ) { p0_transpose_item(F.in[17], D, D, Wckv_t, 0, scr, r, F.lane, nullptr, nullptr); continue; } r -= I_SQ;
        if (r < I_SQ) { p0_transpose_item(F.in[18], D, D, Wckv_t, D, scr, r, F.lane, nullptr, nullptr); continue; } r -= I_SQ;
        if (r < I_SQ) { p0_transpose_item(F.in[19], D, D, Wco_t, 0, scr, r, F.lane, nullptr, nullptr); continue; } r -= I_SQ;
        p0_transpose_item(F.in[21], D, 2048, Wpq_t, 0, scr, r, F.lane, F.in[20], F.in[20] + 512);
    }
    bf16* H = (bf16*)(F.ws + WS_A); bf16* MEMN = (bf16*)(F.ws + WS_MEMN);
    for (int m = 2 * gw; m < TM; m += 2 * NGW) rms_rows_to_bf16<2, true>(F.lane, F.in[1] + (size_t)m * D, F.in[15], MEMN + (size_t)m * D);
    { bf16* SUBK = (bf16*)(F.ws + WS_SUBK); const float* sk = F.in[22]; const int gt = F.vcu * (NWAVES * 64) + F.tid, NGT = F.G * NWAVES * 64;
      for (int i = gt; i < PHEADS * 2 * PKEYS * PHALF / 4; i += NGT) { const f32x4 v = ((const GAS f32x4*)sk)[i]; __hip_atomic_store((unsigned long long*)SUBK + i, (unsigned long long)pk2(v.x, v.y) | ((unsigned long long)pk2(v.z, v.w) << 32), __ATOMIC_RELAXED, __HIP_MEMORY_SCOPE_SYSTEM); } }
    if (split) {
        asm volatile("s_waitcnt vmcnt(0)" ::: "memory"); __syncthreads();
        if (F.tid == 0) { __builtin_amdgcn_fence(__ATOMIC_RELEASE, "agent"); asm volatile("s_waitcnt vmcnt(0)" ::: "memory"); __hip_atomic_fetch_add(F.ctl + CW_WCNT, 1u, RLX_AGENT); }
    } else
        for (int m = 4 * gw; m < T; m += 4 * NGW) rms_rows_to_bf16<4>(F.lane, F.in[0] + (size_t)m * D, F.in[2], H + (size_t)m * D);
}

typedef float f32x2_ __attribute__((ext_vector_type(2)));
struct PeerStream {
    int k, count; int lane;
    bool local; int gbase, gstep, xb0, xb1, vbase;
    __device__ __forceinline__ int item_of(int kk) const { return local ? (kk >= 8 ? 16384 + (((kk - 8) >> 1) ? xb1 : xb0) + (kk & 1) : vbase + 8 * kk) : gbase + kk * gstep; }
    const float* U; const float* V; const float* gf; signed char* UQ; float* SU; unsigned char* VQ;
    const bf16* X2; const float* SS2; signed char* XQ; float* HS;
    LAS unsigned char* buf; LAS unsigned char* sbuf;
    __device__ __forceinline__ void issue(int kk) { const int item = item_of(kk);
        if (item < 16384) {
#pragma unroll
            for (int j = 0; j < 4; ++j) __builtin_amdgcn_global_load_lds((const unsigned*)(V + (size_t)item * D + j * 256 + 4 * lane), (LAS unsigned*)(buf + 4096 + j * 1024), 16, 0, 2);
        } else { const int t = 4 * (item - 16384);
#pragma unroll
            for (int j = 0; j < 8; ++j) __builtin_amdgcn_global_load_lds((const unsigned*)(X2 + (size_t)(t + (j >> 1)) * D + (j & 1) * 512 + 8 * lane), (LAS unsigned*)(buf + j * 1024), 16, 0, 0);
            __builtin_amdgcn_global_load_lds((const unsigned*)(SS2 + (size_t)(t + (lane >> 4)) * 16 + (lane & 15)), (LAS unsigned*)sbuf, 4, 0, 0);
        }
    }
    template <bool WAIT = true> __device__ __forceinline__ void finish(int kk) { const int item = item_of(kk);
        if constexpr (WAIT) asm volatile("s_waitcnt vmcnt(0)" ::: "memory");
        if (item < 16384) { const int e = item;
            v4u o2;
#pragma unroll
            for (int i = 0; i < 4; ++i) { const f32x4 w = *(const LAS f32x4*)(buf + 4096 + 64 * lane + 16 * i) * 16.0f;
                int p = __builtin_amdgcn_cvt_pk_fp8_f32(w[0], w[1], 0, false); p = __builtin_amdgcn_cvt_pk_fp8_f32(w[2], w[3], p, true); o2[i] = (unsigned)p; }
            *(v4u*)(VQ + (size_t)(lane >> 3) * VQ_SLAB + (size_t)e * 128 + 16 * (lane & 7)) = o2;
        } else { const int t = 4 * (item - 16384);
#pragma unroll
            for (int q = 0; q < 4; ++q) { const v4u wa = *(const LAS v4u*)(buf + 2048 * q + 32 * lane), wb = *(const LAS v4u*)(buf + 2048 * q + 32 * lane + 16); const unsigned w[8] = {wa.x, wa.y, wa.z, wa.w, wb.x, wb.y, wb.z, wb.w};
                float am = 0.f;
#pragma unroll
                for (int i = 0; i < 8; ++i) am = fmaxf(am, fmaxf(fabsf(bflo(w[i])), fabsf(bfhi(w[i]))));
                am = wave_max(am); const float inv = am > 0.f ? 127.0f / am : 0.f;
                v4u o;
#pragma unroll
                for (int i = 0; i < 4; ++i) { const int q0 = (int)rintf(bflo(w[2 * i]) * inv), q1 = (int)rintf(bfhi(w[2 * i]) * inv), q2 = (int)rintf(bflo(w[2 * i + 1]) * inv), q3 = (int)rintf(bfhi(w[2 * i + 1]) * inv);
                    o[i] = (unsigned)(q0 & 0xff) | ((unsigned)(q1 & 0xff) << 8) | ((unsigned)(q2 & 0xff) << 16) | ((unsigned)(q3 & 0xff) << 24); }
                *(v4u*)(XQ + (size_t)((t + q) >> 12) * GRP_SHIFT + (size_t)(t + q) * XQ_LD + 16 * lane) = o;
                float a = *(const LAS float*)(sbuf + 64 * q + 4 * (lane & 15)); a += __shfl_xor(a, 1); a += __shfl_xor(a, 2); a += __shfl_xor(a, 4); a += __shfl_xor(a, 8);
                if (lane == 0) HS[t + q] = (1.f / sqrtf(a * (1.f / D) + EPS)) * am * (1.0f / 127.0f); }
        }
        asm volatile("s_waitcnt lgkmcnt(0)" ::: "memory");
    }
};
template <int WHICH> __device__ __forceinline__ void convert_rows(Frame& F, int i0, int i1) {
    const float* SRC = WHICH ? F.in[24] : F.in[23]; signed char* UQ = (signed char*)(F.ws + WS_UQ); float* SU = (float*)(F.ws + WS_SU); unsigned char* VQ = F.ws + WS_VQ;
    int lane = F.lane; asm volatile("" : "+v"(lane));
    f32x4 gg[4];
#pragma unroll
    for (int i = 0; i < 4; ++i) gg[i] = WHICH ? (f32x4){16.f, 16.f, 16.f, 16.f} : *(const f32x4*)(F.in[20] + 16 * lane + 4 * i);
    asm volatile("s_waitcnt vmcnt(0)" ::: "memory");
    LAS unsigned char* const b0 = F.lds + RING_OFF + F.wave * 16384;
#define CT_ISSUE(item, buf) do { _Pragma("unroll") for (int j = 0; j < 4; ++j) \
        __builtin_amdgcn_global_load_lds((const unsigned*)(SRC + (size_t)(item) * D + j * 256 + 4 * lane), (LAS unsigned*)((buf) + j * 1024), 16, 0, 2); } while (0)
    int it = i0 + F.wave, par = 0;
#pragma unroll
    for (int k = 0; k < 3; ++k) if (it + 8 * k < i1) CT_ISSUE(it + 8 * k, b0 + k * 4096);
    for (; it < i1; it += 8, par = (par + 1) & 3) {
        LAS unsigned char* const buf = b0 + par * 4096;
        if (it + 24 < i1) { CT_ISSUE(it + 24, b0 + ((par + 3) & 3) * 4096); asm volatile("s_waitcnt vmcnt(12)" ::: "memory"); }
        else if (it + 16 < i1) asm volatile("s_waitcnt vmcnt(8)" ::: "memory");
        else if (it + 8 < i1) asm volatile("s_waitcnt vmcnt(4)" ::: "memory");
        else asm volatile("s_waitcnt vmcnt(0)" ::: "memory");
        const int e = it; f32x4 v[4];
#pragma unroll
        for (int i = 0; i < 4; ++i) v[i] = *(const LAS f32x4*)(buf + 64 * lane + 16 * i) * gg[i];
        v4u o;
        if constexpr (WHICH == 0) { float am = 0.f;
#pragma unroll
            for (int i = 0; i < 4; ++i) am = fmaxf(am, fmaxf(fmaxf(fabsf(v[i][0]), fabsf(v[i][1])), fmaxf(fabsf(v[i][2]), fabsf(v[i][3]))));
            am = wave_max(am); const float inv = am > 0.f ? 127.0f / am : 0.f;
#pragma unroll
            for (int i = 0; i < 4; ++i) { const int q0 = (int)rintf(v[i][0] * inv), q1 = (int)rintf(v[i][1] * inv), q2 = (int)rintf(v[i][2] * inv), q3 = (int)rintf(v[i][3] * inv);
                o[i] = (unsigned)(q0 & 0xff) | ((unsigned)(q1 & 0xff) << 8) | ((unsigned)(q2 & 0xff) << 16) | ((unsigned)(q3 & 0xff) << 24); }
            *(v4u*)(UQ + ((size_t)(lane >> 3) * (PKEYS * PKEYS) + e) * 128 + 16 * (lane & 7)) = o;
            if (lane == 0) SU[e] = am * (1.0f / 127.0f);
        } else {
#pragma unroll
            for (int i = 0; i < 4; ++i) { int p = __builtin_amdgcn_cvt_pk_fp8_f32(v[i][0], v[i][1], 0, false); p = __builtin_amdgcn_cvt_pk_fp8_f32(v[i][2], v[i][3], p, true); o[i] = (unsigned)p; }
            *(v4u*)(VQ + (size_t)(lane >> 3) * VQ_SLAB + (size_t)e * 128 + 16 * (lane & 7)) = o;
        }
        asm volatile("s_waitcnt lgkmcnt(0)" ::: "memory");
    }
#undef CT_ISSUE
    asm volatile("s_waitcnt vmcnt(0) lgkmcnt(0)\n\ts_barrier" ::: "memory");
}
__device__ __forceinline__ void table_share(const Frame& F, int k, int n, int& i0, int& i1) {
    const int per = (PKEYS * PKEYS + F.G - 1) / F.G, lo = (int)blockIdx.x * per, hi = (lo + per < PKEYS * PKEYS) ? lo + per : PKEYS * PKEYS;
    i0 = lo + (k * per) / n; i1 = lo + ((k + 1) * per) / n; if (i0 > hi) i0 = hi; if (i1 > hi) i1 = hi;
}
__device__ __forceinline__ void xcd_split(Frame& F, bool census, int& part, int& rank, int& nrank) {
    part = (int)(blockIdx.x & 7); rank = (int)(blockIdx.x >> 3); nrank = (F.G - part + 7) >> 3;
    if (census && (F.G & 7) == 0) { const unsigned x = F.MISC[11], r = F.MISC[10]; unsigned pre = 0u; gu32* bar = F.ctl + CW_BAR;
#pragma unroll
        for (unsigned j = 0; j < 16; ++j) { const unsigned c = __hip_atomic_load(bar + XB_XCNT(j), RLX_AGENT); pre += (j < x) ? c : 0u; }
        const unsigned gi = pre + r, per = (unsigned)F.G >> 3; part = (int)(gi / per); rank = (int)(gi % per); nrank = (int)per; }
}
template <int CTRL> __device__ __forceinline__ int dpp_i(int x) { return __builtin_amdgcn_update_dpp(0, x, CTRL, 0xf, 0xf, true); }
template <int CTRL> __device__ __forceinline__ float dpp_f(float x) { return __int_as_float(__builtin_amdgcn_update_dpp(0, __float_as_int(x), CTRL, 0xf, 0xf, true)); }
constexpr int DPP_XOR1 = 0xB1  , DPP_XOR2 = 0x4E  , DPP_HMIRROR = 0x141  , DPP_ROR8 = 0x128  ;
__device__ __forceinline__ float swap32_add(float a, float b) { const auto r = __builtin_amdgcn_permlane32_swap(__float_as_uint(a), __float_as_uint(b), false, false); return __uint_as_float(r[0]) + __uint_as_float(r[1]); }
__device__ __forceinline__ float swap16_add(float a, float b) { const auto r = __builtin_amdgcn_permlane16_swap(__float_as_uint(a), __float_as_uint(b), false, false); return __uint_as_float(r[0]) + __uint_as_float(r[1]); }
struct PuMeta { v4u ida, idb; v4u xq; };
__device__ __forceinline__ void pu_load(PuMeta& m, int t, int g, int col16, const unsigned short* IDS, const signed char* XQ) {
    const v4u* ip = (const v4u*)(IDS + (size_t)t * PEXP + g * 16); m.ida = ip[0]; m.idb = ip[1]; m.xq = *(const v4u*)(XQ + (size_t)(t >> 12) * GRP_SHIFT + (size_t)t * XQ_LD + col16);
}
__device__ __forceinline__ unsigned pu_id(const PuMeta& m, int i) { const unsigned w = (i < 8) ? m.ida[(i & 7) >> 1] : m.idb[(i & 7) >> 1]; return (i & 1) ? (w >> 16) : (w & 0xffffu); }
__device__ __forceinline__ void peer_u(Frame& F, bool census) {
    const unsigned short* IDS = (const unsigned short*)(F.ws + WS_IDS); const signed char* XQ = (const signed char*)(F.ws + WS_XQ); const signed char* UQ = (const signed char*)(F.ws + WS_UQ); int* PD = (int*)(F.ws + WS_E);
    int part, rank, nrank; xcd_split(F, census, part, rank, nrank); const int lane = F.lane, g = lane >> 3, l7 = lane & 7;
    const signed char* slab = UQ + (size_t)__builtin_amdgcn_readfirstlane(part) * (PKEYS * PKEYS) * 128; const unsigned l7o = 16u * (unsigned)l7; const int col16 = 128 * part + 16 * l7;
    const bool b4 = (lane & 4) != 0, b2 = (lane & 2) != 0, b1 = (lane & 1) != 0;
    const int t0 = rank * NWAVES + F.wave, tstep = nrank * NWAVES;
    PuMeta m[2]; v4u q[2][16]; v4u xc[2];
#pragma unroll
    for (int k = 0; k < 2; ++k) { const int t = t0 + k * tstep; pu_load(m[k], t < T ? t : t0, g, col16, IDS, XQ); }
#define PU_ISSUE(buf, mk) do { _Pragma("unroll") for (int i_ = 0; i_ < 16; ++i_) q[buf][i_] = *(const v4u*)(slab + ((pu_id((mk), i_) << 7) | l7o)); xc[buf] = (mk).xq; } while (0)
    PU_ISSUE(0, m[0]);
    { const int tp = t0 + 2 * tstep; if (tp < T) pu_load(m[0], tp, g, col16, IDS, XQ); }
    for (int tb = t0; tb < T; tb += 2 * tstep) {
#pragma unroll
        for (int k = 0; k < 2; ++k) {
            const int t = tb + k * tstep;
            if (t < T) {
                const int tn = t + tstep;
                if (tn < T) PU_ISSUE(k ^ 1, m[k ^ 1]);
                { const int tp = t + 3 * tstep; if (tp < T) pu_load(m[k ^ 1], tp, g, col16, IDS, XQ); }
                int d[16];
#pragma unroll
                for (int i = 0; i < 16; ++i) { const v4u uu = q[k][i]; const v4u xx = xc[k];
                    int a = __builtin_amdgcn_sdot4((int)uu.x, (int)xx.x, 0, false); a = __builtin_amdgcn_sdot4((int)uu.y, (int)xx.y, a, false); a = __builtin_amdgcn_sdot4((int)uu.z, (int)xx.z, a, false); d[i] = __builtin_amdgcn_sdot4((int)uu.w, (int)xx.w, a, false); }
                int r8[8], r4[4], r2[2];
#pragma unroll
                for (int i = 0; i < 8; ++i) { const int sa = d[i] + dpp_i<DPP_HMIRROR>(d[i]), sb = d[i + 8] + dpp_i<DPP_HMIRROR>(d[i + 8]); r8[i] = b4 ? sb : sa; }
#pragma unroll
                for (int i = 0; i < 4; ++i) { const int sa = r8[i] + dpp_i<DPP_XOR2>(r8[i]), sb = r8[i + 4] + dpp_i<DPP_XOR2>(r8[i + 4]); r4[i] = b2 ? sb : sa; }
#pragma unroll
                for (int i = 0; i < 2; ++i) { const int sa = r4[i] + dpp_i<DPP_XOR1>(r4[i]), sb = r4[i + 2] + dpp_i<DPP_XOR1>(r4[i + 2]); r2[i] = b1 ? sb : sa; }
                { const int q0_ = (r2[0] + 32) >> 6, q1_ = (r2[1] + 32) >> 6;
                  PD[((size_t)t * 8 + part) * 64 + lane] = (int)(((unsigned)q0_ & 0xffffu) | ((unsigned)q1_ << 16)); }
            }
        }
    }
#undef PU_ISSUE
}
__device__ __forceinline__ void peer_combine(Frame& F) {
    const int* PD = (const int*)(F.ws + WS_E); const unsigned short* IDS = (const unsigned short*)(F.ws + WS_IDS); const float* GATES = (const float*)(F.ws + WS_GATES); const float* SU = (const float*)(F.ws + WS_SU);
    const float* HS = (const float*)(F.ws + WS_HS); unsigned* PK = (unsigned*)(F.ws + WS_ACTW);
    const int gw = F.vcu * NWAVES + F.wave, NGW = F.G * NWAVES, lane = F.lane, g = lane >> 3, l7 = lane & 7;
    const int ii0 = 2 * (l7 & 1) + 4 * ((l7 >> 1) & 1) + 8 * ((l7 >> 2) & 1), p0 = 8 * ii0 + g, p1 = 8 * (ii0 + 1) + g, q0 = g * 16 + ii0, q1 = q0 + 1;
    for (int t = 2 * gw; t < T; t += 2 * NGW) {
        uint2 v[2][8]; float hs[2], g0[2], g1[2]; int id0[2], id1[2];
#pragma unroll
        for (int r = 0; r < 2; ++r) {
#pragma unroll
            for (int x = 0; x < 8; ++x) { const int w_ = __builtin_nontemporal_load(PD + ((size_t)(t + r) * 8 + x) * 64 + lane); v[r][x] = make_uint2((unsigned)((w_ << 16) >> 16), (unsigned)(w_ >> 16)); }
            hs[r] = HS[t + r]; id0[r] = IDS[(size_t)(t + r) * PEXP + q0]; id1[r] = IDS[(size_t)(t + r) * PEXP + q1]; g0[r] = GATES[(size_t)(t + r) * PEXP + p0]; g1[r] = GATES[(size_t)(t + r) * PEXP + p1]; }
        float su0[2], su1[2];
#pragma unroll
        for (int r = 0; r < 2; ++r) { su0[r] = SU[id0[r]]; su1[r] = SU[id1[r]]; }
#pragma unroll
        for (int r = 0; r < 2; ++r) { int s0 = 0, s1 = 0;
#pragma unroll
            for (int x = 0; x < 8; ++x) { s0 += (int)v[r][x].x; s1 += (int)v[r][x].y; }
            const float w0 = g0[r] * gelu_erf(hs[r] * su0[r] * (64.0f * (float)s0)) * 0.0625f, w1 = g1[r] * gelu_erf(hs[r] * su1[r] * (64.0f * (float)s1)) * 0.0625f;
            *(uint2*)(PK + (size_t)(t + r) * PEXP + q0) = make_uint2((f2bf(w0) << 16) | (unsigned)id0[r], (f2bf(w1) << 16) | (unsigned)id1[r]); }
    }
}
struct PvMeta { v4u pk[4]; unsigned xw; };
__device__ __forceinline__ void pv_load(PvMeta& m, int t, int g, int col, const unsigned* PK, const bf16* X2) {
    const v4u* pp = (const v4u*)(PK + (size_t)t * PEXP + g * 16);
#pragma unroll
    for (int i = 0; i < 4; ++i) m.pk[i] = pp[i];
    m.xw = __builtin_nontemporal_load((const unsigned*)(X2 + (size_t)t * D + col));
}
__device__ __forceinline__ void peer_v(Frame& F, bool census) {
    const bf16* X2 = (const bf16*)(F.ws + WS_C); const unsigned* PK = (const unsigned*)(F.ws + WS_ACTW);
    const unsigned char* VQ = F.ws + WS_VQ; bf16* X3 = (bf16*)(F.ws + WS_A);
    int part, rank, nrank; xcd_split(F, census, part, rank, nrank); const int lane = F.lane, g = lane >> 3, l7 = lane & 7;
    const unsigned char* slab = VQ + (size_t)__builtin_amdgcn_readfirstlane(part) * VQ_SLAB; const unsigned l7o = 16u * (unsigned)l7;
    const bool hi = lane >= 32, b16 = (lane & 16) != 0, b8 = (lane & 8) != 0;
    const int col = 128 * part + 16 * l7 + 2 * g;
    const int t0 = rank * NWAVES + F.wave, tstep = nrank * NWAVES;
    PvMeta m[2]; v4u q[2][16]; float w[2][16]; unsigned xwv[2];
#pragma unroll
    for (int k = 0; k < 2; ++k) { const int t = t0 + k * tstep; pv_load(m[k], t < T ? t : t0, g, col, PK, X2); }
#define PV_ISSUE(buf, mk) do { _Pragma("unroll") for (int i_ = 0; i_ < 16; ++i_) { const unsigned p_ = (mk).pk[i_ >> 2][i_ & 3]; w[buf][i_] = __uint_as_float(p_ & 0xffff0000u); q[buf][i_] = *(const v4u*)(slab + (((p_ & 0xffffu) << 7) | l7o)); } xwv[buf] = (mk).xw; } while (0)
    PV_ISSUE(0, m[0]);
    { const int tp = (t0 + 2 * tstep < T) ? t0 + 2 * tstep : t0; pv_load(m[0], tp, g, col, PK, X2); }
    for (int tb = t0; tb < T; tb += 2 * tstep) {
#pragma unroll
        for (int k = 0; k < 2; ++k) {
            const int tr = tb + k * tstep; const bool live = tr < T; const int t = live ? tr : t0;
            {
                PV_ISSUE(k ^ 1, m[k ^ 1]);
                { const int tp = (tr + 3 * tstep < T) ? tr + 3 * tstep : t0; pv_load(m[k ^ 1], tp, g, col, PK, X2); }
                f32x2_ acc2[8];
#pragma unroll
                for (int i = 0; i < 8; ++i) acc2[i] = (f32x2_){0.f, 0.f};
#pragma unroll
                for (int i = 0; i < 16; ++i) { const float w_ = w[k][i];
#pragma unroll
                    for (int kk = 0; kk < 4; ++kk) { const f32x2_ lo = __builtin_amdgcn_cvt_pk_f32_fp8((int)q[k][i][kk], false), hi2 = __builtin_amdgcn_cvt_pk_f32_fp8((int)q[k][i][kk], true);
                        acc2[2 * kk] += lo * w_; acc2[2 * kk + 1] += hi2 * w_; } }
                const unsigned xw = xwv[k];
                float acc[16];
#pragma unroll
                for (int i = 0; i < 8; ++i) { acc[2 * i] = acc2[i].x; acc[2 * i + 1] = acc2[i].y; }
                float r8[8], r4[4], r2[2];
#pragma unroll
                for (int i = 0; i < 8; ++i) r8[i] = swap32_add(acc[i], acc[i + 8]);
#pragma unroll
                for (int i = 0; i < 4; ++i) r4[i] = swap16_add(r8[i], r8[i + 4]);
#pragma unroll
                for (int i = 0; i < 2; ++i) { const float sa = r4[i] + dpp_f<DPP_ROR8>(r4[i]), sb = r4[i + 2] + dpp_f<DPP_ROR8>(r4[i + 2]); r2[i] = b8 ? sb : sa; }
                const float y0 = bflo(xw) + r2[0], y1 = bfhi(xw) + r2[1];
                if (live) *(unsigned*)(X3 + (size_t)t * D + col) = pk2(y0, y1);
            }
        }
    }
#undef PV_ISSUE
}
__device__ __forceinline__ void final_norm(Frame& F) {
    const bf16* X3 = (const bf16*)(F.ws + WS_A); const float* SS3 = (const float*)(F.ws + WS_SS3); const float* gfin = F.in[25];
    int tid_ = threadIdx.x; asm volatile("" : "+v"(tid_)); const int lane = tid_ & 63;
    const int gw = F.vcu * NWAVES + F.wave, NGW = F.G * NWAVES;
    f32x4 gg[4];
#pragma unroll
    for (int i = 0; i < 4; ++i) gg[i] = *(const f32x4*)(gfin + 256 * i + 4 * lane);
    for (int t = 4 * gw; t < T; t += 4 * NGW) {
        uint2 v[4][4]; float tot[4];
#pragma unroll
        for (int r = 0; r < 4; ++r)
#pragma unroll
            for (int i = 0; i < 4; ++i) { typedef unsigned u32x2_ __attribute__((ext_vector_type(2))); const u32x2_ q_ = __builtin_nontemporal_load((const u32x2_*)(X3 + (size_t)(t + r) * D + 256 * i + 4 * lane)); v[r][i].x = q_[0]; v[r][i].y = q_[1]; }
#pragma unroll
        for (int r = 0; r < 4; ++r) { float a = 0.f;
#pragma unroll
            for (int i = 0; i < 4; ++i) { const float x0 = bflo(v[r][i].x), x1 = bfhi(v[r][i].x), x2 = bflo(v[r][i].y), x3 = bfhi(v[r][i].y); a += (x0 * x0 + x1 * x1) + (x2 * x2 + x3 * x3); }
            tot[r] = a; }
#pragma unroll
        for (int o = 1; o < 64; o <<= 1)
#pragma unroll
            for (int r = 0; r < 4; ++r) tot[r] += __shfl_xor(tot[r], o);
#pragma unroll
        for (int r = 0; r < 4; ++r) { const float rs = 1.f / sqrtf(tot[r] * (1.f / D) + EPS);
#pragma unroll
            for (int i = 0; i < 4; ++i) { f32x4 o; o[0] = bflo(v[r][i].x) * rs * gg[i][0]; o[1] = bfhi(v[r][i].x) * rs * gg[i][1]; o[2] = bflo(v[r][i].y) * rs * gg[i][2]; o[3] = bfhi(v[r][i].y) * rs * gg[i][3];
                __builtin_nontemporal_store(o, (f32x4*)(F.out + (size_t)(t + r) * D + 256 * i + 4 * lane)); } }
    }
}

#include <hip/hip_bf16.h>
#include <cmath>
namespace attn_body {
using bf16=__hip_bfloat16;
using bf16x8=__attribute__((ext_vector_type(8)))short;
using s16x4=__attribute__((ext_vector_type(4)))short;
using f32x16=__attribute__((ext_vector_type(16)))float;
using u32x4=__attribute__((ext_vector_type(4)))unsigned;
constexpr int BATCH=16,NHEAD=8,SEQ=2048,D=64,DM=2560,DMO=1024;
constexpr int NW=8,QBLK=32,QB=QBLK*NW,KVBLK=64,NQB=SEQ/QB;
constexpr int ATTN_PITCH=DM, ATTN_UNIT_ROWS=QB;
__device__ __forceinline__ int crow(int r,int hi){return (r&3)+8*(r>>2)+4*hi;}
#define SBAR() __builtin_amdgcn_sched_barrier(0)
__device__ __forceinline__ void cmask(f32x16&p0,f32x16&p1,int jb,int qrel,int hi){
  const float NEG=-INFINITY; int kb=64*jb+4*hi;
  #pragma unroll
  for(int r=0;r<16;++r){int kv=kb+(r&3)+8*(r>>2); if(kv>qrel)p0[r]=NEG; if(kv+32>qrel)p1[r]=NEG;}
}

constexpr int NSLOT=3, SLOTB=8192;
constexpr int LDS_K=0, LDS_V=NSLOT*SLOTB, LDS_WS=2*NSLOT*SLOTB, LDS_OST=LDS_WS+NW*128*4, LDS_SEL=LDS_OST+NW*4096, LDS_BYTES=LDS_SEL+16*QB*4;
constexpr float C2=0.125f*1.4426950408889634f;
__device__ __forceinline__ void glds16(const void*gsrc,unsigned lds_dst){unsigned keep;
  asm volatile("s_mov_b32 %0, m0\n\ts_mov_b32 m0, %2\n\ts_nop 0\n\tglobal_load_lds_dwordx4 %1, off\n\ts_mov_b32 m0, %0":"=&s"(keep):"v"(gsrc),"s"(lds_dst):"memory");}
__device__ __forceinline__ float max3f(float a,float b,float c){float r;asm("v_max3_f32 %0, %1, %2, %3":"=v"(r):"v"(a),"v"(b),"v"(c));return r;}
__device__ __forceinline__ float max2f(float a,float b){float r;asm("v_max_f32_e32 %0, %1, %2":"=v"(r):"v"(a),"v"(b));return r;}
__device__ __forceinline__ float fadd_s(float a,float b){float r;asm("v_add_f32_e32 %0, %1, %2":"=v"(r):"v"(a),"v"(b));return r;}
__device__ __forceinline__ float fsub_s(float a,float b){float r;asm("v_sub_f32_e32 %0, %1, %2":"=v"(r):"v"(a),"v"(b));return r;}
typedef float f32x2_t __attribute__((ext_vector_type(2))); typedef __bf16 bf16x2_t __attribute__((ext_vector_type(2)));
__device__ __forceinline__ unsigned cvtpk_s(float lo,float hi){f32x2_t v={lo,hi};bf16x2_t b=__builtin_convertvector(v,bf16x2_t);return __builtin_bit_cast(unsigned,b);}
#define WAIT_BAR(N) asm volatile("s_waitcnt vmcnt(" #N ") lgkmcnt(0)\n\ts_barrier":::"memory")

__device__ __forceinline__ void qkt(f32x16&p0,f32x16&p1,const char*Kslot,const bf16x8*qr,const f32x16&negm,int r32,int hi){
  const char*kb=Kslot+hi*1024+r32*16;
  #pragma unroll
  for(int d0=0;d0<4;++d0){
    const bf16x8 b0=*reinterpret_cast<const bf16x8*>(kb+d0*2048);
    const bf16x8 b1=*reinterpret_cast<const bf16x8*>(kb+d0*2048+512);
    if(d0==0){p0=__builtin_amdgcn_mfma_f32_32x32x16_bf16(b0,qr[0],negm,0,0,0);p1=__builtin_amdgcn_mfma_f32_32x32x16_bf16(b1,qr[0],negm,0,0,0);}
    else{p0=__builtin_amdgcn_mfma_f32_32x32x16_bf16(b0,qr[d0],p0,0,0,0);p1=__builtin_amdgcn_mfma_f32_32x32x16_bf16(b1,qr[d0],p1,0,0,0);}}
}
typedef __attribute__((address_space(3))) const char* lds_cptr;
typedef short v4i16_t __attribute__((ext_vector_type(4)));
__device__ __forceinline__ void kload8(bf16x8*kf,lds_cptr kp){
  kf[0]=*(const __attribute__((address_space(3))) bf16x8*)(kp);      kf[1]=*(const __attribute__((address_space(3))) bf16x8*)(kp+512);
  kf[2]=*(const __attribute__((address_space(3))) bf16x8*)(kp+2048); kf[3]=*(const __attribute__((address_space(3))) bf16x8*)(kp+2560);
  kf[4]=*(const __attribute__((address_space(3))) bf16x8*)(kp+4096); kf[5]=*(const __attribute__((address_space(3))) bf16x8*)(kp+4608);
  kf[6]=*(const __attribute__((address_space(3))) bf16x8*)(kp+6144); kf[7]=*(const __attribute__((address_space(3))) bf16x8*)(kp+6656);
}
__device__ __forceinline__ void kload2(bf16x8*kf,lds_cptr kp,int j){ kf[2*j]=*(const __attribute__((address_space(3))) bf16x8*)(kp+j*2048); kf[2*j+1]=*(const __attribute__((address_space(3))) bf16x8*)(kp+j*2048+512); }
__device__ __forceinline__ s16x4 vtr(lds_cptr p){ return __builtin_bit_cast(s16x4,__builtin_amdgcn_ds_read_tr16_b64_v4i16((__attribute__((address_space(3))) v4i16_t*)p)); }
__device__ __forceinline__ float rowmax(const f32x16&p0,const f32x16&p1){
  float a=max3f(p0[0],p0[1],p1[0]),b=max3f(p0[2],p0[3],p1[1]);a=max3f(a,p1[2],p1[3]);
  #pragma unroll
  for(int r=4;r<16;r+=4){a=max3f(a,p0[r],p0[r+1]);b=max3f(b,p0[r+2],p0[r+3]);a=max3f(a,p1[r],p1[r+1]);b=max3f(b,p1[r+2],p1[r+3]);}
  const float m=max2f(a,b);
  auto rr=__builtin_amdgcn_permlane32_swap(__float_as_uint(m),__float_as_uint(m),false,false);
  return max2f(__uint_as_float(rr[0]),__uint_as_float(rr[1]));
}
__device__ __forceinline__ void pv(f32x16*o,int vb,bf16x8 pa0,bf16x8 pa1,bf16x8 pa2,bf16x8 pa3){
  #pragma unroll
  for(int d0=0;d0<2;++d0){s16x4 lo[4],hi[4];
    #pragma unroll
    for(int ks=0;ks<4;++ks){
      asm volatile("ds_read_b64_tr_b16 %0,%1 offset:%c2":"=&v"(lo[ks]):"v"(vb),"i"(d0*4096+ks*1024):"memory");
      asm volatile("ds_read_b64_tr_b16 %0,%1 offset:%c2":"=&v"(hi[ks]):"v"(vb),"i"(d0*4096+ks*1024+512):"memory");}
    asm volatile("s_waitcnt lgkmcnt(0)":::"memory");SBAR();
    #define PK(k) (bf16x8){lo[k][0],lo[k][1],lo[k][2],lo[k][3],hi[k][0],hi[k][1],hi[k][2],hi[k][3]}
    o[d0]=__builtin_amdgcn_mfma_f32_32x32x16_bf16(pa0,PK(0),o[d0],0,0,0);
    o[d0]=__builtin_amdgcn_mfma_f32_32x32x16_bf16(pa1,PK(1),o[d0],0,0,0);
    o[d0]=__builtin_amdgcn_mfma_f32_32x32x16_bf16(pa2,PK(2),o[d0],0,0,0);
    o[d0]=__builtin_amdgcn_mfma_f32_32x32x16_bf16(pa3,PK(3),o[d0],0,0,0);
    #undef PK
  }
}

#ifndef ATTN_STORE16
#define ATTN_STORE16(p,v) (*(u32x4*)(p)=(v))
#endif
template<int THRL> __device__ __forceinline__ void attn_unit(int b,int h,int qb,const bf16*Q,const bf16*__restrict__ K,const bf16*__restrict__ V,bf16*O,float*SSA,int ui,char*shm){
  int tid_=threadIdx.x; asm volatile("":"+v"(tid_)); const int tid=tid_,lane=tid&63,r32=lane&31,hi=lane>>5; const int wid=__builtin_amdgcn_readfirstlane(tid>>6);
  if(wid>=4)__builtin_amdgcn_s_setprio(1);
  const long rowbase=(long)b*SEQ; const int q0=qb*QB;
  const bf16*Qw=Q+(rowbase+q0+wid*QBLK)*DM+h*D;
  const bf16*Kh=K+rowbase*DM+h*D,*Vh=V+rowbase*DM+h*D;
  const unsigned lds0=(unsigned)(uintptr_t)shm;
  float*wsf=(float*)(shm+LDS_WS)+wid*128; const unsigned*selp=(const unsigned*)(shm+LDS_SEL)+ui*QB+wid*QBLK+r32;

  const bf16*ksrc=Kh+(long)lane*DM+wid*8;
  const bf16*vsrc=Vh+(long)(16*(wid&3)+(lane>>2))*DM+(wid>>2)*32+(lane&3)*8;
  const unsigned kdst=lds0+LDS_K+wid*1024, vdst=lds0+LDS_V+wid*1024;
  const int tb4=4*qb;
  #define PHYS(t) (((t)<4)?(tb4+(t)):((t)-4))
  #define DMA_K(t,slot) glds16(ksrc+(long)PHYS(t)*KVBLK*DM,(unsigned)__builtin_amdgcn_readfirstlane(kdst+(slot)))
  #define DMA_V(t,slot) glds16(vsrc+(long)PHYS(t)*KVBLK*DM,(unsigned)__builtin_amdgcn_readfirstlane(vdst+(slot)))
  const int vb0=(int)(lds0+LDS_V)+((lane>>4)&1)*32+(lane&3)*8+(4*hi+((lane&15)>>2))*64;
  const char*Kbase=shm+LDS_K; bf16x8 kf[8];
  const lds_cptr shm3=(lds_cptr)shm; const lds_cptr kp0=shm3+LDS_K+hi*1024+r32*16; const lds_cptr vp0=shm3+LDS_V+((lane>>4)&1)*32+(lane&3)*8+(4*hi+((lane&15)>>2))*64;
  const int NT=(q0+QB)/KVBLK;
  DMA_K(0,0);DMA_V(0,0);DMA_K(1,SLOTB);
  bf16x8 qr[4];
  #pragma unroll
  for(int d0=0;d0<4;++d0)qr[d0]=*reinterpret_cast<const bf16x8*>(&Qw[(long)r32*DM+d0*16+hi*8]);

  float mhat=0.f,l_reg=0.f;f32x16 o[2];o[0]=f32x16{};o[1]=f32x16{};const f32x16 negm0=f32x16{};
  const int qrel=wid*QBLK+r32;
  #define CMASK(P0,P1,t) do{ if((t)<4){cmask(P0,P1,(t),qrel,hi);} }while(0)
  bool resc=false;
  #define START(P0,P1) do{ const float rm=rowmax(P0,P1); resc=false; \
    { const float dl=rm; mhat=fadd_s(mhat,dl); \
      _Pragma("unroll") for(int r=0;r<16;++r){P0[r]=fsub_s(P0[r],dl);P1[r]=fsub_s(P1[r],dl);} \
    } \
    _Pragma("unroll") for(int r=0;r<16;++r)P0[r]=__builtin_amdgcn_exp2f(P0[r]); }while(0)
  #define RESC() do{ if(resc){ asm volatile("s_waitcnt lgkmcnt(0)":::"memory"); \
      _Pragma("unroll") for(int d_=0;d_<2;++d_) _Pragma("unroll") for(int r=0;r<16;++r)o[d_][r]*=wsf[crow(r,hi)]; } }while(0)
  f32x16 pA0,pA1,pB0,pB1;
  int sl_prev=0,sl_cur=0,sl_next=SLOTB;
  #define ROT() do{sl_prev=sl_cur;sl_cur=sl_next;sl_next=(sl_next==(NSLOT-1)*SLOTB)?0:sl_next+SLOTB;}while(0)
  DMA_K(2,2*SLOTB);
  WAIT_BAR(3);
  qkt(pA0,pA1,Kbase,qr,negm0,r32,hi);asm volatile("s_nop 15\n\ts_nop 7":"+v"(pA0),"+v"(pA1));CMASK(pA0,pA1,0);
  START(pA0,pA1);
  _Pragma("unroll") for(int r=0;r<16;++r)pA1[r]=__builtin_amdgcn_exp2f(pA1[r]);
  WAIT_BAR(0);
  DMA_K(3,0);DMA_V(1,SLOTB);
  ROT();
  kload8(kf,kp0+sl_cur);
  WAIT_BAR(2);
  s16x4 vlo[8],vhi[8]; u32x4 pw0,pw1,pw2,pw3;
  #define PKW(P,B) cvtpk_s(P[B],P[B+1])
  #define PAF(k) __builtin_bit_cast(bf16x8,pw##k)
  #define VFR(i) (bf16x8){vlo[i][0],vlo[i][1],vlo[i][2],vlo[i][3],vhi[i][0],vhi[i][1],vhi[i][2],vhi[i][3]}
  #define PIN(x) asm volatile("":"+v"(x))
  #define MX3(a,b,c) __builtin_fmaxf(__builtin_fmaxf((a),(b)),(c))
  #define GAPA(MF,A0,A1,A2,A3,W0,W1,PW) do{ MF; sacc+=A0; sacc+=A1; sacc+=A2; sacc+=A3; PIN(sacc); W0; W1; PIN(PW); SBAR(); }while(0)
  #define EX(v) __builtin_amdgcn_exp2f(v)
  #define GAPB(MF,X,B) do{ MF; X[B]=EX(X[B]); X[B+1]=EX(X[B+1]); X[B+2]=EX(X[B+2]); X[B+3]=EX(X[B+3]); PIN(X); SBAR(); }while(0)
  #define VRD(i) do{ vlo[i]=vtr(vp_+(((i)>>2)*4096+((i)&3)*1024)); vhi[i]=vtr(vp_+(((i)>>2)*4096+((i)&3)*1024+512)); }while(0)
  #define KRD(G,j) do{ if(G){ kload2(kf,kp0+sl_next,j); SBAR(); } }while(0)
  #define STEP(C0,C1,P0,P1,t,GK,GV,GL) do{ SBAR(); \
    const lds_cptr vp_=vp0+sl_prev; \
    float sacc; { const unsigned sw_=*selp; const float nm_=((sw_>>(((t)<4)?31:((((t)-4)>>2)&7)))&1u)?-mhat:-1.0e30f; f32x16 negm; _Pragma("unroll") for(int r=0;r<16;++r)negm[r]=nm_; asm volatile("":"+v"(negm)); \
    VRD(0); SBAR(); sacc=(P0[0]+P0[1]); \
    GAPA(C0=__builtin_amdgcn_mfma_f32_32x32x16_bf16(kf[0],qr[0],negm,0,0,0), P0[2],P0[3],P0[4],P0[5],     pw0[0]=PKW(P0,0), pw0[1]=PKW(P0,2), pw0); \
    VRD(4); SBAR(); GAPA(C1=__builtin_amdgcn_mfma_f32_32x32x16_bf16(kf[1],qr[0],negm,0,0,0), P0[6],P0[7],P0[8],P0[9],     pw0[2]=PKW(P0,4), pw0[3]=PKW(P0,6), pw0); \
    } \
    VRD(1); SBAR(); GAPA(C0=__builtin_amdgcn_mfma_f32_32x32x16_bf16(kf[2],qr[1],C0,0,0,0),   P0[10],P0[11],P0[12],P0[13], pw1[0]=PKW(P0,8), pw1[1]=PKW(P0,10), pw1); \
    VRD(5); SBAR(); GAPA(C1=__builtin_amdgcn_mfma_f32_32x32x16_bf16(kf[3],qr[1],C1,0,0,0),   P0[14],P0[15],P1[0],P1[1],   pw1[2]=PKW(P0,12),pw1[3]=PKW(P0,14), pw1); \
    VRD(2); SBAR(); GAPA(C0=__builtin_amdgcn_mfma_f32_32x32x16_bf16(kf[4],qr[2],C0,0,0,0),   P1[2],P1[3],P1[4],P1[5],     pw2[0]=PKW(P1,0), pw2[1]=PKW(P1,2), pw2); \
    VRD(6); SBAR(); GAPA(C1=__builtin_amdgcn_mfma_f32_32x32x16_bf16(kf[5],qr[2],C1,0,0,0),   P1[6],P1[7],P1[8],P1[9],     pw2[2]=PKW(P1,4), pw2[3]=PKW(P1,6), pw2); \
    VRD(3); SBAR(); GAPA(C0=__builtin_amdgcn_mfma_f32_32x32x16_bf16(kf[6],qr[3],C0,0,0,0),   P1[10],P1[11],P1[12],P1[13], pw3[0]=PKW(P1,8), pw3[1]=PKW(P1,10), pw3); \
    VRD(7); SBAR(); GAPA(C1=__builtin_amdgcn_mfma_f32_32x32x16_bf16(kf[7],qr[3],C1,0,0,0),   P1[14],P1[15],0.f,0.f,       pw3[2]=PKW(P1,12),pw3[3]=PKW(P1,14), pw3); \
    l_reg+=sacc; \
    if(GK){DMA_K((t)+3,sl_cur);} if(GV){DMA_V((t)+1,sl_next);} \
    CMASK(C0,C1,t); \
    { float a=MX3(C0[0],C0[1],C1[0]),b=MX3(C0[2],C0[3],C1[1]); a=MX3(a,C1[2],C1[3]); \
      _Pragma("unroll") for(int r=4;r<16;r+=4){a=MX3(a,C0[r],C0[r+1]);b=MX3(b,C0[r+2],C0[r+3]);a=MX3(a,C1[r],C1[r+1]);b=MX3(b,C1[r+2],C1[r+3]);} \
      float rm=__builtin_fmaxf(a,b); { auto rr=__builtin_amdgcn_permlane32_swap(__float_as_uint(rm),__float_as_uint(rm),false,false); rm=__builtin_fmaxf(__uint_as_float(rr[0]),__uint_as_float(rr[1])); } \
      resc=false; \
      if(__builtin_expect(__any(rm>(float)THRL),0)){ const float dl=__builtin_fmaxf(rm,0.f); mhat+=dl; \
        _Pragma("unroll") for(int r=0;r<16;++r){C0[r]-=dl;C1[r]-=dl;} \
        const float f=__builtin_amdgcn_exp2f(-dl); l_reg*=f; if(hi==0)wsf[r32]=f; resc=true; } } \
    SBAR(); \
    GAPB(o[0]=__builtin_amdgcn_mfma_f32_32x32x16_bf16(PAF(0),VFR(0),o[0],0,0,0), C0,0); \
    GAPB(o[1]=__builtin_amdgcn_mfma_f32_32x32x16_bf16(PAF(0),VFR(4),o[1],0,0,0), C0,4); \
    KRD(GL,0); GAPB(o[0]=__builtin_amdgcn_mfma_f32_32x32x16_bf16(PAF(1),VFR(1),o[0],0,0,0), C0,8); \
    KRD(GL,1); GAPB(o[1]=__builtin_amdgcn_mfma_f32_32x32x16_bf16(PAF(1),VFR(5),o[1],0,0,0), C0,12); \
    KRD(GL,2); GAPB(o[0]=__builtin_amdgcn_mfma_f32_32x32x16_bf16(PAF(2),VFR(2),o[0],0,0,0), C1,0); \
    KRD(GL,3); GAPB(o[1]=__builtin_amdgcn_mfma_f32_32x32x16_bf16(PAF(2),VFR(6),o[1],0,0,0), C1,4); \
    GAPB(o[0]=__builtin_amdgcn_mfma_f32_32x32x16_bf16(PAF(3),VFR(3),o[0],0,0,0), C1,8); \
    GAPB(o[1]=__builtin_amdgcn_mfma_f32_32x32x16_bf16(PAF(3),VFR(7),o[1],0,0,0), C1,12); \
    }while(0)
  int t=1;
  for(;t+5<NT;t+=2){
    STEP(pB0,pB1,pA0,pA1,t,true,true,true);     WAIT_BAR(2); RESC(); ROT();
    STEP(pA0,pA1,pB0,pB1,t+1,true,true,true);   WAIT_BAR(2); RESC(); ROT();
  }
  #define ENDW(tt) do{ if((tt)+3<NT){WAIT_BAR(2);} else if((tt)+2<NT){WAIT_BAR(1);} else {WAIT_BAR(0);} }while(0)
  for(;t+1<NT;t+=2){
    STEP(pB0,pB1,pA0,pA1,t,(t+3<NT),(t+1<NT),(t+1<NT));       ENDW(t);   RESC(); ROT();
    STEP(pA0,pA1,pB0,pB1,t+1,(t+4<NT),(t+2<NT),(t+2<NT));     ENDW(t+1); RESC(); ROT();
  }
  STEP(pB0,pB1,pA0,pA1,NT-1,false,false,false); RESC();
  { float sacc=pB0[0]+pB0[1]; _Pragma("unroll") for(int r=2;r<16;++r)sacc+=pB0[r]; _Pragma("unroll") for(int r=0;r<16;++r)sacc+=pB1[r]; l_reg+=sacc;
    pw0=(u32x4){PKW(pB0,0),PKW(pB0,2),PKW(pB0,4),PKW(pB0,6)};pw1=(u32x4){PKW(pB0,8),PKW(pB0,10),PKW(pB0,12),PKW(pB0,14)};pw2=(u32x4){PKW(pB1,0),PKW(pB1,2),PKW(pB1,4),PKW(pB1,6)};pw3=(u32x4){PKW(pB1,8),PKW(pB1,10),PKW(pB1,12),PKW(pB1,14)};
    SBAR(); pv(o,vb0+sl_cur,PAF(0),PAF(1),PAF(2),PAF(3)); }
  #undef PKW
  #undef PAF
  #undef VFR
  #undef PIN
  #undef MX3
  #undef GAPA
  #undef GAPB
  #undef EX
  #undef VRD
  #undef KRD
  #undef STEP
  #undef ENDW
  {auto rr=__builtin_amdgcn_permlane32_swap(__float_as_uint(l_reg),__float_as_uint(l_reg),false,false);l_reg=__uint_as_float(rr[0])+__uint_as_float(rr[1]);}
  if(hi==0)wsf[32+r32]=l_reg;asm volatile("s_waitcnt lgkmcnt(0)":::"memory");
  float rli[16];
  #pragma unroll
  for(int r=0;r<16;++r)rli[r]=__builtin_amdgcn_rcpf(wsf[32+crow(r,hi)]);
  bf16*Ow=O+(rowbase+q0+wid*QBLK)*DMO+h*D;
  { bf16*stg=(bf16*)(shm+LDS_OST)+wid*2048;
    #pragma unroll
    for(int r=0;r<16;++r){const int orow=crow(r,hi);
      #pragma unroll
      for(int d0=0;d0<2;++d0)stg[orow*64+d0*32+r32]=__float2bfloat16(o[d0][r]*rli[r]);}
    asm volatile("s_waitcnt lgkmcnt(0)":::"memory");
    #pragma unroll
    for(int i=0;i<4;++i){const int row=i*8+(lane>>3),ch=lane&7; const u32x4 v=*(const u32x4*)(stg+row*64+ch*8); ATTN_STORE16(Ow+(long)row*DMO+ch*8,v);
      float sq=0.f;
      #pragma unroll
      for(int e=0;e<4;++e){const float lo_=__uint_as_float(v[e]<<16),hi_=__uint_as_float(v[e]&0xffff0000u); sq+=lo_*lo_+hi_*hi_;}
      sq+=__shfl_xor(sq,1); sq+=__shfl_xor(sq,2); sq+=__shfl_xor(sq,4);
      if(ch==0)SSA[(rowbase+q0+wid*QBLK+row)*8+h]=sq; } }
  __builtin_amdgcn_s_setprio(0);
  asm volatile("s_waitcnt lgkmcnt(0)\n\ts_barrier":::"memory");
  #undef DMA_K
  #undef DMA_V
  #undef PHYS
  #undef CMASK
  #undef START
  #undef RESC
  #undef ROT
}
constexpr int ATTN_LDS_BYTES=LDS_BYTES;
struct AttnTensors { const bf16* Q; const bf16* K; const bf16* V; bf16* O; const float* KM; float* SSA; };
struct AttnUnit { int bh; int qb; };
struct StaticOrder {
  int vcu,G;
  __device__ __forceinline__ explicit StaticOrder(int grid,int block):vcu((grid%8==0)?((block%8)*(grid/8)+block/8):block),G(grid){}
  __device__ __forceinline__ bool next(int i,AttnUnit&u)const{ const int it=(i>>2)*G+vcu; if(it>=2*BATCH*NHEAD)return false; const int j=i&3,s=it&1; u.bh=it>>1; u.qb=s?((j==0)?6:(j==1)?5:(j==2)?2:1):((j==0)?7:(j==1)?4:(j==2)?3:0); return true; }
  __device__ __forceinline__ void a_ready(const AttnUnit&)const{}
  __device__ __forceinline__ void done(const AttnUnit&)const{}
};
__device__ __forceinline__ void attn_select(int b,int h,int qb,const bf16*Q,const float*__restrict__ KM,int ui,char*shm){
  int tid_=threadIdx.x; asm volatile("":"+v"(tid_)); const int tid=tid_,lane=tid&63,r32=lane&31,hi=lane>>5; const int wid=__builtin_amdgcn_readfirstlane(tid>>6);
  unsigned*selw=(unsigned*)(shm+LDS_SEL)+ui*QB+wid*QBLK+r32; float*kml=(float*)(shm+LDS_K);
  unsigned word=0xffffffffu;
  if(qb>3){
    if(tid<qb*64){ const long ki=((long)(b*NHEAD+h)*8)*64+tid; kml[tid]=(KM[ki]+KM[(long)BATCH*NHEAD*8*64+ki])*(1.0f/256.0f); }
    const bf16*qrow=Q+((long)b*SEQ+qb*QB+wid*QBLK+r32)*DM+h*D+hi*8; uint4 qv[4];
    #pragma unroll
    for(int d0=0;d0<4;++d0)qv[d0]=*reinterpret_cast<const uint4*>(qrow+d0*16);
    asm volatile("s_waitcnt vmcnt(0) lgkmcnt(0)\n\ts_barrier":::"memory");
    float g1=-3.0e38f,g2=-3.0e38f,g3=-3.0e38f; int i1=0,i2=0,i3=0;
    #pragma unroll 1
    for(int n=0;n<qb;++n){ const float*km=kml+n*64+hi*8; float a=0.f;
      #pragma unroll
      for(int d0=0;d0<4;++d0){ const float4 k0=*(const float4*)(km+d0*16),k1=*(const float4*)(km+d0*16+4); const uint4 q4=qv[d0];
        a+=__uint_as_float(q4.x<<16)*k0.x+__uint_as_float(q4.x&0xffff0000u)*k0.y+__uint_as_float(q4.y<<16)*k0.z+__uint_as_float(q4.y&0xffff0000u)*k0.w
          +__uint_as_float(q4.z<<16)*k1.x+__uint_as_float(q4.z&0xffff0000u)*k1.y+__uint_as_float(q4.w<<16)*k1.z+__uint_as_float(q4.w&0xffff0000u)*k1.w; }
      a+=__shfl_xor(a,32);
      if(a>g1){g3=g2;i3=i2;g2=g1;i2=i1;g1=a;i1=n;} else if(a>g2){g3=g2;i3=i2;g2=a;i2=n;} else if(a>g3){g3=a;i3=n;} }
    word=0x80000000u|(1u<<i1)|(1u<<i2)|(1u<<i3); }
  if(hi==0)*selw=word;
  asm volatile("s_waitcnt lgkmcnt(0)\n\ts_barrier":::"memory");
}
__device__ __forceinline__ int attn_qb(int role,int j){ return role?((j==0)?5:(j==1)?4:(j==2)?2:0):((j==0)?7:(j==1)?6:(j==2)?3:1); }
template<int THRL=8> __device__ __forceinline__ void attn_item(char*lds,const AttnTensors&T,int it){
  const int bh=it>>1,role=it&1,b=bh/NHEAD,h=bh%NHEAD; const int nu=4;
  for(int j=0;j<nu;++j)attn_select(b,h,attn_qb(role,j),T.Q,T.KM,j,lds);
  for(int j=0;j<nu;++j)attn_unit<THRL>(b,h,attn_qb(role,j),T.Q,T.K,T.V,T.O,T.SSA,j,lds);
}
template<class Sched,int THRL=8> __device__ __forceinline__ void attn_phase(char*lds,const AttnTensors&T,const Sched&S){
  AttnUnit u;
  for(int i=0;i<16&&S.next(i,u);++i)attn_select(u.bh/NHEAD,u.bh%NHEAD,u.qb,T.Q,T.KM,i,lds);
  for(int i=0;i<16&&S.next(i,u);++i){ S.a_ready(u); attn_unit<THRL>(u.bh/NHEAD,u.bh%NHEAD,u.qb,T.Q,T.K,T.V,T.O,T.SSA,i,lds); S.done(u); }
}
#undef SBAR
#undef WAIT_BAR
}

namespace cross_body {
typedef short bf16x8 __attribute__((ext_vector_type(8)));
typedef float f32x4 __attribute__((ext_vector_type(4)));
typedef unsigned u32x2 __attribute__((ext_vector_type(2)));
typedef unsigned u32x4 __attribute__((ext_vector_type(4)));
#define CB_LAS __attribute__((address_space(3)))
constexpr int TILE_OFF = 0, PW_OFF = 65536, LDS_BYTES = 65536 + 8 * 8192;
#define CB_BAR() asm volatile("s_waitcnt lgkmcnt(0)\n\ts_barrier" ::: "memory")
#define CB_VMWAIT() asm volatile("s_waitcnt vmcnt(0)" ::: "memory")
__device__ __forceinline__ void cross_stage(CB_LAS unsigned char* buf, const unsigned short* KC, const unsigned short* VT, int b, int hd, int i, int wid, const unsigned (&voK)[4], const unsigned (&voV)[4]) {
    if (i < 4) { const unsigned short* base = KC + (size_t)(b * 256 + 64 * i) * 1024 + hd * 256;
#pragma unroll
        for (int q = 0; q < 4; ++q) __builtin_amdgcn_global_load_lds((const unsigned*)(base + voK[q]), (CB_LAS unsigned*)(buf + (wid * 4 + q) * 1024), 16, 0, 0);
    } else { const unsigned short* base = VT + (size_t)(hd * 256) * 4096 + b * 256 + 64 * (i - 4);
#pragma unroll
        for (int q = 0; q < 4; ++q) __builtin_amdgcn_global_load_lds((const unsigned*)(base + voV[q]), (CB_LAS unsigned*)(buf + (wid * 4 + q) * 1024), 16, 0, 0);
    }
}
__device__ __forceinline__ void cross_unit(CB_LAS unsigned char* lds, const unsigned short* QC, const unsigned short* KC, const unsigned short* VT, unsigned short* OC, int b, int hd, int t0, bf16x8 (&qf)[8], bool first, bool has_next, int nb_, int nhd, int nt0, int zz = 0) {
    const int tid = threadIdx.x + zz, lane = tid & 63, n = lane & 15, g = lane >> 4; const int wid = __builtin_amdgcn_readfirstlane(tid >> 6);
    CB_LAS unsigned char* pw = lds + PW_OFF + wid * 8192;
    unsigned voK[4], voV[4];
#pragma unroll
    for (int q = 0; q < 4; ++q) { const int off = (wid * 4 + q) * 1024 + lane * 16; { const int row = off >> 9, c = (off >> 4) & 31, sc = c ^ (row & 15); voK[q] = (unsigned)(row * 1024 + 8 * sc); }
        { const int row = off >> 7, c = (off >> 4) & 7, sc = c ^ ((row >> 1) & 7); voV[q] = (unsigned)(row * 4096 + 8 * sc); } }
    if (first) {
        CB_BAR();
        cross_stage(lds + TILE_OFF, KC, VT, b, hd, 0, wid, voK, voV);
        const unsigned short* qrow = QC + (size_t)(t0 + wid * 16 + n) * 1024 + hd * 256 + 8 * g;
#pragma unroll
        for (int ks = 0; ks < 8; ++ks) qf[ks] = *(const bf16x8*)(qrow + 32 * ks);
    }
    f32x4 s[16];
#pragma unroll
    for (int i = 0; i < 16; ++i) s[i] = (f32x4){0.f, 0.f, 0.f, 0.f};
#pragma unroll
    for (int kt = 0; kt < 4; ++kt) {
        CB_LAS unsigned char* tile = lds + TILE_OFF + (kt & 1) * 32768;
        CB_VMWAIT(); CB_BAR();
        cross_stage(lds + TILE_OFF + ((kt + 1) & 1) * 32768, KC, VT, b, hd, kt + 1, wid, voK, voV);
#pragma unroll
        for (int nb = 0; nb < 4; ++nb) { const int row = 16 * nb + n;
#pragma unroll
            for (int ks = 0; ks < 8; ++ks) { const bf16x8 kf = *(const CB_LAS bf16x8*)(tile + row * 512 + (((4 * ks + g) ^ (row & 15)) << 4));
                s[kt * 4 + nb] = __builtin_amdgcn_mfma_f32_16x16x32_bf16(kf, qf[ks], s[kt * 4 + nb], 0, 0, 0); }
            if (nb & 1) __builtin_amdgcn_sched_barrier(0); }
    }
    float mx = -3.0e38f;
#pragma unroll
    for (int i = 0; i < 16; ++i) mx = fmaxf(mx, fmaxf(fmaxf(s[i][0], s[i][1]), fmaxf(s[i][2], s[i][3])));
    mx = fmaxf(mx, __shfl_xor(mx, 16)); mx = fmaxf(mx, __shfl_xor(mx, 32));
    const float c2 = 0.0625f * 1.4426950408889634f; float l = 0.f;
#pragma unroll
    for (int i = 0; i < 16; ++i) {
        f32x4 p; p[0] = __builtin_amdgcn_exp2f((s[i][0] - mx) * c2); p[1] = __builtin_amdgcn_exp2f((s[i][1] - mx) * c2); p[2] = __builtin_amdgcn_exp2f((s[i][2] - mx) * c2); p[3] = __builtin_amdgcn_exp2f((s[i][3] - mx) * c2);
        l += (p[0] + p[1]) + (p[2] + p[3]);
        u32x2 w; w.x = pg8::cvt_pk_bf16(p[0], p[1]); w.y = pg8::cvt_pk_bf16(p[2], p[3]);
        *(CB_LAS u32x2*)(pw + n * 512 + (((2 * i + (g >> 1)) ^ n) << 4) + ((g & 1) << 3)) = w;
    }
    l += __shfl_xor(l, 16); l += __shfl_xor(l, 32);
    const float linv = 1.0f / l;
    f32x4 o[16];
#pragma unroll
    for (int i = 0; i < 16; ++i) o[i] = (f32x4){0.f, 0.f, 0.f, 0.f};
#pragma unroll
    for (int kt = 0; kt < 4; ++kt) {
        CB_LAS unsigned char* tile = lds + TILE_OFF + (kt & 1) * 32768;
        CB_VMWAIT(); CB_BAR();
        if (kt < 3) cross_stage(lds + TILE_OFF + ((kt + 1) & 1) * 32768, KC, VT, b, hd, 5 + kt, wid, voK, voV);
        else if (has_next) {
            cross_stage(lds + TILE_OFF, KC, VT, nb_, nhd, 0, wid, voK, voV);
            const unsigned short* qrow = QC + (size_t)(nt0 + wid * 16 + n) * 1024 + nhd * 256 + 8 * g;
#pragma unroll
            for (int ks = 0; ks < 8; ++ks) qf[ks] = *(const bf16x8*)(qrow + 32 * ks); }
        bf16x8 pf[2];
#pragma unroll
        for (int ks = 0; ks < 2; ++ks) pf[ks] = *(const CB_LAS bf16x8*)(pw + n * 512 + (((8 * kt + 4 * ks + g) ^ n) << 4));
#pragma unroll
        for (int db = 0; db < 16; ++db) { const int row = 16 * db + n;
#pragma unroll
            for (int ks = 0; ks < 2; ++ks) { const bf16x8 vf = *(const CB_LAS bf16x8*)(tile + row * 128 + (((4 * ks + g) ^ ((row >> 1) & 7)) << 4));
                o[db] = __builtin_amdgcn_mfma_f32_16x16x32_bf16(vf, pf[ks], o[db], 0, 0, 0); }
            if ((db & 7) == 7) __builtin_amdgcn_sched_barrier(0); }
    }
    asm volatile("s_waitcnt lgkmcnt(0)" ::: "memory");
#pragma unroll
    for (int db = 0; db < 16; ++db) { u32x2 w; w.x = pg8::cvt_pk_bf16(o[db][0] * linv, o[db][1] * linv); w.y = pg8::cvt_pk_bf16(o[db][2] * linv, o[db][3] * linv);
        *(CB_LAS u32x2*)(pw + n * 512 + (((2 * db + (g >> 1)) ^ n) << 4) + ((g & 1) << 3)) = w; }
    asm volatile("s_waitcnt lgkmcnt(0)" ::: "memory");
#pragma unroll
    for (int i = 0; i < 8; ++i) { const int row = 2 * i + (lane >> 5), c = lane & 31; const u32x4 v = *(const CB_LAS u32x4*)(pw + row * 512 + ((c ^ row) << 4));
        *(u32x4*)(OC + (size_t)(t0 + wid * 16 + row) * 1024 + hd * 256 + 8 * c) = v; }
    asm volatile("s_waitcnt lgkmcnt(0)" ::: "memory");
}
__device__ __forceinline__ void cross_phase(CB_LAS unsigned char* lds, const unsigned short* QC, const unsigned short* KC, const unsigned short* VT, unsigned short* OC, int vcu, int G) {
    bf16x8 qf[8]; bool first = true;
    for (int u = vcu; u < 16 * 4 * 16; u += G) { const int tt = u & 15, hd = (u >> 4) & 3, b = u >> 6; const int un = u + G; const bool hn = un < 16 * 4 * 16;
        cross_unit(lds, QC, KC, VT, OC, b, hd, b * 2048 + tt * 128, qf, first, hn, un >> 6, (un >> 4) & 3, (un >> 6) * 2048 + (un & 15) * 128); first = false; }
    CB_VMWAIT(); CB_BAR();
}
#undef CB_BAR
#undef CB_VMWAIT
#undef CB_LAS
}

namespace route_body {
typedef short bf16x8 __attribute__((ext_vector_type(8)));
typedef float f32x4 __attribute__((ext_vector_type(4)));
typedef unsigned u32x2 __attribute__((ext_vector_type(2)));
typedef unsigned u32x4 __attribute__((ext_vector_type(4)));
#define RB_LAS __attribute__((address_space(3)))
constexpr int SUB_OFF = 0, LIST_OFF = 65536, LDS_BYTES = 65536 + 8 * 2048;
__device__ __forceinline__ unsigned ordf(float f) { return __float_as_uint(f); }
__device__ __forceinline__ float unordf(unsigned k) { return __uint_as_float(k); }
__device__ __forceinline__ unsigned umax_(unsigned a, unsigned b) { unsigned r; asm("v_max_f32 %0, %1, %2" : "=v"(r) : "v"(a), "v"(b)); return r; }
__device__ __forceinline__ unsigned umin_(unsigned a, unsigned b) { unsigned r; asm("v_min_f32 %0, %1, %2" : "=v"(r) : "v"(a), "v"(b)); return r; }
#define RB_CE(x, i, l) do { const unsigned hi_ = umax_(x[i], x[l]), lo_ = umin_(x[i], x[l]); x[i] = hi_; x[l] = lo_; } while (0)
#define RB_CEA(x, i, l) do { const unsigned hi_ = umax_(x[i], x[l]), lo_ = umin_(x[i], x[l]); x[i] = lo_; x[l] = hi_; } while (0)
__device__ __forceinline__ void sort16(unsigned (&x)[16]) {
#pragma unroll
    for (int p = 1; p < 16; p <<= 1)
#pragma unroll
        for (int k = p; k >= 1; k >>= 1)
#pragma unroll
            for (int j = k % p; j <= 15 - k; j += 2 * k)
#pragma unroll
                for (int i = 0; i <= ((k - 1) < (15 - j - k) ? (k - 1) : (15 - j - k)); ++i)
                    if ((i + j) / (2 * p) == (i + j + k) / (2 * p)) RB_CE(x, i + j, i + j + k);
}
__device__ __forceinline__ void bmerge16(unsigned (&x)[16]) {
#pragma unroll
    for (int j = 8; j > 0; j >>= 1)
#pragma unroll
        for (int i = 0; i < 16; ++i) { const int l = i ^ j; if (l > i) RB_CE(x, i, l); }
}
__device__ __forceinline__ void mergetop(unsigned (&a)[16], const unsigned (&b)[16]) {
#pragma unroll
    for (int i = 0; i < 16; ++i) a[i] = umax_(a[i], b[15 - i]);
    bmerge16(a);
}
__device__ __forceinline__ void xmergetop(unsigned (&a)[16], int mask) {
    unsigned b[16];
#pragma unroll
    for (int i = 0; i < 16; ++i) b[i] = (unsigned)__shfl_xor((int)a[i], mask);
    mergetop(a, b);
}
__device__ __forceinline__ unsigned cand(float fa, float fb, int i, int j) { return (ordf(fa + fb) & ~0xFFu) | (unsigned)(255 - (i * 16 + j)); }

struct StrideTiles { int first, step, n; __device__ __forceinline__ int count() const { return n; } __device__ __forceinline__ int at(int k) const { return first + k * step; } };
struct PanelTiles { int pm0, pm1; __device__ __forceinline__ int count() const { return 4; } __device__ __forceinline__ int at(int k) const { return 2 * ((k >> 1) ? pm1 : pm0) + (k & 1); } };
template <class ST, class TT> __device__ __forceinline__ void route_phase(RB_LAS unsigned char* lds, const unsigned short* PQ, const unsigned short* SUBK, unsigned short* IDS, float* GATES, int h, const TT& tts, ST& st, bool drain) {
    const int tid = threadIdx.x, lane = tid & 63, n = lane & 15, g = lane >> 4; const int wid = __builtin_amdgcn_readfirstlane(tid >> 6);
    RB_LAS unsigned char* sub = lds + SUB_OFF; RB_LAS unsigned* lst = (RB_LAS unsigned*)(lds + LIST_OFF + wid * 2048) + n * 32;
    __syncthreads();
#pragma unroll
    for (int i = 0; i < 8; ++i) { const int off = (wid * 8 + i) * 1024 + lane * 16, R = off >> 8, c = (off >> 4) & 15, sc = c ^ (R & 15);
        __builtin_amdgcn_global_load_lds((const unsigned*)(SUBK + ((size_t)h * 256 + R) * 128 + 8 * sc), (RB_LAS unsigned*)(sub + (wid * 8 + i) * 1024), 16, 0, 0); }
    asm volatile("s_waitcnt vmcnt(0)" ::: "memory");
    __syncthreads();
    bf16x8 qf[8];
    { const unsigned short* qrow = PQ + (size_t)(tts.at(0) * 128 + wid * 16 + n) * 2048 + h * 256 + 8 * g;
#pragma unroll
      for (int ks = 0; ks < 8; ++ks) qf[ks] = *(const bf16x8*)(qrow + 32 * ks); }
    unsigned short pid[4]; f32x4 pgate; int pt = -1;
    for (int ti = 0; ti < tts.count(); ++ti) { const int tt = tts.at(ti);
        const int t = tt * 128 + wid * 16 + n;
        unsigned key[2][2][16];
#pragma unroll
        for (int p = 0; p < 2; ++p)
#pragma unroll
            for (int kblk = 0; kblk < 8; ++kblk) { const int R = p * 128 + 16 * kblk + n; f32x4 s = (f32x4){0.f, 0.f, 0.f, 0.f};
#pragma unroll
                for (int ks = 0; ks < 4; ++ks) { const bf16x8 kf = *(const RB_LAS bf16x8*)(sub + R * 256 + (((4 * ks + g) ^ (R & 15)) << 4));
                    s = __builtin_amdgcn_mfma_f32_16x16x32_bf16(kf, qf[p * 4 + ks], s, 0, 0, 0); }
#pragma unroll
                for (int r = 0; r < 4; ++r) key[p][kblk >> 2][(kblk & 3) * 4 + r] = (ordf(s[r]) & ~0x7Fu) | (unsigned)(127 - (16 * kblk + 4 * g + r)); }
        { const int tn_ = (ti + 1 < tts.count()) ? tts.at(ti + 1) : tts.at(0); const unsigned short* qrow = PQ + (size_t)(tn_ * 128 + wid * 16 + n) * 2048 + h * 256 + 8 * g;
#pragma unroll
          for (int ks = 0; ks < 8; ++ks) qf[ks] = *(const bf16x8*)(qrow + 32 * ks); }
        if (pt >= 0) {
#pragma unroll
            for (int r = 0; r < 4; ++r) { const int k = 4 * g + r; IDS[(size_t)pt * 128 + (k & 7) * 16 + 2 * h + (k >> 3)] = pid[r]; }
            *(f32x4*)(GATES + (size_t)pt * 128 + h * 16 + 4 * g) = pgate; }
        const bool shave = st.k < st.count; if (shave) st.issue(st.k);
        unsigned top[2][16];
#pragma unroll
        for (int p = 0; p < 2; ++p) {
            sort16(key[p][0]); sort16(key[p][1]); mergetop(key[p][0], key[p][1]); xmergetop(key[p][0], 16); xmergetop(key[p][0], 32);
#pragma unroll
            for (int i = 0; i < 16; ++i) top[p][i] = key[p][0][i];
        }
#pragma unroll
        for (int r = 0; r < 4; ++r) { const unsigned va = g == 0 ? top[0][r] : g == 1 ? top[0][4 + r] : g == 2 ? top[0][8 + r] : top[0][12 + r];
            const unsigned vb = g == 0 ? top[1][r] : g == 1 ? top[1][4 + r] : g == 2 ? top[1][8 + r] : top[1][12 + r]; lst[4 * g + r] = va; lst[16 + 4 * g + r] = vb; }
        float fa[16], fb[16];
#pragma unroll
        for (int i = 0; i < 16; ++i) { fa[i] = unordf(top[0][i] & ~0x7Fu); fb[i] = unordf(top[1][i] & ~0x7Fu); }
        unsigned c[16];
#pragma unroll
        for (int i = 0; i < 16; ++i) c[i] = 0xFF800000u;
        if (g == 0) {
#pragma unroll
            for (int j = 0; j < 16; ++j) c[j] = cand(fa[0], fb[j], 0, j);
        } else if (g == 1) {
#pragma unroll
            for (int j = 0; j < 8; ++j) c[j] = cand(fa[1], fb[j], 1, j);
#pragma unroll
            for (int j = 0; j < 3; ++j) c[8 + j] = cand(fa[4], fb[j], 4, j);
            c[11] = cand(fa[8], fb[0], 8, 0); c[12] = cand(fa[9], fb[0], 9, 0); c[13] = cand(fa[10], fb[0], 10, 0);
        } else if (g == 2) {
#pragma unroll
            for (int j = 0; j < 5; ++j) c[j] = cand(fa[2], fb[j], 2, j);
#pragma unroll
            for (int j = 0; j < 4; ++j) c[5 + j] = cand(fa[3], fb[j], 3, j);
#pragma unroll
            for (int i = 11; i < 16; ++i) c[9 + (i - 11)] = cand(fa[i], fb[0], i, 0);
        } else {
#pragma unroll
            for (int i = 5; i < 8; ++i) { c[2 * (i - 5)] = cand(fa[i], fb[0], i, 0); c[2 * (i - 5) + 1] = cand(fa[i], fb[1], i, 1); }
        }
        sort16(c); xmergetop(c, 16); xmergetop(c, 32);
        const float mxs = unordf(c[0] & ~0xFFu);
        asm volatile("s_waitcnt lgkmcnt(0)" ::: "memory");
        unsigned ids[4]; float pe[4]; float ls = 0.f;
#pragma unroll
        for (int r = 0; r < 4; ++r) { const unsigned key = g == 0 ? c[r] : g == 1 ? c[4 + r] : g == 2 ? c[8 + r] : c[12 + r]; const int pos = 255 - (int)(key & 0xFFu);
            const unsigned ka_ = lst[pos >> 4], kb_ = lst[16 + (pos & 15)];
            ids[r] = (127u - (ka_ & 0x7Fu)) * 128u + (127u - (kb_ & 0x7Fu));
            const float sv = unordf(ka_ & ~0x7Fu) + unordf(kb_ & ~0x7Fu); pe[r] = __builtin_amdgcn_exp2f((sv - mxs) * 1.4426950408889634f); ls += pe[r]; }
        ls += __shfl_xor(ls, 16); ls += __shfl_xor(ls, 32);
        const float linv = 1.0f / ls;
        asm volatile("s_waitcnt lgkmcnt(0)" ::: "memory");
        if (shave) { st.finish(st.k); ++st.k; }
#pragma unroll
        for (int r = 0; r < 4; ++r) pid[r] = (unsigned short)ids[r];
        pgate = (f32x4){pe[0] * linv, pe[1] * linv, pe[2] * linv, pe[3] * linv}; pt = t;
    }
    if (pt >= 0) {
#pragma unroll
        for (int r = 0; r < 4; ++r) { const int k = 4 * g + r; IDS[(size_t)pt * 128 + (k & 7) * 16 + 2 * h + (k >> 3)] = pid[r]; }
        *(f32x4*)(GATES + (size_t)pt * 128 + h * 16 + 4 * g) = pgate; }
    __syncthreads();
    if (drain && st.k < st.count) {
        RB_LAS unsigned char* const bA = st.buf; RB_LAS unsigned char* const sA = st.sbuf; RB_LAS unsigned char* const bB = lds + SUB_OFF + wid * 8192; RB_LAS unsigned char* const sB = lds + LIST_OFF + wid * 256;
        st.issue(st.k);
        for (int par = 0; st.k < st.count; ++st.k, par ^= 1) {
            if (st.k + 1 < st.count) { st.buf = par ? bA : bB; st.sbuf = par ? sA : sB; st.issue(st.k + 1); if (st.item_of(st.k + 1) < 16384) asm volatile("s_waitcnt vmcnt(4)" ::: "memory"); else asm volatile("s_waitcnt vmcnt(9)" ::: "memory"); } else asm volatile("s_waitcnt vmcnt(0)" ::: "memory");
            st.buf = par ? bB : bA; st.sbuf = par ? sB : sA; st.template finish<false>(st.k); }
        st.buf = bA; st.sbuf = sA; }
    __syncthreads();
}
#undef RB_CE
#undef RB_CEA
#undef RB_LAS
}

namespace lru_body {
typedef short bf16x8 __attribute__((ext_vector_type(8)));
typedef float f32x4 __attribute__((ext_vector_type(4)));
typedef unsigned u32x4 __attribute__((ext_vector_type(4)));
#define LB_LAS __attribute__((address_space(3)))
#define LB_BAR() asm volatile("s_waitcnt lgkmcnt(0)\n\ts_barrier" ::: "memory")
#define LB_LDSWAIT() do { asm volatile("s_waitcnt lgkmcnt(0)" ::: "memory"); __builtin_amdgcn_sched_barrier(0); } while (0)
constexpr int XS_OFF = 0  , XC_OFF = 17408  , WT_OFF = 33792  , RI_OFF = 50176  , EX_OFF = 119808  , LDS_BYTES = 123904;
constexpr int RSTR = 68;
__device__ __forceinline__ float bf(unsigned short b) { return __uint_as_float(((unsigned)b) << 16); }
__device__ __forceinline__ float sigm(float v) { return __builtin_amdgcn_rcpf(1.0f + __builtin_amdgcn_exp2f(-1.4426950408889634f * v)); }
__device__ __forceinline__ float gelu_as(float v) {
    const float av = fabsf(v), t = __builtin_amdgcn_rcpf(1.0f + 0.2316418882f * av);
    float q = t * 0.5307027145f + (-0.7265760135f); q = q * t + 0.7107068705f; q = q * t + (-0.142248368f); q = q * t + 0.127414796f; q = q * t;
    const float e = __builtin_amdgcn_exp2f(v * v * (-0.72134752044f)); const float m = v * (q * e); return v < 0.f ? m : v - m;
}
typedef float f32x2 __attribute__((ext_vector_type(2)));
__device__ __forceinline__ f32x2 exp2_2(f32x2 v) { return (f32x2){__builtin_amdgcn_exp2f(v.x), __builtin_amdgcn_exp2f(v.y)}; }
__device__ __forceinline__ f32x2 rcp_2(f32x2 v) { return (f32x2){__builtin_amdgcn_rcpf(v.x), __builtin_amdgcn_rcpf(v.y)}; }
__device__ __forceinline__ f32x2 sqrt_2(f32x2 v) { return (f32x2){__builtin_amdgcn_sqrtf(v.x), __builtin_amdgcn_sqrtf(v.y)}; }
__device__ __forceinline__ f32x2 splat2(float v) { return (f32x2){v, v}; }
__device__ __forceinline__ f32x2 gelu_as2(f32x2 v) {
    const f32x2 av = (f32x2){fabsf(v.x), fabsf(v.y)}, t = rcp_2(splat2(1.0f) + splat2(0.2316418882f) * av);
    f32x2 q = t * splat2(0.5307027145f) + splat2(-0.7265760135f); q = q * t + splat2(0.7107068705f); q = q * t + splat2(-0.142248368f); q = q * t + splat2(0.127414796f); q = q * t;
    const f32x2 e = exp2_2(v * v * splat2(-0.72134752044f)); const f32x2 m = v * (q * e); const f32x2 d = v - m;
    return (f32x2){v.x < 0.f ? m.x : d.x, v.y < 0.f ? m.y : d.y};
}
__device__ __forceinline__ void lru_item(LB_LAS unsigned char* lds, int b, int blk, const unsigned short* PROJ, unsigned short* MIXED, float* SSL, const float* conv_w, const float* conv_b, const float* wa, const float* ba_, const float* wx,
                                         const float* bx_, const float* lam) {
    int tid_ = threadIdx.x; asm volatile("" : "+v"(tid_)); const int tid = tid_, c = tid & 63, n = tid & 15, g = (tid >> 4) & 3; const int s = __builtin_amdgcn_readfirstlane(tid >> 6);
    const int cb = blk * 64;
    if (s >= 4) __builtin_amdgcn_s_setprio(1);
    LB_LAS unsigned short* XS = (LB_LAS unsigned short*)(lds + XS_OFF); LB_LAS unsigned char* XC = lds + XC_OFF; LB_LAS unsigned char* WT = lds + WT_OFF;
    LB_LAS float* RI = (LB_LAS float*)(lds + RI_OFF); LB_LAS float* EX = (LB_LAS float*)(lds + EX_OFF);
    __syncthreads();
    for (int i = tid; i < 2 * 4096; i += 512) { const int mat = i >> 12, d = (i >> 6) & 63, e = i & 63; const float v = (mat ? wx : wa)[(size_t)(blk * 64 + d) * 64 + e];
        *(LB_LAS unsigned short*)(WT + mat * 8192 + e * 128 + ((((d >> 3) ^ ((e >> 1) & 7))) << 4) + (d & 7) * 2) = (unsigned short)f2bf(v); }
    const float w0 = conv_w[0 * 512 + cb + c], w1 = conv_w[1 * 512 + cb + c], w2 = conv_w[2 * 512 + cb + c], w3 = conv_w[3 * 512 + cb + c], cbias = conv_b[cb + c];
    const float ba = ba_[cb + c], bx = bx_[cb + c], sp8 = 8.0f * log1pf(expf(-lam[cb + c]));
    const size_t tbase = (size_t)b * 2048;
    u32x4 xv[3];
#define LB_XLOAD(T0) do { _Pragma("unroll") for (int p_ = 0; p_ < 3; ++p_) { const int idx_ = tid + 512 * p_, row_ = idx_ >> 3, ch_ = idx_ & 7; const long tok_ = (long)(T0) - 3 + row_; \
        xv[p_] = (u32x4){0u, 0u, 0u, 0u}; if (row_ < 131 && tok_ >= 0) xv[p_] = __builtin_nontemporal_load((const u32x4*)(PROJ + (tbase + tok_) * 2560 + cb + 8 * ch_)); } } while (0)
#define LB_XSTORE() do { _Pragma("unroll") for (int p_ = 0; p_ < 3; ++p_) { const int idx_ = tid + 512 * p_, row_ = idx_ >> 3, ch_ = idx_ & 7; if (row_ < 131) *(LB_LAS u32x4*)(XS + row_ * 64 + 8 * ch_) = xv[p_]; } } while (0)
    LB_XLOAD(0); LB_XSTORE();
    float carry = 0.f;
    for (int k = 0; k < 16; ++k) {
        const int T0 = 128 * k;
        LB_BAR();
        unsigned short gt[16];
#pragma unroll
        for (int i = 0; i < 16; ++i) gt[i] = __builtin_nontemporal_load(PROJ + (tbase + T0 + 16 * s + i) * 2560 + 512 + cb + c);
        float xc[16];
        { float xs[19];
          unsigned short xr[19];
#pragma unroll
          for (int j = 0; j < 19; ++j) xr[j] = XS[(16 * s + j) * 64 + c];
          LB_LDSWAIT();
#pragma unroll
          for (int j = 0; j < 19; ++j) xs[j] = bf(xr[j]);
#pragma unroll
          for (int i = 0; i < 16; i += 2) { const f32x2 r = splat2(cbias) + splat2(w0) * (f32x2){xs[i], xs[i + 1]} + splat2(w1) * (f32x2){xs[i + 1], xs[i + 2]} + splat2(w2) * (f32x2){xs[i + 2], xs[i + 3]} + splat2(w3) * (f32x2){xs[i + 3], xs[i + 4]};
              xc[i] = r.x; xc[i + 1] = r.y; const unsigned w = pg8::cvt_pk_bf16(r.x, r.y); const int tok = 16 * s + i;
              *(LB_LAS unsigned short*)(XC + tok * 128 + ((((c >> 3) ^ ((tok >> 1) & 7))) << 4) + (c & 7) * 2) = (unsigned short)w;
              *(LB_LAS unsigned short*)(XC + (tok + 1) * 128 + ((((c >> 3) ^ ((tok >> 1) & 7))) << 4) + (c & 7) * 2) = (unsigned short)(w >> 16); } }
        LB_BAR();
        if (k + 1 < 16) LB_XLOAD(T0 + 128);
        { bf16x8 af[2], wf[2][4][2]; f32x4 acc[2][4];
#pragma unroll
          for (int ks = 0; ks < 2; ++ks) { const int row = 16 * s + n; af[ks] = *(const LB_LAS bf16x8*)(XC + row * 128 + (((4 * ks + g) ^ ((row >> 1) & 7)) << 4)); }
#pragma unroll
          for (int mat = 0; mat < 2; ++mat)
#pragma unroll
            for (int nt = 0; nt < 4; ++nt)
#pragma unroll
                for (int ks = 0; ks < 2; ++ks) { const int row = 16 * nt + n; wf[mat][nt][ks] = *(const LB_LAS bf16x8*)(WT + mat * 8192 + row * 128 + (((4 * ks + g) ^ ((row >> 1) & 7)) << 4)); }
#pragma unroll
          for (int mat = 0; mat < 2; ++mat)
#pragma unroll
            for (int nt = 0; nt < 4; ++nt) { acc[mat][nt] = __builtin_amdgcn_mfma_f32_16x16x32_bf16(af[0], wf[mat][nt][0], (f32x4){0.f, 0.f, 0.f, 0.f}, 0, 0, 0);
                acc[mat][nt] = __builtin_amdgcn_mfma_f32_16x16x32_bf16(af[1], wf[mat][nt][1], acc[mat][nt], 0, 0, 0); }
#pragma unroll
          for (int mat = 0; mat < 2; ++mat)
#pragma unroll
            for (int nt = 0; nt < 4; ++nt)
#pragma unroll
                for (int r = 0; r < 4; ++r) RI[mat * 128 * RSTR + (16 * s + 4 * g + r) * RSTR + 16 * nt + n] = acc[mat][nt][r]; }
        LB_BAR();
        float av[16], bv[16]; float A = 1.f, B = 0.f;
        { float pr[16], pi[16];
#pragma unroll
          for (int i = 0; i < 16; ++i) { const int tok = 16 * s + i; pr[i] = RI[tok * RSTR + c]; pi[i] = RI[128 * RSTR + tok * RSTR + c]; }
          LB_LDSWAIT();
          const f32x2 nl2 = splat2(-1.4426950408889634f), one2 = splat2(1.0f), nsp2 = splat2(-1.4426950408889634f * sp8);
#pragma unroll
          for (int i = 0; i < 16; i += 2) {
            const f32x2 gr = rcp_2(one2 + exp2_2(nl2 * ((f32x2){pr[i], pr[i + 1]} + splat2(ba)))), gi = rcp_2(one2 + exp2_2(nl2 * ((f32x2){pi[i], pi[i + 1]} + splat2(bx))));
            const f32x2 a = exp2_2(nsp2 * gr); f32x2 om = one2 - a * a; om = (f32x2){fmaxf(om.x, 0.f), fmaxf(om.y, 0.f)};
            const f32x2 b = sqrt_2(om) * (gi * (f32x2){xc[i], xc[i + 1]});
            av[i] = a.x; av[i + 1] = a.y; bv[i] = b.x; bv[i + 1] = b.y; A *= a.x; B = a.x * B + b.x; A *= a.y; B = a.y * B + b.y; } }
        EX[(s * 64 + c) * 2] = A; EX[(s * 64 + c) * 2 + 1] = B;
        LB_BAR();
        float hin = carry, hall = carry;
        { float ea[8], eb[8];
#pragma unroll
          for (int w = 0; w < 8; ++w) { ea[w] = EX[(w * 64 + c) * 2]; eb[w] = EX[(w * 64 + c) * 2 + 1]; }
          LB_LDSWAIT();
#pragma unroll
          for (int w = 0; w < 8; ++w) { hall = ea[w] * hall + eb[w]; if (w < s) hin = hall; } }
        carry = hall;
        float h = hin;
        float sq[16];
#pragma unroll
        for (int i = 0; i < 16; i += 2) { const float h0 = av[i] * h + bv[i]; h = av[i + 1] * h0 + bv[i + 1];
            const f32x2 y = (f32x2){h0, h} * (f32x2){bf(gt[i]), bf(gt[i + 1])};   const unsigned w = pg8::cvt_pk_bf16(y.x, y.y);
            MIXED[(tbase + T0 + 16 * s + i) * 1024 + cb + c] = (unsigned short)w; MIXED[(tbase + T0 + 16 * s + i + 1) * 1024 + cb + c] = (unsigned short)(w >> 16);
            const f32x2 yf = (f32x2){__uint_as_float(w << 16), __uint_as_float(w & 0xffff0000u)}; const f32x2 q2 = yf * yf; sq[i] = q2.x; sq[i + 1] = q2.y; }
        {
          const bool h3 = (c & 8) != 0, h2 = (c & 4) != 0; float r8[8], r4[4], r2[2], r1;
#pragma unroll
          for (int i = 0; i < 8; ++i) r8[i] = swap32_add(sq[i], sq[i + 8]);
#pragma unroll
          for (int i = 0; i < 4; ++i) r4[i] = swap16_add(r8[i], r8[i + 4]);
#pragma unroll
          for (int i = 0; i < 2; ++i) { const float sa = r4[i] + dpp_f<DPP_ROR8>(r4[i]), sb = r4[i + 2] + dpp_f<DPP_ROR8>(r4[i + 2]); r2[i] = h3 ? sb : sa; }
          { const float sa = r2[0] + dpp_f<DPP_HMIRROR>(r2[0]), sb = r2[1] + dpp_f<DPP_HMIRROR>(r2[1]); r1 = h2 ? sb : sa; }
          r1 += dpp_f<DPP_XOR2>(r1); r1 += dpp_f<DPP_XOR1>(r1);
          if ((c & 3) == 0) SSL[(tbase + T0 + 16 * s + (c >> 2)) * 8 + blk] = r1; }
        if (k + 1 < 16) LB_XSTORE();
    }
    __builtin_amdgcn_s_setprio(0);
    __syncthreads();
#undef LB_XLOAD
#undef LB_XSTORE
}
#undef LB_BAR
#undef LB_LDSWAIT
#undef LB_LAS
}

__device__ __forceinline__ void p0_hrows(Frame& F) {
    bf16* H = (bf16*)(F.ws + WS_A);
    const int lw = ((int)blockIdx.x >> 3) * NWAVES + F.wave, nlw = (F.G >> 3) * NWAVES, r0 = ((int)blockIdx.x & 7) * (T / 8);
    for (int m = 4 * lw; m < T / 8; m += 4 * nlw) rms_rows_to_bf16<4>(F.lane, F.in[0] + (size_t)(r0 + m) * D, F.in[2], H + (size_t)(r0 + m) * D);
}
struct QuadSync { gu32* cnt; unsigned* bar; unsigned gen; unsigned n; bool local; };
__device__ __forceinline__ void quad_sync(QuadSync& q, gu32* extra = nullptr, unsigned extra_want = 0u) {
    asm volatile("s_waitcnt vmcnt(0)" ::: "memory");
    __syncthreads();
    ++q.gen;
    if (threadIdx.x == 0) {
        if (!q.local) { __builtin_amdgcn_fence(__ATOMIC_RELEASE, "agent"); asm volatile("s_waitcnt vmcnt(0)" ::: "memory"); }
        __hip_atomic_fetch_add(q.cnt, 1u, RLX_AGENT);
        const unsigned want = q.n * q.gen;
        if (extra != nullptr) XB_SPIN((xb_ld((unsigned*)q.cnt) < want) | (xb_ld((unsigned*)extra) < extra_want), q.bar); else XB_SPIN(xb_ld((unsigned*)q.cnt) < want, q.bar);
        __builtin_amdgcn_fence(__ATOMIC_ACQUIRE, "agent");
        asm volatile("s_waitcnt vmcnt(0)" ::: "memory");
    }
    __syncthreads();
}
struct QuadOrder { pg8::StaticOrder S;
    __device__ __forceinline__ bool next(int i, pg8::Unit& u) const { pg8::Unit v; if (!S.next(i >> 1, v)) return false; u.pm = v.pm; u.pn = 2 * v.pn + (i & 1); return true; }
    __device__ __forceinline__ void a_ready(const pg8::Unit&) const {}
    __device__ __forceinline__ void done(const pg8::Unit&) const {}
};
constexpr int NPHASE = 12;
#ifndef MK_ONE_LAUNCH
#define MK_ONE_LAUNCH 1
#endif
struct Args { const float* in[26]; float* out; unsigned char* ws; int ph_lo, ph_hi; };
__global__ void __launch_bounds__(NWAVES * 64, 2) mk_fwd(Args args) {
    extern __shared__ __attribute__((aligned(16))) unsigned char lds[];
    Frame F;
    F.lds = (LAS unsigned char*)lds;
    F.MISC = (volatile LAS unsigned*)(F.lds + MISC_OFF);
    F.tid = threadIdx.x; F.lane = F.tid & 63; F.wave = __builtin_amdgcn_readfirstlane(F.tid >> 6);
    F.G = gridDim.x; { const int bx = blockIdx.x; F.vcu = (F.G % 8 == 0) ? (bx % 8) * (F.G / 8) + bx / 8 : bx; }
    F.ws = args.ws; F.out = args.out; F.ctl = (gu32*)(args.ws + WS_CTL);
#pragma unroll
    for (int i = 0; i < 26; ++i) F.in[i] = args.in[i];
    for (int u = F.tid; u < (LDS_BYTES - LDSCTL_OFF) / 4; u += NWAVES * 64) ((LAS unsigned*)(F.lds + LDSCTL_OFF))[u] = 0u;
    __syncthreads();
    const int lo = args.ph_lo, hi = args.ph_hi;
    if (threadIdx.x == 0) __hip_atomic_store(F.ctl + CW_XID + blockIdx.x, xb_xcc_id() + 1u, RLX_AGENT);
    XcdBarrier bar; bar.bar = (unsigned*)(F.ctl + CW_BAR); bar.x = 0; bar.st = nullptr;
    if (hi - lo > 1) bar = xcd_barrier_post((unsigned*)(F.ctl + CW_BAR), F.MISC + 8);
#define IN(k) (lo <= (k) && (k) < hi)
#define SEAM(k) do { if (IN(k) && IN((k) + 1)) xcd_barrier(bar); } while (0)
#define QSEAM(k) do { if (IN(k) && IN((k) + 1)) { if (quad) quad_sync(qs); else xcd_barrier(bar); } } while (0)
    const bool quad = (F.G == 256) && (hi - lo > 1); QuadSync qs; qs.cnt = F.ctl + CW_QUAD + 64 * (blockIdx.x & 63); qs.bar = (unsigned*)(F.ctl + CW_BAR); qs.gen = 0u; qs.n = 4u; qs.local = false;
    QuadSync gs; gs.cnt = F.ctl + CW_G32 + 64 * (blockIdx.x & 7); gs.bar = qs.bar; gs.gen = 0u; gs.n = 32u; gs.local = false;
#define GSEAM(k) do { if (IN(k) && IN((k) + 1)) { if (quad) quad_sync(gs); else xcd_barrier(bar); } } while (0)
    bf16* Win_t = (bf16*)(F.ws + WS_WIN); bf16* Wout_t = (bf16*)(F.ws + WS_WOUT); bf16* Wcq_t = (bf16*)(F.ws + WS_WCQ); bf16* Wckv_t = (bf16*)(F.ws + WS_WCKV);
    bf16* Wco_t = (bf16*)(F.ws + WS_WCO); bf16* Wpq_t = (bf16*)(F.ws + WS_WPQ);
    bf16* H = (bf16*)(F.ws + WS_A); bf16* X1 = (bf16*)(F.ws + WS_A); bf16* PROJ = (bf16*)(F.ws + WS_B); bf16* QC = (bf16*)(F.ws + WS_B + GRP_SHIFT * ((size_t)blockIdx.x & 7)); bf16* OC = (bf16*)(F.ws + WS_B + GRP_SHIFT * ((size_t)blockIdx.x & 7) + 8 * MiB);
    bf16* MIXED = (bf16*)(F.ws + WS_C); bf16* X2 = (bf16*)(F.ws + WS_C); bf16* MEMN = (bf16*)(F.ws + WS_MEMN); bf16* KCVC = (bf16*)(F.ws + WS_KCVC); bf16* PQ = (bf16*)(F.ws + WS_E);
    float* SS1 = (float*)(F.ws + WS_SS1); float* SS2 = (float*)(F.ws + WS_SS2);

    if (IN(0)) { p0_prologue(F, quad && IN(1));
        if (quad && IN(1)) {
            unsigned xid[32];
#pragma unroll
            for (int j = 0; j < 32; ++j) xid[j] = xb_ld((unsigned*)(F.ctl + CW_XID + (blockIdx.x & 7) + 8 * j));
            p0_hrows(F);
            { unsigned same = 1u;
#pragma unroll
              for (int j = 1; j < 32; ++j) same &= (xid[j] == xid[0]) ? 1u : 0u;
              gs.local = (same != 0u) && (xid[0] != 0u); }
            quad_sync(gs);
            if (threadIdx.x == 0) { XB_SPIN(xb_ld((unsigned*)(F.ctl + CW_WCNT)) < (unsigned)F.G, qs.bar); __builtin_amdgcn_fence(__ATOMIC_ACQUIRE, "agent"); asm volatile("s_waitcnt vmcnt(0)" ::: "memory"); }
            __syncthreads(); }
        else SEAM(0); }
#define STAG_SPLIT(k, n) int a0, a1; table_share(F, k, n, a0, a1); const int am = a0 + ((((int)blockIdx.x >> 3) & 3) * (a1 - a0) + 1) / 3
#define STAG_BEFORE(WHICH, k, n) do { STAG_SPLIT(k, n); if (am > a0) convert_rows<WHICH>(F, a0, am < a1 ? am : a1); } while (0)
#define STAG_AFTER(WHICH, k, n) do { STAG_SPLIT(k, n); if (am < a1) convert_rows<WHICH>(F, am, a1); } while (0)
    if (IN(1)) {
        STAG_BEFORE(0, 0, 1);
        { pg8::Gemm g{H, Win_t, T, DIN, D}; pg8::StaticOrder S; S.init(T, DIN, F.G, (int)blockIdx.x); pg8::EpiStore E{PROJ, DIN, 4, 6, attn_body::C2, (float*)(F.ws + WS_KMEAN), 2, 4};
          pg8::gemm_phase<pg8::EpiStore, pg8::StaticOrder, true, true>(F.lds + RING_OFF, g, S, E); }
        STAG_AFTER(0, 0, 1);
        GSEAM(1);
    }
    if (IN(2)) {
        const attn_body::AttnTensors AT{(const attn_body::bf16*)(PROJ + COL_Q), (const attn_body::bf16*)(PROJ + COL_K), (const attn_body::bf16*)(PROJ + COL_V), (attn_body::bf16*)(MIXED + DLRU), (const float*)(F.ws + WS_KMEAN), (float*)(F.ws + WS_SSA)};
        for (int it = F.vcu; it < 2 * BATCH * AH; it += F.G) {
            if (it & 1) lru_body::lru_item(F.lds + RING_OFF, (it >> 1) / LBLK, (it >> 1) % LBLK, PROJ, MIXED, (float*)(F.ws + WS_SSL), F.in[4], F.in[5], F.in[6], F.in[7], F.in[8], F.in[9], F.in[10]);
            else { int gi = it >> 1;
                if (quad) { const int x = it >> 5, e = (it & 31) >> 1; gi = (e < 8) ? 4 * (2 * x + (e >> 2)) + (e & 3) : 64 + 16 * ((e - 8) & 3) + 2 * x + ((e - 8) >> 2); }
                if (gi < 64) { pg8::Gemm g{MEMN, Wckv_t, TM, D, D}; pg8::OneUnit S{gi >> 2, gi & 3, true}; pg8::EpiStore E{KCVC, D, 0, 0, 1.0f, nullptr};
                    pg8::gemm_phase<pg8::EpiStore, pg8::OneUnit, true, true>(F.lds + RING_OFF, g, S, E); }
                else { pg8::Gemm g{Wckv_t + (size_t)D * D, MEMN, D, TM, D}; pg8::OneUnit S{(gi - 64) >> 4, (gi - 64) & 15, true}; pg8::EpiStore E{KCVC + (size_t)TM * D, TM, 0, 0, 1.0f, nullptr};
                    pg8::gemm_phase<pg8::EpiStore, pg8::OneUnit, true, true>(F.lds + RING_OFF, g, S, E); } }
            attn_body::attn_item((char*)lds + RING_OFF, AT, it); }
        GSEAM(2);
        if (quad && threadIdx.x == 0) __hip_atomic_fetch_add(F.ctl + CW_P2CNT, 1u, RLX_AGENT); }
    if (quad && IN(3) && lo < 3) { unsigned same = 1u; const unsigned x0 = xb_ld((unsigned*)(F.ctl + CW_XID + (blockIdx.x & 63)));
#pragma unroll
        for (int j = 1; j < 4; ++j) same &= (xb_ld((unsigned*)(F.ctl + CW_XID + (blockIdx.x & 63) + 64 * j)) == x0) ? 1u : 0u;
        qs.local = (same != 0u) && (x0 != 0u); }
    if (IN(3)) { pg8::Gemm g{MIXED, Wout_t, T, D, D}; pg8::StaticOrder S; S.init(T, D, F.G, (int)blockIdx.x); pg8::EpiResidGN E{F.in[0], X1, SS1, (const float*)(F.ws + WS_SSL), (const float*)(F.ws + WS_SSA), D, EPS};
        {
          pg8::Unit u0, u1; const bool h0 = S.next(0, u0), h1 = S.next(1, u1); pg8::Unit u2; const bool h2 = S.next(2, u2);
          if (h0 && !h2) { LAS float* gnl = (LAS float*)(F.lds + RING_OFF + 131072); const int ui = F.tid >> 8, r = F.tid & 255;
              if (ui == 0 || h1) { const int row = (ui ? u1.pm : u0.pm) * 256 + r; const float rl = 1.0f / sqrtf(E.rsum8(E.SSL + (size_t)row * 8) * (1.0f / 512.0f) + EPS), rh = 1.0f / sqrtf(E.rsum8(E.SSA + (size_t)row * 8) * (1.0f / 512.0f) + EPS);
                  gnl[(ui * 256 + r) * 2] = rl / rh; gnl[(ui * 256 + r) * 2 + 1] = rh; }
              asm volatile("s_waitcnt vmcnt(0) lgkmcnt(0)\n\ts_barrier" ::: "memory");
              E.gn = (const LAS float*)gnl; E.pm0 = u0.pm; } }
        pg8::gemm_phase<pg8::EpiResidGN, pg8::StaticOrder, true, true>(F.lds + RING_OFF, g, S, E);
        QSEAM(3); }
#define RS_STAGE(E_, SSp_, pmA_, pmB_, haveB_) do { LAS float* rl_ = (LAS float*)(F.lds + RING_OFF + 131072); const int ui_ = F.tid >> 8, r_ = F.tid & 255; \
        if (ui_ == 0 || (haveB_)) { const int row_ = (ui_ ? (pmB_) : (pmA_)) * 256 + r_; const f32x4* sp_ = (const f32x4*)((SSp_) + (size_t)row_ * 16); const f32x4 s0_ = sp_[0], s1_ = sp_[1], s2_ = sp_[2], s3_ = sp_[3]; \
            const float tot_ = ((s0_[0] + s0_[1]) + (s0_[2] + s0_[3])) + ((s1_[0] + s1_[1]) + (s1_[2] + s1_[3])) + ((s2_[0] + s2_[1]) + (s2_[2] + s2_[3])) + ((s3_[0] + s3_[1]) + (s3_[2] + s3_[3])); \
            rl_[ui_ * 256 + r_] = 1.0f / sqrtf(tot_ * (1.0f / 1024.0f) + EPS); } \
        asm volatile("s_waitcnt vmcnt(0) lgkmcnt(0)\n\ts_barrier" ::: "memory"); (E_).rsl = (const LAS float*)rl_; (E_).pm0 = (pmA_); } while (0)
    if (IN(4)) {
        pg8::Gemm g{X1, Wcq_t, T, D, D}; pg8::StaticOrder S; S.init(T, D, F.G, (int)blockIdx.x); pg8::EpiScale E{SS1, QC, D, EPS};
        { pg8::Unit a0, a1, a2; const bool h0 = S.next(0, a0), h1 = S.next(1, a1), h2 = S.next(2, a2); if (h0 && !h2) RS_STAGE(E, SS1, a0.pm, a1.pm, h1); }
        pg8::gemm_phase<pg8::EpiScale, pg8::StaticOrder, true, true>(F.lds + RING_OFF, g, S, E);
        __builtin_amdgcn_fence(__ATOMIC_ACQUIRE, "agent");
        { cross_body::bf16x8 qf[8]; int zz = 0; asm volatile("" : "+s"(zz)); bool first = true;
          for (int i = 0; ; ++i) { pg8::Unit u, un; if (!S.next(i, u)) break; const bool more = S.next(i + 1, un);
              const int b = u.pm >> 3, t0 = u.pm * 256;
              cross_body::cross_unit(F.lds + RING_OFF, QC, KCVC, KCVC + (size_t)TM * D, OC, b, u.pn, t0, qf, first, true, b, u.pn, t0 + 128, zz);
              cross_body::cross_unit(F.lds + RING_OFF, QC, KCVC, KCVC + (size_t)TM * D, OC, b, u.pn, t0 + 128, qf, false, more, un.pm >> 3, un.pn, un.pm * 256, zz);
              first = false; }
          asm volatile("s_waitcnt vmcnt(0) lgkmcnt(0)\n\ts_barrier" ::: "memory"); }
        QSEAM(4); }
    if (IN(5)) { pg8::Gemm g{OC, Wco_t, T, D, D}; pg8::StaticOrder S; S.init(T, D, F.G, (int)blockIdx.x); pg8::EpiResid E{nullptr, X1, X2, SS2, D};
        pg8::gemm_phase<pg8::EpiResid, pg8::StaticOrder, true, true>(F.lds + RING_OFF, g, S, E);
        if (IN(5) && IN(6)) { if (quad) quad_sync(qs, F.ctl + CW_P2CNT, (unsigned)F.G); else xcd_barrier(bar); } }
    if (IN(6)) { pg8::Gemm g{X2, Wpq_t, T, 2048, D}; pg8::EpiScale E{SS2, PQ, 2048, EPS};
        if (quad) { QuadOrder S; S.S.init(T, D, F.G, (int)blockIdx.x);
            { pg8::Unit a0, a1, a2; const bool h0 = S.S.next(0, a0), h1 = S.S.next(1, a1), h2 = S.S.next(2, a2); if (h0 && !h2) RS_STAGE(E, SS2, a0.pm, a1.pm, h1); }
            pg8::gemm_phase<pg8::EpiScale, QuadOrder, true, true>(F.lds + RING_OFF, g, S, E); }
        else { pg8::StaticOrder S; S.init(T, 2048, F.G, (int)blockIdx.x); pg8::gemm_phase<pg8::EpiScale, pg8::StaticOrder, true, true>(F.lds + RING_OFF, g, S, E); }
        if (quad && IN(7)) { asm volatile("s_waitcnt vmcnt(0)" ::: "memory"); __syncthreads(); } else SEAM(6); }
    if (IN(7)) { PeerStream st; st.k = 0; st.lane = F.lane; st.U = F.in[23]; st.V = F.in[24]; st.gf = F.in[20]; st.UQ = (signed char*)(F.ws + WS_UQ); st.SU = (float*)(F.ws + WS_SU); st.VQ = F.ws + WS_VQ;
        st.X2 = X2; st.SS2 = SS2; st.XQ = (signed char*)(F.ws + WS_XQ); st.HS = (float*)(F.ws + WS_HS); st.buf = F.lds + STREAM_OFF + F.wave * STREAM_WAVE_BYTES; st.sbuf = F.lds + STREAM_OFF + NWAVES * STREAM_WAVE_BYTES + F.wave * 256;
        if (quad) {
            pg8::StaticOrder S; S.init(T, D, F.G, (int)blockIdx.x); pg8::Unit u0, u1; S.next(0, u0); S.next(1, u1);
            st.local = true; st.count = 12; st.xb0 = 64 * u0.pm + 16 * u0.pn + 2 * F.wave; st.xb1 = 64 * u1.pm + 16 * u1.pn + 2 * F.wave; st.vbase = 64 * (int)blockIdx.x + F.wave; st.gbase = 0; st.gstep = 0;
            const route_body::PanelTiles tts{u0.pm, u1.pm};
            route_body::route_phase(F.lds + RING_OFF, PQ, (const bf16*)(F.ws + WS_SUBK), (unsigned short*)(F.ws + WS_IDS), (float*)(F.ws + WS_GATES), 2 * u0.pn, tts, st, false);
            route_body::route_phase(F.lds + RING_OFF, PQ, (const bf16*)(F.ws + WS_SUBK), (unsigned short*)(F.ws + WS_IDS), (float*)(F.ws + WS_GATES), 2 * u0.pn + 1, tts, st, true);
        } else { const int h = F.vcu & 7, rank = F.vcu >> 3, nrank = (F.G - h + 7) >> 3;
            st.local = false; st.gbase = F.vcu * 8 + F.wave; st.gstep = F.G * 8; st.count = (16384 + 8192 - st.gbase + st.gstep - 1) / st.gstep; st.xb0 = st.xb1 = st.vbase = 0;
            const route_body::StrideTiles tts{rank, nrank, (T / 128 - rank + nrank - 1) / nrank};
            route_body::route_phase(F.lds + RING_OFF, PQ, (const bf16*)(F.ws + WS_SUBK), (unsigned short*)(F.ws + WS_IDS), (float*)(F.ws + WS_GATES), h, tts, st, true); }
        SEAM(7); }
    if (IN(8)) { peer_u(F, hi - lo > 1); SEAM(8); }
    if (IN(9)) { peer_combine(F); SEAM(9); }
    if (IN(10)) { peer_v(F, hi - lo > 1); SEAM(10); }
    if (IN(11)) { final_norm(F); }
#undef IN
#undef SEAM
#undef QSEAM
#undef RS_STAGE
#undef GSEAM
}

extern "C" void kernel_launch(void* const* d_in, const int* in_sizes, int n_in, void* d_out, int out_size, void* d_ws, size_t ws_size, hipStream_t stream) {
    static int grid = 0;
    if (grid == 0) {
        if (n_in != 26 || in_sizes[0] != T * D || out_size != T * D || ws_size < WS_END) { fprintf(stderr, "kernel_launch: unexpected shapes (n_in %d, in0 %d, out %d, ws %zu); nothing launched\n", n_in, n_in > 0 ? in_sizes[0] : -1, out_size, ws_size); grid = -1; return; }
        int dev = 0, cus = 0, per_cu = 0;
        if (hipGetDevice(&dev) != hipSuccess || hipDeviceGetAttribute(&cus, hipDeviceAttributeMultiprocessorCount, dev) != hipSuccess) { grid = -1; return; }
        if (hipFuncSetAttribute((const void*)mk_fwd, hipFuncAttributeMaxDynamicSharedMemorySize, LDS_BYTES) != hipSuccess) { fprintf(stderr, "kernel_launch: hipFuncSetAttribute failed\n"); grid = -1; return; }
        if (hipOccupancyMaxActiveBlocksPerMultiprocessor(&per_cu, (const void*)mk_fwd, NWAVES * 64, LDS_BYTES) != hipSuccess || per_cu < 1) fprintf(stderr, "kernel_launch: occupancy query reports %d\n", per_cu);
        (void)hipGetLastError();
        grid = cus;
    }
    if (grid < 0) return;
    (void)hipMemsetAsync((char*)d_ws + WS_CTL, 0, CTL_ZERO_BYTES, stream);
    Args a{};
    for (int i = 0; i < 26; ++i) a.in[i] = (const float*)d_in[i];
    a.out = (float*)d_out; a.ws = (unsigned char*)d_ws;
#if MK_ONE_LAUNCH
    a.ph_lo = 0; a.ph_hi = NPHASE;
    hipLaunchKernelGGL(mk_fwd, dim3(grid), dim3(NWAVES * 64), LDS_BYTES, stream, a);
#else
    for (int p = 0; p < NPHASE; ++p) { a.ph_lo = p; a.ph_hi = p + 1; hipLaunchKernelGGL(mk_fwd, dim3(grid), dim3(NWAVES * 64), LDS_BYTES, stream, a); }
#endif
}
```
